# Optimizing an MI355X kernel written in HIP

```python
import jax, jax.numpy as jnp
from jax import lax
import numpy as np

D_MODEL = 1024
BATCH = 2
SEQ = 8192
DEPTH = 2

GRID_W = 64
CTX_LEN = 256
EPS = 1e-6
ROPE_THETA = 10000.0
Q_BLOCK = 128
N_MOD = 6
FNET_GROUPS = 4
FNET_GROUP_DIM = 128
FNET_WIDTH = FNET_GROUPS * FNET_GROUP_DIM
MLA_HEADS = 8
MLA_Q_LORA = 256
MLA_KV_LORA = 128
MLA_NOPE = 64
MLA_ROPE = 32
MLA_V = 64
MLA_QK = MLA_NOPE + MLA_ROPE
AB_IN = FNET_WIDTH + MLA_Q_LORA + MLA_KV_LORA + MLA_ROPE
AB_OUT = FNET_WIDTH + MLA_HEADS * MLA_V
GQA_HEADS = 8
GQA_KV_HEADS = 2
GQA_GROUP = GQA_HEADS // GQA_KV_HEADS
GQA_HEAD_DIM = 128
C_IN = (GQA_HEADS + 2 * GQA_KV_HEADS) * GQA_HEAD_DIM
C_OUT = GQA_HEADS * GQA_HEAD_DIM
N_EXPERTS = 16
EXPERT_FF = 2048
CAPACITY_FACTOR = 2
N_EVEN = (DEPTH + 1) // 2
N_ODD = DEPTH // 2

kernel_name = "hybrid_fnet_mla_gqa_ecmoe_dit"


def rms_norm(x, g):
    xf = x.astype(jnp.float32)
    y = xf * lax.rsqrt(jnp.mean(xf * xf, axis=-1, keepdims=True) + EPS)
    return (y * g.astype(jnp.float32)).astype(x.dtype)


def modulate(x, g, shift, scale):
    return rms_norm(x, g) * (1 + scale) + shift


def rope_1d(x, pos):
    half = x.shape[-1] // 2
    inv = ROPE_THETA ** (-jnp.arange(half, dtype=jnp.float32) / half)
    ang = pos[:, None] * inv[None, :]
    cos = jnp.cos(ang)[None, :, None, :]
    sin = jnp.sin(ang)[None, :, None, :]
    xf = x.astype(jnp.float32)
    x1, x2 = xf[..., :half], xf[..., half:]
    return jnp.concatenate([x1 * cos - x2 * sin, x1 * sin + x2 * cos], axis=-1).astype(x.dtype)


def axial_rope(x, row, col):
    half = x.shape[-1] // 2
    return jnp.concatenate([rope_1d(x[..., :half], row), rope_1d(x[..., half:], col)], axis=-1)


def block_attention(q, k, v, scale):
    B, S, Hk, G, dk = q.shape
    dv = v.shape[-1]
    nb = S // Q_BLOCK
    qb = q.reshape(B, nb, Q_BLOCK, Hk, G, dk).transpose(1, 0, 2, 3, 4, 5)

    def one_block(qi):
        s = jnp.einsum('bqkgd,btkd->bkgqt', qi, k).astype(jnp.float32) * scale
        p = jax.nn.softmax(s, axis=-1).astype(v.dtype)
        return jnp.einsum('bkgqt,btkd->bqkgd', p, v)

    o = lax.map(one_block, qb)
    return o.transpose(1, 0, 2, 3, 4, 5).reshape(B, S, Hk, G, dv)


def fourier_mix(f):
    B, S, _ = f.shape
    ff = f.reshape(B, S, FNET_GROUPS, FNET_GROUP_DIM).astype(jnp.float32)
    y = jnp.fft.fft2(ff, axes=(1, 3), norm='ortho').real
    return y.reshape(B, S, FNET_WIDTH).astype(f.dtype)


def mla_project(proj, q_norm, w_uq, kv_norm, w_ukv, row, col):
    B, S, _ = proj.shape
    o = FNET_WIDTH
    f = proj[..., :o]
    cq = proj[..., o:o + MLA_Q_LORA]
    o += MLA_Q_LORA
    ckv = proj[..., o:o + MLA_KV_LORA]
    o += MLA_KV_LORA
    kr = proj[..., o:o + MLA_ROPE][:, :, None, :]
    q = (rms_norm(cq, q_norm) @ w_uq).reshape(B, S, MLA_HEADS, MLA_QK)
    kv = (rms_norm(ckv, kv_norm) @ w_ukv).reshape(B, S, MLA_HEADS, MLA_NOPE + MLA_V)
    q_nope, q_rope = q[..., :MLA_NOPE], q[..., MLA_NOPE:]
    k_nope, v = kv[..., :MLA_NOPE], kv[..., MLA_NOPE:]
    if row is not None:
        q_rope = axial_rope(q_rope, row, col)
        kr = axial_rope(kr, row, col)
    q = jnp.concatenate([q_nope, q_rope], axis=-1)
    k = jnp.concatenate([k_nope, jnp.broadcast_to(kr, (B, S, MLA_HEADS, MLA_ROPE))], axis=-1)
    return f, q, k, v


def mixer_ab(h_lat, h_ctx, w_in, q_norm, w_uq, kv_norm, w_ukv, w_o, row, col, ctx_out):
    B, S, _ = h_lat.shape
    scale = MLA_QK ** -0.5
    f_l, q_l, k_l, v_l = mla_project(h_lat @ w_in, q_norm, w_uq, kv_norm, w_ukv, row, col)
    f_c, q_c, k_c, v_c = mla_project(h_ctx @ w_in, q_norm, w_uq, kv_norm, w_ukv, None, None)
    k_all = jnp.concatenate([k_c, k_l], axis=1)
    v_all = jnp.concatenate([v_c, v_l], axis=1)
    a_l = block_attention(q_l[:, :, :, None, :], k_all, v_all, scale).reshape(B, S, MLA_HEADS * MLA_V)
    y_l = jnp.concatenate([fourier_mix(f_l), a_l], axis=-1) @ w_o
    y_c = None
    if ctx_out:
        L = h_ctx.shape[1]
        a_c = block_attention(q_c[:, :, :, None, :], k_c, v_c, scale).reshape(B, L, MLA_HEADS * MLA_V)
        y_c = jnp.concatenate([fourier_mix(f_c), a_c], axis=-1) @ w_o
    return y_l, y_c


def gqa_project(h, w_in, q_gain, k_gain, row, col):
    B, S, _ = h.shape
    p = h @ w_in
    nq = GQA_HEADS * GQA_HEAD_DIM
    nk = GQA_KV_HEADS * GQA_HEAD_DIM
    q = rms_norm(p[..., :nq].reshape(B, S, GQA_HEADS, GQA_HEAD_DIM), q_gain)
    k = rms_norm(p[..., nq:nq + nk].reshape(B, S, GQA_KV_HEADS, GQA_HEAD_DIM), k_gain)
    v = p[..., nq + nk:].reshape(B, S, GQA_KV_HEADS, GQA_HEAD_DIM)
    if row is not None:
        q = axial_rope(q, row, col)
        k = axial_rope(k, row, col)
    return q.reshape(B, S, GQA_KV_HEADS, GQA_GROUP, GQA_HEAD_DIM), k, v


def mixer_c(h_lat, h_ctx, w_in, q_gain, k_gain, w_o, row, col, ctx_out):
    B, S, _ = h_lat.shape
    scale = GQA_HEAD_DIM ** -0.5
    q_l, k_l, v_l = gqa_project(h_lat, w_in, q_gain, k_gain, row, col)
    q_c, k_c, v_c = gqa_project(h_ctx, w_in, q_gain, k_gain, None, None)
    k_all = jnp.concatenate([k_c, k_l], axis=1)
    v_all = jnp.concatenate([v_c, v_l], axis=1)
    y_l = block_attention(q_l, k_all, v_all, scale).reshape(B, S, C_OUT) @ w_o
    y_c = None
    if ctx_out:
        L = h_ctx.shape[1]
        y_c = block_attention(q_c, k_c, v_c, scale).reshape(B, L, C_OUT) @ w_o
    return y_l, y_c


def expert_choice_ffn(h, w_router, w_gate, w_up, w_down):
    B, N, D = h.shape
    cap = CAPACITY_FACTOR * N // N_EXPERTS
    logits = jnp.einsum('bnd,de->bne', h, w_router).astype(jnp.float32)
    aff = jax.nn.softmax(logits, axis=-1)
    g, idx = lax.top_k(jnp.swapaxes(aff, 1, 2), cap)
    xs = jax.vmap(lambda hb, ib: hb[ib])(h, idx)
    a = jnp.einsum('becd,edf->becf', xs, w_gate)
    u = jnp.einsum('becd,edf->becf', xs, w_up)
    y = jnp.einsum('becf,efd->becd', jax.nn.silu(a) * u, w_down)
    y = y * g[..., None].astype(y.dtype)
    return jax.vmap(lambda yb, ib: jnp.zeros((N, D), yb.dtype).at[ib.reshape(-1)].add(yb.reshape(-1, D)))(y, idx)


def setup_inputs(seed: int = 0) -> dict:
    key = jax.random.key(seed)
    ks = jax.random.split(key, 24)
    D = D_MODEL
    nrm = lambda k, shape, s: jax.random.normal(k, shape, jnp.float32) * s
    gain = lambda k, shape: 1.0 + 0.05 * jax.random.normal(k, shape, jnp.float32)
    return {
        "x": nrm(ks[0], (BATCH, SEQ, D), 1.0),
        "c": nrm(ks[1], (BATCH, D), 1.0),
        "ctx": nrm(ks[2], (BATCH, CTX_LEN, D), 1.0),
        "c_ctx": nrm(ks[3], (D,), 1.0),
        "ada_w": nrm(ks[4], (DEPTH, D, N_MOD * D), 0.5 * D ** -0.5),
        "ada_b": nrm(ks[5], (DEPTH, N_MOD * D), 0.02),
        "norm1": gain(ks[6], (DEPTH, D)),
        "norm2": gain(ks[7], (DEPTH, D)),
        "ab_w_in": nrm(ks[8], (N_EVEN, D, AB_IN), D ** -0.5),
        "ab_q_norm": gain(ks[9], (N_EVEN, MLA_Q_LORA)),
        "ab_w_uq": nrm(ks[10], (N_EVEN, MLA_Q_LORA, MLA_HEADS * MLA_QK), MLA_Q_LORA ** -0.5),
        "ab_kv_norm": gain(ks[11], (N_EVEN, MLA_KV_LORA)),
        "ab_w_ukv": nrm(ks[12], (N_EVEN, MLA_KV_LORA, MLA_HEADS * (MLA_NOPE + MLA_V)), MLA_KV_LORA ** -0.5),
        "ab_w_o": nrm(ks[13], (N_EVEN, AB_OUT, D), AB_OUT ** -0.5),
        "c_w_in": nrm(ks[14], (N_ODD, D, C_IN), D ** -0.5),
        "c_q_gain": gain(ks[15], (N_ODD, GQA_HEAD_DIM)),
        "c_k_gain": gain(ks[16], (N_ODD, GQA_HEAD_DIM)),
        "c_w_o": nrm(ks[17], (N_ODD, C_OUT, D), C_OUT ** -0.5),
        "moe_router": nrm(ks[18], (DEPTH, D, N_EXPERTS), D ** -0.5),
        "moe_w_gate": nrm(ks[19], (DEPTH, N_EXPERTS, D, EXPERT_FF), D ** -0.5),
        "moe_w_up": nrm(ks[20], (DEPTH, N_EXPERTS, D, EXPERT_FF), D ** -0.5),
        "moe_w_down": nrm(ks[21], (DEPTH, N_EXPERTS, EXPERT_FF, D), EXPERT_FF ** -0.5),
        "final_norm": gain(ks[22], (D,)),
    }


def reference(x, c, ctx, c_ctx, ada_w, ada_b, norm1, norm2, ab_w_in, ab_q_norm, ab_w_uq, ab_kv_norm,
              ab_w_ukv, ab_w_o, c_w_in, c_q_gain, c_k_gain, c_w_o, moe_router, moe_w_gate, moe_w_up,
              moe_w_down, final_norm):
    B, S, D = x.shape
    rows = S // GRID_W
    row = jnp.repeat(jnp.arange(rows, dtype=jnp.float32), GRID_W)
    col = jnp.tile(jnp.arange(GRID_W, dtype=jnp.float32), rows)
    h_lat, h_ctx = x, ctx
    for i in range(DEPTH):
        last = i == DEPTH - 1
        mod_l = (jax.nn.silu(c) @ ada_w[i] + ada_b[i])[:, None, :]
        mod_c = jax.nn.silu(c_ctx) @ ada_w[i] + ada_b[i]
        sh1_l, sc1_l, g1_l, sh2_l, sc2_l, g2_l = jnp.split(mod_l, N_MOD, axis=-1)
        sh1_c, sc1_c, g1_c, sh2_c, sc2_c, g2_c = jnp.split(mod_c, N_MOD, axis=-1)
        a_l = modulate(h_lat, norm1[i], sh1_l, sc1_l)
        a_c = modulate(h_ctx, norm1[i], sh1_c, sc1_c)
        j = i // 2
        if i % 2 == 0:
            y_l, y_c = mixer_ab(a_l, a_c, ab_w_in[j], ab_q_norm[j], ab_w_uq[j], ab_kv_norm[j],
                                ab_w_ukv[j], ab_w_o[j], row, col, not last)
        else:
            y_l, y_c = mixer_c(a_l, a_c, c_w_in[j], c_q_gain[j], c_k_gain[j], c_w_o[j], row, col, not last)
        h_lat = h_lat + g1_l * y_l
        m_l = modulate(h_lat, norm2[i], sh2_l, sc2_l)
        h_lat = h_lat + g2_l * expert_choice_ffn(m_l, moe_router[i], moe_w_gate[i], moe_w_up[i], moe_w_down[i])
        if not last:
            h_ctx = h_ctx + g1_c * y_c
            m_c = modulate(h_ctx, norm2[i], sh2_c, sc2_c)
            h_ctx = h_ctx + g2_c * expert_choice_ffn(m_c, moe_router[i], moe_w_gate[i], moe_w_up[i], moe_w_down[i])
    return rms_norm(h_lat, final_norm)
```

```cpp
#include <hip/hip_runtime.h>
#include <cstdio>
#include <cstring>
#include <cstdint>

namespace nv {
__device__ __forceinline__ void sincos_acc(double x, float& s, float& c) {
  const double k = rint(x * 0.63661977236758134308);
  double r = fma(-k, 1.57079632679489655800e+00, x);
  r = fma(-k, 6.12323399573676603587e-17, r);
  const double r2 = r * r;
  double sp = 1.0 / 6227020800.0;
  sp = fma(sp, r2, -1.0 / 39916800.0);
  sp = fma(sp, r2, 1.0 / 362880.0);
  sp = fma(sp, r2, -1.0 / 5040.0);
  sp = fma(sp, r2, 1.0 / 120.0);
  sp = fma(sp, r2, -1.0 / 6.0);
  sp = fma(sp * r2, r, r);
  double cp = -1.0 / 87178291200.0;
  cp = fma(cp, r2, 1.0 / 479001600.0);
  cp = fma(cp, r2, -1.0 / 3628800.0);
  cp = fma(cp, r2, 1.0 / 40320.0);
  cp = fma(cp, r2, -1.0 / 720.0);
  cp = fma(cp, r2, 1.0 / 24.0);
  cp = fma(cp, r2, -0.5);
  cp = fma(cp, r2, 1.0);
  const int q = ((int)k) & 3;
  const double ss = (q == 0) ? sp : (q == 1) ? cp : (q == 2) ? -sp : -cp;
  const double cc = (q == 0) ? cp : (q == 1) ? -sp : (q == 2) ? -cp : sp;
  s = (float)ss; c = (float)cc;
}

}

#include <hip/hip_cooperative_groups.h>
namespace fk {
namespace cg = cooperative_groups;
#define LAS __attribute__((address_space(3)))
#define GAS __attribute__((address_space(1)))
typedef unsigned short bf16_t;
typedef short bf16x8 __attribute__((ext_vector_type(8)));
typedef short s16x4 __attribute__((ext_vector_type(4)));
typedef float f32x4 __attribute__((ext_vector_type(4)));
typedef float f32x2 __attribute__((ext_vector_type(2)));
typedef float f32x16 __attribute__((ext_vector_type(16)));
typedef unsigned u32x4 __attribute__((ext_vector_type(4)));
typedef unsigned u32x2 __attribute__((ext_vector_type(2)));

constexpr int D = 1024, NB = 2, S = 8192, L = 256, T = S + L, M = NB * T, MT = M / 256;
constexpr int NE = 16, FF = 2048, CAPL = 1024, CAPC = 32, PR = 2304;
constexpr float EPS = 1e-6f;
constexpr int NWAVES = 8, NTHR = 512;

constexpr size_t al256(size_t x) { return (x + 255) / 256 * 256; }
constexpr size_t WS_CTL = 0, CTL_BYTES = 1u << 20;
constexpr int CW_BAR = 1024;
constexpr int CW_MOD = 8192;
constexpr int CW_SSQ = CW_MOD + 36864;
constexpr int CW_CNT = CW_SSQ + 8 * M;
static_assert((CW_CNT + 48 * 64) * 4 <= (int)CTL_BYTES, "ctl");
constexpr size_t WS_WIN0 = CTL_BYTES;
constexpr size_t WS_WUQ = WS_WIN0 + (size_t)1024 * 1024 * 2;
constexpr size_t WS_WUKV = WS_WUQ + (size_t)768 * 256 * 2;
constexpr size_t WS_WDFT = WS_WUKV + (size_t)1024 * 256 * 2;
constexpr size_t WS_WO0 = WS_WDFT + (size_t)512 * 1024 * 2;
constexpr size_t WS_WIN1 = WS_WO0 + (size_t)1024 * 1024 * 2;
constexpr size_t WS_WO1 = WS_WIN1 + (size_t)1536 * 1024 * 2;
constexpr size_t WS_WGU = WS_WO1 + (size_t)1024 * 1024 * 2;
constexpr size_t WS_WD = WS_WGU + (size_t)2 * 16 * 4096 * 1024 * 2;
constexpr size_t WS_MODP = WS_WD + (size_t)2 * 16 * 1024 * 2048 * 2;
constexpr size_t WS_ROPEA = WS_MODP + (size_t)48 * 16 * 768 * 4;
constexpr size_t WS_ROPEC = WS_ROPEA + 128 * 8 * 8;
constexpr size_t WS_H = al256(WS_ROPEC + 128 * 32 * 8);
constexpr size_t WS_XN = WS_H + (size_t)M * D * 4;
constexpr size_t WS_XN8 = WS_XN + (size_t)M * D * 2;
constexpr size_t WS_P2 = WS_XN8 + (size_t)M * D;
constexpr size_t WS_FTL = WS_P2 + (size_t)M * 384 * 2;
constexpr size_t WS_FTC = WS_FTL + (size_t)2 * 128 * 8192 * 4 * 2;
constexpr size_t WS_YC = WS_FTC + (size_t)2 * 128 * 256 * 4 * 2;
constexpr size_t WS_AC = WS_YC + (size_t)M * D * 2;
constexpr size_t WS_Q = WS_AC + (size_t)M * D * 2;
constexpr size_t WS_K = WS_Q + (size_t)M * D * 2;
constexpr size_t WS_V = WS_K + (size_t)M * 768 * 2;
constexpr size_t WS_AFFL = WS_V + (size_t)M * 512 * 2;
constexpr size_t WS_AFFC = WS_AFFL + (size_t)2 * 16 * 8192 * 4;
constexpr size_t WS_IDX = WS_AFFC + (size_t)2 * 16 * 256 * 4;
constexpr size_t WS_GATE = WS_IDX + (size_t)16 * PR * 4;
constexpr size_t WS_INV = WS_GATE + (size_t)16 * PR * 4;
constexpr size_t WS_H1 = al256(WS_INV + (size_t)M * 16 * 4);
constexpr size_t WS_END = WS_H1 + (size_t)16 * PR * 2048 * 2;
constexpr size_t WS_QKR = WS_H1;
constexpr size_t WS_Y2 = WS_YC;
static_assert(WS_Y2 + (size_t)16 * PR * 1024 * 2 <= WS_K && (size_t)M * 1280 * 4 <= (size_t)16 * PR * 2048 * 2, "aliases");

constexpr int RING_BYTES = 131072;
constexpr int LDS_MISC = RING_BYTES;
constexpr int LDS_TAB = RING_BYTES + 1024;
constexpr int LDS_BYTES = 147456;

__device__ __forceinline__ unsigned cvt_pk_bf16(float lo, float hi) { unsigned r; asm volatile("v_cvt_pk_bf16_f32 %0, %1, %2" : "=v"(r) : "v"(lo), "v"(hi)); return r; }
__device__ __forceinline__ float bf2f(unsigned short b) { return __uint_as_float((unsigned)b << 16); }
__device__ __forceinline__ float bflo(unsigned w) { return __uint_as_float(w << 16); }
__device__ __forceinline__ float bfhi(unsigned w) { return __uint_as_float(w & 0xffff0000u); }
__device__ __forceinline__ float wave_sum(float v) {
#pragma unroll
  for (int o = 1; o < 64; o <<= 1) v += __shfl_xor(v, o);
  return v;
}
__device__ __forceinline__ float siluf(float x) { return x / (1.f + __expf(-x)); }
using nv::sincos_acc;

#define XB_TMO      128
#define XB_XCNT(j)  (256  + 64 * (j))
#define XB_XSUB(j)  (1280 + 64 * (j))
#define XB_XGEN(j)  (2304 + 64 * (j))
#define XB_TOP      3328
#define XB_TOPGEN   3392
#define XCD_BAR_WORDS 3456
#define XB_SPIN_CAP (1u << 20)
__device__ __forceinline__ unsigned xb_ld(unsigned* p)              { return __hip_atomic_load(p, __ATOMIC_RELAXED, __HIP_MEMORY_SCOPE_AGENT); }
__device__ __forceinline__ unsigned xb_add(unsigned* p, unsigned v) { return __hip_atomic_fetch_add(p, v, __ATOMIC_RELAXED, __HIP_MEMORY_SCOPE_AGENT); }
__device__ __forceinline__ unsigned xb_xcc_id() { return (unsigned)__builtin_amdgcn_s_getreg((3 << 11) | 20) & 0xFu; }
#define XB_SPIN(cond, bar) do { unsigned _sp = 0; while (cond) { __builtin_amdgcn_s_sleep(1); \
    if ((++_sp & 255u) == 0u) { if (xb_ld(&(bar)[XB_TMO])) break; if (_sp > XB_SPIN_CAP) { atomicAdd(&(bar)[XB_TMO], 1u); break; } } } } while (0)
struct XcdBarrier { unsigned* bar; unsigned x; volatile LAS unsigned* st; };
__device__ __forceinline__ XcdBarrier xcd_barrier_post(unsigned* bar, volatile LAS unsigned* st) {
  XcdBarrier b; b.bar = bar; b.x = xb_xcc_id(); b.st = st;
  if (threadIdx.x == 0) (void)xb_add(&bar[XB_XCNT(b.x)], 1u);
  return b;
}
__device__ __forceinline__ void xcd_barrier_complete(unsigned* bar, unsigned x, unsigned& nloc, unsigned& nx) {
  const unsigned G = gridDim.x * gridDim.y * gridDim.z;
  unsigned sum, cnt, mine, sp = 0u;
  for (;;) {
    sum = 0u; cnt = 0u; mine = 0u;
#pragma unroll
    for (unsigned j = 0; j < 16; ++j) { const unsigned c = xb_ld(&bar[XB_XCNT(j)]); sum += c; cnt += (c > 0u) ? 1u : 0u; mine = (j == x) ? c : mine; }
    if (sum == G) break;
    __builtin_amdgcn_s_sleep(1);
    if ((++sp & 255u) == 0u) { if (xb_ld(&bar[XB_TMO])) break; if (sp > XB_SPIN_CAP) { atomicAdd(&bar[XB_TMO], 1u); break; } }
  }
  nloc = mine > 0u ? mine : 1u; nx = cnt > 0u ? cnt : 1u;
}
__device__ __forceinline__ void xcd_barrier(const XcdBarrier& b) {
  asm volatile("s_waitcnt vmcnt(0)" ::: "memory");
  __syncthreads();
  if (threadIdx.x == 0) {
    unsigned* bar = b.bar;
    __builtin_amdgcn_s_waitcnt(0);
    unsigned nloc = b.st[0], nx = b.st[1];
    if (nloc == 0u) { xcd_barrier_complete(bar, b.x, nloc, nx); b.st[0] = nloc; b.st[1] = nx; }
    const unsigned old = xb_add(&bar[XB_XSUB(b.x)], 1u);
    const unsigned gen = old / nloc;
    if (old + 1u == (gen + 1u) * nloc) {
      __builtin_amdgcn_fence(__ATOMIC_RELEASE, "agent");
      asm volatile("s_waitcnt vmcnt(0)" ::: "memory");
      const unsigned og = xb_add(&bar[XB_TOP], 1u);
      const unsigned tg = og / nx;
      if (og + 1u == (tg + 1u) * nx) xb_add(&bar[XB_TOPGEN], 1u);
      else XB_SPIN(xb_ld(&bar[XB_TOPGEN]) == tg, bar);
      __builtin_amdgcn_fence(__ATOMIC_ACQUIRE, "agent");
      xb_add(&bar[XB_XGEN(b.x)], 1u);
      asm volatile("s_waitcnt vmcnt(0)" ::: "memory");
    } else {
      XB_SPIN(xb_ld(&bar[XB_XGEN(b.x)]) == gen, bar);
      __builtin_amdgcn_fence(__ATOMIC_ACQUIRE, "agent");
      asm volatile("s_waitcnt vmcnt(0)" ::: "memory");
    }
  }
  __syncthreads();
}

namespace pg8 {
typedef int v4i_t __attribute__((ext_vector_type(4)));
typedef int v8i_t __attribute__((ext_vector_type(8)));
constexpr int BM = 256, BK = 64, HALF = 128, HTB = HALF * BK * 2, STAGE_BYTES = 8 * HTB, NXCD = 8, WGM = 8;
__host__ __device__ __forceinline__ int lds_byte(int r, int c) { const int st = (r >> 4) * 2 + (c >> 5), rr = r & 15, cc = c & 31, ob = rr * 64 + cc * 2; return st * 1024 + (ob ^ (((ob >> 9) & 1) << 5)); }
__host__ __device__ __forceinline__ void stage_rc(int b, int& R, int& C) { const int st = b / 1024, sb = b % 1024, swz = sb ^ (((sb >> 9) & 1) << 5); R = (st >> 1) * 16 + swz / 64; C = (st & 1) * 32 + (swz % 64) / 2; }
__host__ __device__ __forceinline__ int perm32(int rho) { const int n = rho >> 4, i = rho & 15; return 8 * (i >> 2) + 4 * n + (i & 3); }

struct Unit { int pm, pn, z, ord; };

struct PlainSched {
  const char* A; const char* Bt; int lda, ldb;
  static constexpr int es = 2;
  int nM, nN, nwg, G, c, skipctx;
  __device__ __forceinline__ void init(const void* A_, int lda_, const void* Bt_, int ldb_, int Mrows, int Ncols, int G_, int c_, int skipctx_ = 0) {
    A = (const char*)A_; Bt = (const char*)Bt_; lda = lda_; ldb = ldb_; skipctx = skipctx_; nM = skipctx_ ? 64 : Mrows / BM; nN = Ncols / BM; nwg = nM * nN; G = G_; c = c_; }
  __device__ __forceinline__ bool next(int i, Unit& u) const {
    const long Lq = (long)i * G + c; if (Lq >= nwg) return false;
    int wgid = (int)Lq; { const int q = nwg / NXCD, r = nwg % NXCD, xcd = wgid % NXCD, off = wgid / NXCD; wgid = (xcd < r ? xcd * (q + 1) : r * (q + 1) + (xcd - r) * q) + off; }
    const int nig = WGM * nN, gid = wgid / nig, fm = gid * WGM, gsz = (nM - fm) < WGM ? (nM - fm) : WGM;
    u.pm = fm + ((wgid % nig) % gsz); u.pn = (wgid % nig) / gsz; u.z = 0; u.ord = i; if (skipctx) u.pm += 1 + (u.pm >= 32 ? 1 : 0); return true;
  }
  __device__ __forceinline__ const char* a_base(const Unit& u) const { return A + (size_t)u.pm * BM * lda * 2; }
  __device__ __forceinline__ const char* b_base(const Unit& u) const { return Bt + (size_t)u.pn * BM * ldb * 2; }
  __device__ __forceinline__ void a_off(const Unit&, const int (&R)[2], const int (&C)[2], unsigned (&o)[2][2]) const {
#pragma unroll
    for (int h = 0; h < 2; ++h)
#pragma unroll
      for (int i = 0; i < 2; ++i) o[h][i] = (unsigned)((h * HALF + R[i]) * lda + C[i]) * 2u;
  }
};
struct QKVSched {
  static constexpr int es = 2;
  const char* A; const char* Bq; const char* Bkv; int lda, ldb, G, c;
  __device__ __forceinline__ void init(const void* P2, const void* Wq, const void* Wkv, int G_, int c_) { A = (const char*)P2; Bq = (const char*)Wq; Bkv = (const char*)Wkv; lda = 384; ldb = 256; G = G_; c = c_; }
  __device__ __forceinline__ bool next(int i, Unit& u) const {
    const int q = i * G + c; if (q >= 462) return false;
    if (q < 198) { u.z = 0; u.pm = q % 66; u.pn = q / 66; } else { const int r = q - 198; u.z = 1; u.pm = r % 66; u.pn = r / 66; }
    u.ord = i; return true;
  }
  __device__ __forceinline__ const char* a_base(const Unit& u) const { return A + (u.z ? 256 : 0) + (size_t)u.pm * BM * lda * 2; }
  __device__ __forceinline__ const char* b_base(const Unit& u) const { return (u.z ? Bkv : Bq) + (size_t)u.pn * BM * ldb * 2; }
  __device__ __forceinline__ void a_off(const Unit&, const int (&R)[2], const int (&C)[2], unsigned (&o)[2][2]) const {
#pragma unroll
    for (int h = 0; h < 2; ++h)
#pragma unroll
      for (int i = 0; i < 2; ++i) o[h][i] = (unsigned)((h * HALF + R[i]) * lda + C[i]) * 2u;
  }
};
template <bool GATHER, int ES> struct MoeSched {
  static constexpr int es = ES;
  const char* A; const char* Bt; int lda, ldb; size_t a_zstride, b_zstride;
  const int* idx;
  const LAS int* lidx;
  int TM, nN, per_x, vloc, xcd;
  __device__ __forceinline__ void init(const void* A_, int lda_, size_t azs, const void* Bt_, int ldb_, size_t bzs, const int* idx_, int TM_, int nN_, int G, int c) {
    A = (const char*)A_; Bt = (const char*)Bt_; lda = lda_; ldb = ldb_; a_zstride = azs; b_zstride = bzs; idx = idx_; TM = TM_; nN = nN_;
    xcd = c % 8; vloc = c / 8; per_x = 2 * TM * nN; (void)G; }
  __device__ __forceinline__ void stage_idx(LAS int* dst) {
    lidx = dst; Unit u;
    for (int i = 0; next(i, u); ++i) for (int r = threadIdx.x; r < BM; r += NTHR) dst[i * BM + r] = idx[u.z * PR + u.pm * BM + r];
    __syncthreads();
  }
  __device__ __forceinline__ bool next(int i, Unit& u) const {
    const int q = i * 32 + vloc; if (q >= per_x) return false;
    u.pm = q % TM; u.pn = (q / TM) % nN; u.z = xcd * 2 + q / (TM * nN); u.ord = i; return true;
  }
  __device__ __forceinline__ const char* a_base(const Unit& u) const { return GATHER ? A : A + (size_t)u.z * a_zstride + (size_t)u.pm * BM * lda * ES; }
  __device__ __forceinline__ const char* b_base(const Unit& u) const { return Bt + (size_t)u.z * b_zstride + (size_t)u.pn * BM * ldb * ES; }
  __device__ __forceinline__ void a_off(const Unit& u, const int (&R)[2], const int (&C)[2], unsigned (&o)[2][2]) const {
#pragma unroll
    for (int h = 0; h < 2; ++h)
#pragma unroll
      for (int i = 0; i < 2; ++i) {
        if (GATHER) { const int row = lidx[u.ord * BM + h * HALF + R[i]]; o[h][i] = (unsigned)(row * lda * ES + C[i] * 2); }
        else o[h][i] = (unsigned)((h * HALF + R[i]) * lda * ES + C[i] * 2);
      }
  }
};

template <class Epi, class Sched>
__device__ __forceinline__ void gemm_phase(LAS unsigned char* lds, const int K, const Sched& S, const Epi& E) {
  constexpr int ES = Sched::es; constexpr bool FP8 = ES == 1;
  const int tid = threadIdx.x, wid = __builtin_amdgcn_readfirstlane(tid >> 6), lane = tid & 63, wr = wid >> 2, wc = wid & 3, fr = lane & 15, fq = lane >> 4;
  const int nt = K * ES / (BK * 2);
  int RA[2], CA[2]; unsigned voffB[2];
#pragma unroll
  for (int i = 0; i < 2; ++i) { int R, C; stage_rc(tid * 16 + i * 8192, R, C); const int Rb = (R & ~31) + perm32(R & 31);
    RA[i] = R; CA[i] = C; voffB[i] = (unsigned)(Rb * S.ldb * ES + C * 2); }
  const size_t kstep = (size_t)(BK * 2);
  const size_t hstepB = (size_t)HALF * S.ldb * ES;
  const unsigned ldsw = (unsigned)wid * 1024u;
  const int aoff = lds_byte(wr * 64 + fr, fq * 8), boff = lds_byte(wc * 32 + fr, fq * 8);
#define PG8_SA(b, h) (((b) * 2 + (h)) * HTB)
#define PG8_SB(b, h) ((4 + (b) * 2 + (h)) * HTB)
#define PG8_STAGE2(bufoff, gbase, v0, v1) do { \
    __builtin_amdgcn_global_load_lds((const unsigned*)((const char*)(gbase) + (v0)), (LAS unsigned*)(lds + (bufoff) + ldsw), 16, 0, 0); \
    __builtin_amdgcn_global_load_lds((const unsigned*)((const char*)(gbase) + (v1)), (LAS unsigned*)(lds + (bufoff) + ldsw + 8192), 16, 0, 0); } while (0)
#define PG8_STAGEB(bufoff, gbase) PG8_STAGE2(bufoff, gbase, voffB[0], voffB[1])
#define PG8_LDA(dst, b, h) do { if constexpr (FP8) { _Pragma("unroll") for (int m = 0; m < 4; ++m) { const v4i_t lo_ = *(const LAS v4i_t*)(lds + PG8_SA(b, h) + aoff + m * 2048), hi_ = *(const LAS v4i_t*)(lds + PG8_SA(b, h) + aoff + m * 2048 + 1024); dst##8[m] = __builtin_shufflevector(lo_, hi_, 0, 1, 2, 3, 4, 5, 6, 7); } } \
    else { _Pragma("unroll") for (int m = 0; m < 4; ++m) _Pragma("unroll") for (int k = 0; k < 2; ++k) dst[m][k] = *(const LAS bf16x8*)(lds + PG8_SA(b, h) + aoff + m * 2048 + k * 1024); } } while (0)
#define PG8_LDB(dst, b, h) do { if constexpr (FP8) { _Pragma("unroll") for (int n = 0; n < 2; ++n) { const v4i_t lo_ = *(const LAS v4i_t*)(lds + PG8_SB(b, h) + boff + n * 2048), hi_ = *(const LAS v4i_t*)(lds + PG8_SB(b, h) + boff + n * 2048 + 1024); dst##8[n] = __builtin_shufflevector(lo_, hi_, 0, 1, 2, 3, 4, 5, 6, 7); } } \
    else { _Pragma("unroll") for (int n = 0; n < 2; ++n) _Pragma("unroll") for (int k = 0; k < 2; ++k) dst[n][k] = *(const LAS bf16x8*)(lds + PG8_SB(b, h) + boff + n * 2048 + k * 1024); } } while (0)
#define PG8_CAT(x, y) __builtin_shufflevector(__builtin_bit_cast(v4i_t, x), __builtin_bit_cast(v4i_t, y), 0, 1, 2, 3, 4, 5, 6, 7)
#define PG8_MMA(ai, bj, At, Bt) do { __builtin_amdgcn_s_setprio(1); \
    if constexpr (FP8) { _Pragma("unroll") for (int m = 0; m < 4; ++m) _Pragma("unroll") for (int n = 0; n < 2; ++n) \
        asm volatile("v_mfma_scale_f32_16x16x128_f8f6f4 %0, %1, %2, %0, %3, %3 op_sel_hi:[0,0,0]" : "+v"(acc[ai][bj][m][n]) : "v"(Bt##8[n]), "v"(At##8[m]), "v"(scl8)); } \
    else { _Pragma("unroll") for (int m = 0; m < 4; ++m) _Pragma("unroll") for (int n = 0; n < 2; ++n) _Pragma("unroll") for (int k = 0; k < 2; ++k) \
        acc[ai][bj][m][n] = __builtin_amdgcn_mfma_f32_16x16x32_bf16(Bt[n][k], At[m][k], acc[ai][bj][m][n], 0, 0, 0); } \
    __builtin_amdgcn_s_setprio(0); } while (0)
#define PG8_WAIT_V(n) asm volatile("s_waitcnt vmcnt(" #n ")" ::: "memory")
#define PG8_WAIT_L(n) asm volatile("s_waitcnt lgkmcnt(" #n ")" ::: "memory")
#define PG8_BAR __builtin_amdgcn_s_barrier()
#define PG8_SCHED __builtin_amdgcn_sched_barrier(0)
  Unit cur, nxt; int ui = 0;
  if (!S.next(0, cur)) return;
  f32x4 acc[2][2][4][2];
#pragma unroll
  for (int a = 0; a < 2; ++a)
#pragma unroll
    for (int b = 0; b < 2; ++b)
#pragma unroll
      for (int m = 0; m < 4; ++m)
#pragma unroll
        for (int n = 0; n < 2; ++n) acc[a][b][m][n] = (f32x4){0.f, 0.f, 0.f, 0.f};
  bf16x8 At[4][2], B0[2][2], B1[2][2]; v8i_t At8[4], B08[2], B18[2];
  int scl8 = 0x7f7f7f7f; asm volatile("" : "+v"(scl8));
  const char* cA = S.a_base(cur); const char* cB = S.b_base(cur);
  unsigned oC[2][2], oN[2][2];
  S.a_off(cur, RA, CA, oC);
  PG8_STAGEB(PG8_SB(0, 0), cB); PG8_STAGEB(PG8_SB(0, 1), cB + hstepB); PG8_STAGE2(PG8_SA(0, 0), cA, oC[0][0], oC[0][1]); PG8_STAGE2(PG8_SA(0, 1), cA, oC[1][0], oC[1][1]);
  if (wr == 1) PG8_BAR;
  PG8_WAIT_V(2); PG8_BAR;
  PG8_STAGEB(PG8_SB(1, 0), cB + kstep); PG8_STAGE2(PG8_SA(1, 0), cA + kstep, oC[0][0], oC[0][1]); PG8_STAGEB(PG8_SB(1, 1), cB + hstepB + kstep);
  PG8_WAIT_V(6); PG8_BAR;
  for (;;) {
    const bool has_next = S.next(ui + 1, nxt);
    const char* nA = has_next ? S.a_base(nxt) : cA; const char* nB = has_next ? S.b_base(nxt) : cB;
    if (has_next) S.a_off(nxt, RA, CA, oN);
    else {
#pragma unroll
      for (int h = 0; h < 2; ++h)
#pragma unroll
        for (int i = 0; i < 2; ++i) oN[h][i] = oC[h][i];
    }
#pragma unroll 1
    for (int t = 0; t < nt; t += 2) {
      const bool last = (t == nt - 2);
      const char* a1 = cA + (size_t)(t + 1) * kstep;
      const char* a2 = last ? nA : cA + (size_t)(t + 2) * kstep; const char* b2 = last ? nB : cB + (size_t)(t + 2) * kstep;
      const char* a3 = a2 + kstep; const char* b3 = b2 + kstep;
      const unsigned x00 = last ? oN[0][0] : oC[0][0], x01 = last ? oN[0][1] : oC[0][1], x10 = last ? oN[1][0] : oC[1][0], x11 = last ? oN[1][1] : oC[1][1];
      PG8_LDB(B0, 0, 0); PG8_LDB(B1, 0, 1); PG8_SCHED; PG8_LDA(At, 0, 0); PG8_STAGE2(PG8_SA(1, 1), a1, oC[1][0], oC[1][1]);
      PG8_WAIT_V(8); PG8_WAIT_L(0); PG8_BAR; PG8_MMA(0, 0, At, B0); PG8_MMA(0, 1, At, B1); PG8_BAR; PG8_SCHED;
      PG8_LDA(At, 0, 1); PG8_STAGEB(PG8_SB(0, 0), b2); PG8_STAGEB(PG8_SB(0, 1), b2 + hstepB); PG8_STAGE2(PG8_SA(0, 0), a2, x00, x01);
      PG8_WAIT_V(8); PG8_WAIT_L(0); PG8_BAR; PG8_MMA(1, 0, At, B0); PG8_MMA(1, 1, At, B1); PG8_BAR; PG8_SCHED;
      PG8_LDB(B0, 1, 0); PG8_LDB(B1, 1, 1); PG8_SCHED; PG8_LDA(At, 1, 0); PG8_STAGE2(PG8_SA(0, 1), a2, x10, x11);
      PG8_WAIT_V(8); PG8_WAIT_L(0); PG8_BAR; PG8_MMA(0, 0, At, B0); PG8_MMA(0, 1, At, B1); PG8_BAR; PG8_SCHED;
      PG8_LDA(At, 1, 1); PG8_STAGEB(PG8_SB(1, 0), b3); PG8_STAGEB(PG8_SB(1, 1), b3 + hstepB); PG8_STAGE2(PG8_SA(1, 0), a3, x00, x01);
      PG8_WAIT_V(8); PG8_WAIT_L(0); PG8_BAR; PG8_MMA(1, 0, At, B0); PG8_MMA(1, 1, At, B1); PG8_BAR; PG8_SCHED;
    }
    if constexpr (FP8) {
#pragma unroll
      for (int a = 0; a < 2; ++a)
#pragma unroll
        for (int b = 0; b < 2; ++b)
          asm volatile("s_nop 15\n\ts_nop 15" : "+v"(acc[a][b][0][0]), "+v"(acc[a][b][0][1]), "+v"(acc[a][b][1][0]), "+v"(acc[a][b][1][1]), "+v"(acc[a][b][2][0]), "+v"(acc[a][b][2][1]), "+v"(acc[a][b][3][0]), "+v"(acc[a][b][3][1]));
    }
    if (wr == 0) PG8_BAR;
    E(acc, cur, wr, wc, fr, fq);
#ifdef EXP_EPI2
    if constexpr (FP8) E(acc, cur, wr, wc, fr, fq);
#endif
    if (!has_next) break;
#pragma unroll
    for (int a = 0; a < 2; ++a)
#pragma unroll
      for (int b = 0; b < 2; ++b)
#pragma unroll
        for (int m = 0; m < 4; ++m)
#pragma unroll
          for (int n = 0; n < 2; ++n) acc[a][b][m][n] = (f32x4){0.f, 0.f, 0.f, 0.f};
    cur = nxt; cA = nA; cB = nB; ++ui;
#pragma unroll
    for (int h = 0; h < 2; ++h)
#pragma unroll
      for (int i = 0; i < 2; ++i) oC[h][i] = oN[h][i];
    if (wr == 1) PG8_BAR;
  }
  PG8_WAIT_V(0);
  PG8_BAR;
#undef PG8_SA
#undef PG8_SB
#undef PG8_STAGE2
#undef PG8_STAGEB
#undef PG8_LDA
#undef PG8_LDB
#undef PG8_MMA
#undef PG8_CAT
#undef PG8_WAIT_V
#undef PG8_WAIT_L
#undef PG8_BAR
#undef PG8_SCHED
}
}

typedef f32x4 AccT[2][2][4][2];
__device__ __forceinline__ u32x4 pack8(const f32x4 a, const f32x4 b) { u32x4 w; w.x = cvt_pk_bf16(a[0], a[1]); w.y = cvt_pk_bf16(a[2], a[3]); w.z = cvt_pk_bf16(b[0], b[1]); w.w = cvt_pk_bf16(b[2], b[3]); return w; }
__device__ __forceinline__ float clamp448(float x) { return __builtin_amdgcn_fmed3f(x, -448.f, 448.f); }
__device__ __forceinline__ unsigned pack4_fp8(float a, float b, float c, float d) {
  int w = 0; w = __builtin_amdgcn_cvt_pk_fp8_f32(clamp448(a), clamp448(b), w, false); w = __builtin_amdgcn_cvt_pk_fp8_f32(clamp448(c), clamp448(d), w, true); return (unsigned)w; }
__device__ __forceinline__ u32x2 pack8_fp8(const f32x4 a, const f32x4 b) { u32x2 w; w.x = pack4_fp8(a[0], a[1], a[2], a[3]); w.y = pack4_fp8(b[0], b[1], b[2], b[3]); return w; }
constexpr float W8_SCALE = 32.f, H8_SCALE = 4.f;
__device__ __forceinline__ void rope8(f32x4& v0, f32x4& v1, int fq, int prow, int pcol, const f32x2* tab) {
  const f32x2* tp = tab + (fq < 2 ? prow : pcol) * 8;
#pragma unroll
  for (int n = 0; n < 2; ++n)
#pragma unroll
    for (int j = 0; j < 4; ++j) {
      const float x = n == 0 ? v0[j] : v1[j];
      const float p = __shfl_xor(x, 16);
      const f32x2 cs = tp[4 * n + j];
      const float o = (fq & 1) ? (p * cs.y + x * cs.x) : (x * cs.x - p * cs.y);
      if (n == 0) v0[j] = o; else v1[j] = o;
    }
}
struct EpiInProj0 {
  bf16_t* FTL; bf16_t* FTC; bf16_t* P2; bf16_t* Kb; float* ssq; const f32x2* ropeA;
  __device__ __forceinline__ void operator()(const AccT& acc, const pg8::Unit& u, int wr, int wc, int fr, int fq) const {
    const int b = u.pm / 33; const bool isctx = (u.pm % 33) == 0;
#pragma unroll
    for (int ai = 0; ai < 2; ++ai)
#pragma unroll
      for (int m = 0; m < 4; ++m) {
        const int row = u.pm * 256 + ai * 128 + wr * 64 + m * 16 + fr, i = row - b * T;
        if (u.pn < 2) {
#pragma unroll
          for (int bj = 0; bj < 2; ++bj) {
            const int c0 = u.pn * 256 + bj * 128 + wc * 32 + 8 * fq, cb = c0 >> 2;
            const f32x4 v0 = acc[ai][bj][m][0], v1 = acc[ai][bj][m][1];
            u32x2 w0, w1; w0.x = cvt_pk_bf16(v0[0], v0[1]); w0.y = cvt_pk_bf16(v0[2], v0[3]); w1.x = cvt_pk_bf16(v1[0], v1[1]); w1.y = cvt_pk_bf16(v1[2], v1[3]);
            bf16_t* d = isctx ? FTC + ((size_t)(b * 128 + cb) * 256 + i) * 4 : FTL + ((size_t)(b * 128 + cb) * 8192 + (i - 256)) * 4;
            *(u32x2*)d = w0; *(u32x2*)(d + (isctx ? 256 * 4 : 8192 * 4)) = w1;
          }
        } else if (u.pn == 2) {
          float ss = 0.f;
#pragma unroll
          for (int bj = 0; bj < 2; ++bj) {
            const f32x4 v0 = acc[ai][bj][m][0], v1 = acc[ai][bj][m][1];
            ss += (v0[0] * v0[0] + v0[1] * v0[1]) + (v0[2] * v0[2] + v0[3] * v0[3]) + (v1[0] * v1[0] + v1[1] * v1[1]) + (v1[2] * v1[2] + v1[3] * v1[3]);
            *(u32x4*)(P2 + (size_t)row * 384 + bj * 128 + wc * 32 + 8 * fq) = pack8(v0, v1);
          }
          ss += __shfl_xor(ss, 16); ss += __shfl_xor(ss, 32);
          if (fq == 0) ssq[row * 8 + wc] = ss;
        } else {
          { const f32x4 v0 = acc[ai][0][m][0], v1 = acc[ai][0][m][1];
            float ss = (v0[0] * v0[0] + v0[1] * v0[1]) + (v0[2] * v0[2] + v0[3] * v0[3]) + (v1[0] * v1[0] + v1[1] * v1[1]) + (v1[2] * v1[2] + v1[3] * v1[3]);
            *(u32x4*)(P2 + (size_t)row * 384 + 256 + wc * 32 + 8 * fq) = pack8(v0, v1);
            ss += __shfl_xor(ss, 16); ss += __shfl_xor(ss, 32);
            if (fq == 0) ssq[row * 8 + 4 + wc] = ss; }
          if (wc == 0) {
            f32x4 v0 = acc[ai][1][m][0], v1 = acc[ai][1][m][1];
            if (!isctx) { const int s = i - 256; rope8(v0, v1, fq, s >> 6, s & 63, ropeA); }
            const u32x4 w = pack8(v0, v1);
#pragma unroll
            for (int h = 0; h < 8; ++h) *(u32x4*)(Kb + (size_t)row * 768 + h * 96 + 64 + 8 * fq) = w;
          }
        }
      }
  }
};
struct EpiQ {
  bf16_t* Q; const float* ssq; const f32x2* ropeA;
  __device__ __forceinline__ void operator()(const AccT& acc, const pg8::Unit& u, int wr, int wc, int fr, int fq) const {
    const int b = u.pm / 33; const bool isctx = (u.pm % 33) == 0;
#pragma unroll
    for (int ai = 0; ai < 2; ++ai)
#pragma unroll
      for (int m = 0; m < 4; ++m) {
        const int row = u.pm * 256 + ai * 128 + wr * 64 + m * 16 + fr, i = row - b * T, s = i - 256;
        const f32x4 s4 = *(const f32x4*)(ssq + row * 8); const float rstd = rsqrtf(((s4[0] + s4[1]) + (s4[2] + s4[3])) * (1.f / 256.f) + EPS);
#pragma unroll
        for (int bj = 0; bj < 2; ++bj) {
          const int g32 = u.pn * 8 + bj * 4 + wc;
          f32x4 v0 = acc[ai][bj][m][0] * rstd, v1 = acc[ai][bj][m][1] * rstd;
          if ((g32 % 3) == 2 && !isctx) rope8(v0, v1, fq, s >> 6, s & 63, ropeA);
          *(u32x4*)(Q + (size_t)row * 768 + g32 * 32 + 8 * fq) = pack8(v0, v1);
          asm volatile("" ::: "memory");
        }
      }
  }
};
struct EpiKV {
  bf16_t* Kb; bf16_t* Vb; const float* ssq;
  __device__ __forceinline__ void operator()(const AccT& acc, const pg8::Unit& u, int wr, int wc, int fr, int fq) const {
#pragma unroll
    for (int ai = 0; ai < 2; ++ai)
#pragma unroll
      for (int m = 0; m < 4; ++m) {
        const int row = u.pm * 256 + ai * 128 + wr * 64 + m * 16 + fr;
        const f32x4 s4 = *(const f32x4*)(ssq + row * 8 + 4); const float rstd = rsqrtf(((s4[0] + s4[1]) + (s4[2] + s4[3])) * (1.f / 128.f) + EPS);
#pragma unroll
        for (int bj = 0; bj < 2; ++bj) {
          const int head = u.pn * 2 + bj, d = wc * 32 + 8 * fq;
          const u32x4 w = pack8(acc[ai][bj][m][0] * rstd, acc[ai][bj][m][1] * rstd);
          if (wc < 2) *(u32x4*)(Kb + (size_t)row * 768 + head * 96 + d) = w; else *(u32x4*)(Vb + (size_t)row * 512 + head * 64 + (d - 64)) = w;
        }
        asm volatile("" ::: "memory");
      }
  }
};
struct EpiQKV { EpiQ q; EpiKV kv;
  __device__ __forceinline__ void operator()(const AccT& acc, const pg8::Unit& u, int wr, int wc, int fr, int fq) const { if (u.z == 0) q(acc, u, wr, wc, fr, fq); else kv(acc, u, wr, wc, fr, fq); } };
struct EpiBf16 {
  bf16_t* O; int ldo;
  __device__ __forceinline__ void operator()(const AccT& acc, const pg8::Unit& u, int wr, int wc, int fr, int fq) const {
#pragma unroll
    for (int ai = 0; ai < 2; ++ai)
#pragma unroll
      for (int m = 0; m < 4; ++m) {
        const size_t row = (size_t)u.pm * 256 + ai * 128 + wr * 64 + m * 16 + fr;
#pragma unroll
        for (int bj = 0; bj < 2; ++bj) *(u32x4*)(O + row * ldo + u.pn * 256 + bj * 128 + wc * 32 + 8 * fq) = pack8(acc[ai][bj][m][0], acc[ai][bj][m][1]);
      }
  }
};
template <bool FIRST> struct EpiResid {
  float* H; const float* modl; const float* x; const float* ctx;
  __device__ __forceinline__ void operator()(const AccT& acc, const pg8::Unit& u, int wr, int wc, int fr, int fq) const {
    const int b = u.pm / 33, pt = u.pm % 33; const bool isctx = pt == 0;
    const float* g1 = modl + (isctx ? 2 : b) * 6144 + 2048;
    const float* src = FIRST ? (isctx ? ctx + (size_t)b * L * D : x + ((size_t)b * S + (size_t)(pt - 1) * 256) * D) : H + (size_t)u.pm * 256 * D;
#pragma unroll
    for (int bj = 0; bj < 2; ++bj) {
      const int c0 = u.pn * 256 + bj * 128 + wc * 32 + 8 * fq;
      const f32x4 ga = *(const f32x4*)(g1 + c0), gb = *(const f32x4*)(g1 + c0 + 4);
#pragma unroll
      for (int ai = 0; ai < 2; ++ai)
#pragma unroll
        for (int m = 0; m < 4; ++m) {
          const size_t ro = (size_t)(ai * 128 + wr * 64 + m * 16 + fr) * D + c0;
          const float* sp = src + ro; float* hp = H + (size_t)u.pm * 256 * D + ro;
          const f32x4 h0 = *(const f32x4*)sp, h1 = *(const f32x4*)(sp + 4);
          *(f32x4*)hp = h0 + ga * acc[ai][bj][m][0]; *(f32x4*)(hp + 4) = h1 + gb * acc[ai][bj][m][1];
        }
    }
  }
};
template <bool F8> struct EpiGateUp {
  void* H1;
  __device__ __forceinline__ void operator()(const AccT& acc, const pg8::Unit& u, int wr, int wc, int fr, int fq) const {
    constexpr float ws = F8 ? 1.f / W8_SCALE : 1.f, hs = F8 ? H8_SCALE : 1.f;
#pragma unroll
    for (int ai = 0; ai < 2; ++ai)
#pragma unroll
      for (int m = 0; m < 4; ++m) {
        const size_t prow = (size_t)u.z * PR + u.pm * 256 + ai * 128 + wr * 64 + m * 16 + fr;
        f32x4 o0, o1;
#pragma unroll
        for (int j = 0; j < 4; ++j) { o0[j] = siluf(acc[ai][0][m][0][j] * ws) * (acc[ai][1][m][0][j] * (ws * hs)); o1[j] = siluf(acc[ai][0][m][1][j] * ws) * (acc[ai][1][m][1][j] * (ws * hs)); }
        const size_t off = prow * FF + u.pn * 128 + wc * 32 + 8 * fq;
        if constexpr (F8) *(u32x2*)((unsigned char*)H1 + off) = pack8_fp8(o0, o1); else *(u32x4*)((bf16_t*)H1 + off) = pack8(o0, o1);
      }
  }
};
template <bool F8> struct EpiDown {
  bf16_t* Y2;
  __device__ __forceinline__ void operator()(const AccT& acc, const pg8::Unit& u, int wr, int wc, int fr, int fq) const {
    constexpr float sc = F8 ? 1.f / (W8_SCALE * H8_SCALE) : 1.f;
#pragma unroll
    for (int ai = 0; ai < 2; ++ai)
#pragma unroll
      for (int m = 0; m < 4; ++m) {
        const size_t prow = (size_t)u.z * PR + u.pm * 256 + ai * 128 + wr * 64 + m * 16 + fr;
#pragma unroll
        for (int bj = 0; bj < 2; ++bj) *(u32x4*)(Y2 + prow * D + u.pn * 256 + bj * 128 + wc * 32 + 8 * fq) = pack8(acc[ai][bj][m][0] * sc, acc[ai][bj][m][1] * sc);
      }
  }
};
struct EpiInProj1 {
  bf16_t* QKR; bf16_t* Vb;
  __device__ __forceinline__ void operator()(const AccT& acc, const pg8::Unit& u, int wr, int wc, int fr, int fq) const {
#pragma unroll
    for (int ai = 0; ai < 2; ++ai)
#pragma unroll
      for (int m = 0; m < 4; ++m) {
        const size_t row = (size_t)u.pm * 256 + ai * 128 + wr * 64 + m * 16 + fr;
#pragma unroll
        for (int bj = 0; bj < 2; ++bj) {
          const int c0 = u.pn * 256 + bj * 128 + wc * 32 + 8 * fq;
          if (u.pn < 5) *(u32x4*)(QKR + row * 1280 + c0) = pack8(acc[ai][bj][m][0], acc[ai][bj][m][1]);
          else *(u32x4*)(Vb + row * 256 + (c0 - 1280)) = pack8(acc[ai][bj][m][0], acc[ai][bj][m][1]);
        }
      }
  }
};

__device__ __forceinline__ f32x2 cmul(f32x2 a, f32x2 b) { return (f32x2){a.x * b.x - a.y * b.y, a.x * b.y + a.y * b.x}; }
template <int N, int LOGN>
__device__ __forceinline__ void fft_item(LAS f32x2* d, const LAS f32x2* T1, const LAS f32x2* T2, const bf16_t* src, bf16_t* yc_row0, int kcol, float norm, int tid) {
  for (int c = tid; c < N / 2; c += NTHR) {
    const u32x4 w = *(const u32x4*)(src + (size_t)c * 8);
    *(LAS f32x4*)(d + 2 * c) = (f32x4){bflo(w.x), bfhi(w.x), bflo(w.z), bfhi(w.z)};
    *(LAS f32x4*)(d + N + 2 * c) = (f32x4){bflo(w.y), bfhi(w.y), bflo(w.w), bfhi(w.w)};
  }
  __syncthreads();
#pragma unroll 1
  for (int h = N / 2; h >= 2; h >>= 2) {
    const int hh = h >> 1, tmul = 4096 / h;
    for (int q = tid; q < N / 2; q += NTHR) {
      const int seq = q >= (N / 4) ? 1 : 0, qq = q & (N / 4 - 1);
      const int pos = qq & (hh - 1), i0 = seq * N + ((qq - pos) << 2) + pos;
      const f32x2 x0 = d[i0], x1 = d[i0 + hh], x2 = d[i0 + h], x3 = d[i0 + h + hh];
      const int tw = pos * tmul;
      const f32x2 w1 = cmul(T2[tw >> 6], T1[tw & 63]);
      const f32x2 w2 = (f32x2){w1.x * w1.x - w1.y * w1.y, 2.f * w1.x * w1.y};
      const f32x2 a0 = x0 + x2, a2 = cmul(x0 - x2, w1), a1 = x1 + x3, t3 = cmul(x1 - x3, w1), a3 = (f32x2){t3.y, -t3.x};
      d[i0] = a0 + a1; d[i0 + hh] = cmul(a0 - a1, w2); d[i0 + h] = a2 + a3; d[i0 + h + hh] = cmul(a2 - a3, w2);
    }
    __syncthreads();
  }
  if ((LOGN & 1) == 1) {
    for (int j = tid; j < N; j += NTHR) { const int seq = j >= (N / 2) ? 1 : 0, jj = j & (N / 2 - 1), i0 = seq * N + 2 * jj; const f32x2 a = d[i0], bb = d[i0 + 1]; d[i0] = a + bb; d[i0 + 1] = a - bb; }
    __syncthreads();
  }
  for (int m = tid; m < N; m += NTHR) {
    const int k = (int)(__brev((unsigned)m) >> (32 - LOGN)), km = (N - k) & (N - 1), mp = (int)(__brev((unsigned)km) >> (32 - LOGN));
    const f32x2 A0 = d[m], B0 = d[mp], A1 = d[N + m], B1 = d[N + mp];
    const float hn = 0.5f * norm;
    u32x4 w;
    w.x = cvt_pk_bf16((A0.x + B0.x) * hn, (A0.y - B0.y) * hn);
    w.y = cvt_pk_bf16((A0.y + B0.y) * hn, (B0.x - A0.x) * hn);
    w.z = cvt_pk_bf16((A1.x + B1.x) * hn, (A1.y - B1.y) * hn);
    w.w = cvt_pk_bf16((A1.y + B1.y) * hn, (B1.x - A1.x) * hn);
    *(u32x4*)(yc_row0 + (size_t)k * D + kcol) = w;
  }
  __syncthreads();
}
__device__ __forceinline__ void fft_phase(LAS unsigned char* lds, const bf16_t* FTL, const bf16_t* FTC, bf16_t* YC, int G) {
  const int tid = threadIdx.x;
  LAS f32x2* d = (LAS f32x2*)lds; LAS f32x2* T1 = (LAS f32x2*)(lds + LDS_TAB); LAS f32x2* T2 = T1 + 64;
  if (tid < 128) { const int j = tid & 63; float s, c; sincos_acc(6.283185307179586476925 * (double)(tid < 64 ? j : 64 * j) / 8192.0, s, c); (tid < 64 ? T1 : T2)[j] = (f32x2){c, -s}; }
  __syncthreads();
  for (int it = blockIdx.x; it < 256; it += G) {
    const int b = it >> 7, cb = it & 127, kcol = (cb >> 5) * 256 + (cb & 31) * 8;
    fft_item<8192, 13>(d, T1, T2, FTL + (size_t)(b * 128 + cb) * 8192 * 4, YC + ((size_t)b * T + 256) * D, kcol, 1.0f / 1024.0f, tid);
    fft_item<256, 8>(d, T1, T2, FTC + (size_t)(b * 128 + cb) * 256 * 4, YC + ((size_t)b * T) * D, kcol, 0.0055242717280199f  , tid);
  }
}

#ifndef ATT3_PLAIN
#define ATT3_PLAIN 4
#endif
namespace att {
constexpr int NW = 8, QBLK = 32, KVBLK = 64;
constexpr size_t SHM_V = KVBLK * 128 * 2, SHM_K = KVBLK * 128 * 2;
#define KSWZ(row, colB) ((row) * 256 + ((colB) ^ (((row) & 7) << 4)))
#define SBAR() __builtin_amdgcn_sched_barrier(0)
__device__ __forceinline__ int crow(int r, int hi) { return (r & 3) + 8 * (r >> 2) + 4 * hi; }
template <int CSCALE_NUM> struct Dummy {};
__device__ __forceinline__ void partialSM(f32x16& p0, f32x16& p1, float& m_reg, float& mn, float& alpha, const float C, const float THRS) {
  float pmax = p0[0];
#pragma unroll
  for (int r = 1; r < 16; ++r) pmax = fmaxf(pmax, p0[r]);
#pragma unroll
  for (int r = 0; r < 16; ++r) pmax = fmaxf(pmax, p1[r]);
  { auto rr = __builtin_amdgcn_permlane32_swap(__float_as_uint(pmax), __float_as_uint(pmax), false, false);
    pmax = fmaxf(__uint_as_float(rr[0]), __uint_as_float(rr[1])); }
  if (__builtin_expect(__all(pmax - m_reg <= THRS), 1)) { mn = m_reg; alpha = 1.f; }
  else { mn = fmaxf(m_reg, pmax); alpha = __builtin_amdgcn_exp2f((m_reg - mn) * C); m_reg = mn; }
  const float mnC = -mn * C;
#pragma unroll
  for (int r = 0; r < 16; ++r) p0[r] = fmaf(p0[r], C, mnC);
#pragma unroll
  for (int r = 0; r < 16; ++r) p1[r] = fmaf(p1[r], C, mnC);
#pragma unroll
  for (int r = 0; r < 16; ++r) p0[r] = __builtin_amdgcn_exp2f(p0[r]);
}
__device__ __forceinline__ void finishSM(f32x16& p0, f32x16& p1, float alpha, float& l_reg, bf16x8& pa0, bf16x8& pa1, bf16x8& pa2, bf16x8& pa3) {
#pragma unroll
  for (int r = 0; r < 16; ++r) p1[r] = __builtin_amdgcn_exp2f(p1[r]);
  float ps = 0;
#pragma unroll
  for (int r = 0; r < 16; ++r) ps += p0[r];
#pragma unroll
  for (int r = 0; r < 16; ++r) ps += p1[r];
  { auto rr = __builtin_amdgcn_permlane32_swap(__float_as_uint(ps), __float_as_uint(ps), false, false);
    ps = __uint_as_float(rr[0]) + __uint_as_float(rr[1]); }
  l_reg = l_reg * alpha + ps;
#define PK4(P, BASE, OUT) do { unsigned a0 = cvt_pk_bf16(P[BASE + 0], P[BASE + 1]), a1 = cvt_pk_bf16(P[BASE + 2], P[BASE + 3]);   \
    unsigned b0 = cvt_pk_bf16(P[BASE + 4], P[BASE + 5]), b1 = cvt_pk_bf16(P[BASE + 6], P[BASE + 7]);                              \
    auto r0 = __builtin_amdgcn_permlane32_swap(a0, b0, false, false); auto r1 = __builtin_amdgcn_permlane32_swap(a1, b1, false, false); \
    u32x4 w = {r0[0], r1[0], r0[1], r1[1]}; OUT = *reinterpret_cast<bf16x8*>(&w); } while (0)
  PK4(p0, 0, pa0); PK4(p0, 8, pa1); PK4(p1, 0, pa2); PK4(p1, 8, pa3);
#undef PK4
}
template <int DK>
__device__ __forceinline__ void qkt(f32x16& p0, f32x16& p1, const char* Ks, const bf16x8* qr, int r32, int hi) {
  p0 = f32x16{}; p1 = f32x16{};
#pragma unroll
  for (int d0 = 0; d0 < DK / 16; ++d0) { const int cb = (d0 * 16 + hi * 8) * 2;
    const bf16x8 b0 = *reinterpret_cast<const bf16x8*>(Ks + KSWZ(r32, cb));
    const bf16x8 b1 = *reinterpret_cast<const bf16x8*>(Ks + KSWZ(32 + r32, cb));
    p0 = __builtin_amdgcn_mfma_f32_32x32x16_bf16(b0, qr[d0], p0, 0, 0, 0);
    p1 = __builtin_amdgcn_mfma_f32_32x32x16_bf16(b1, qr[d0], p1, 0, 0, 0); }
}
__device__ __forceinline__ int v_st(int k, int c) { const int kk = (k & ~0xC) | ((k & 4) << 1) | ((k & 8) >> 1); return ((kk >> 3) * 4 + (c >> 5)) * 512 + ((kk & 7) * 32 + (c & 31)) * 2; }
__device__ __forceinline__ int v_rd_base(int lane) { return ((lane & 3) << 3) | (((lane >> 2) & 3) << 6) | (((lane >> 4) & 1) << 5) | (((lane >> 5) & 1) << 8); }
constexpr int v_rd_off(int d0, int ks, int half) { return d0 * 512 + ks * 4096 + half * 2048; }
template <int OFF> __device__ __forceinline__ s16x4 tr_read(int vb) {
  s16x4 r; asm volatile("ds_read_b64_tr_b16 %0, %1 offset:%2" : "=&v"(r) : "v"(vb), "i"(OFF) : "memory"); return r;
}
template <int D0> __device__ __forceinline__ void pv_one(f32x16& od, int vb, bf16x8 pa0, bf16x8 pa1, bf16x8 pa2, bf16x8 pa3) {
  const s16x4 l0 = tr_read<v_rd_off(D0, 0, 0)>(vb), h0 = tr_read<v_rd_off(D0, 0, 1)>(vb), l1 = tr_read<v_rd_off(D0, 1, 0)>(vb), h1 = tr_read<v_rd_off(D0, 1, 1)>(vb);
  const s16x4 l2 = tr_read<v_rd_off(D0, 2, 0)>(vb), h2 = tr_read<v_rd_off(D0, 2, 1)>(vb), l3 = tr_read<v_rd_off(D0, 3, 0)>(vb), h3 = tr_read<v_rd_off(D0, 3, 1)>(vb);
  asm volatile("s_waitcnt lgkmcnt(0)" ::: "memory"); SBAR();
#define PK(Lo, Hi) (bf16x8){Lo[0], Lo[1], Lo[2], Lo[3], Hi[0], Hi[1], Hi[2], Hi[3]}
  od = __builtin_amdgcn_mfma_f32_32x32x16_bf16(pa0, PK(l0, h0), od, 0, 0, 0);
  od = __builtin_amdgcn_mfma_f32_32x32x16_bf16(pa1, PK(l1, h1), od, 0, 0, 0);
  od = __builtin_amdgcn_mfma_f32_32x32x16_bf16(pa2, PK(l2, h2), od, 0, 0, 0);
  od = __builtin_amdgcn_mfma_f32_32x32x16_bf16(pa3, PK(l3, h3), od, 0, 0, 0);
#undef PK
}
template <int DV> __device__ __forceinline__ void pv_all(f32x16* o, int vb, bf16x8 pa0, bf16x8 pa1, bf16x8 pa2, bf16x8 pa3) {
  pv_one<0>(o[0], vb, pa0, pa1, pa2, pa3); pv_one<1>(o[1], vb, pa0, pa1, pa2, pa3);
  if constexpr (DV == 128) { pv_one<2>(o[2], vb, pa0, pa1, pa2, pa3); pv_one<3>(o[3], vb, pa0, pa1, pa2, pa3); }
}
__device__ __forceinline__ __amdgpu_buffer_rsrc_t make_rsrc(const void* p) {
  const unsigned lo = __builtin_amdgcn_readfirstlane((unsigned)(uintptr_t)p), hi = __builtin_amdgcn_readfirstlane((unsigned)((uintptr_t)p >> 32));
  return __builtin_amdgcn_make_buffer_rsrc((void*)(((uintptr_t)hi << 32) | lo), 0, 0x7fffffff, 0x00020000);
}
struct NoHook { static constexpr int VM_EXTRA = 0; __device__ __forceinline__ void step() {} };
template <int DK, int DV, int ldq, int ldk, int ldv, int ldo, int SDEPTH, class Hook>
__device__ __forceinline__ void attn_unit(const bf16_t* __restrict__ Qb, const bf16_t* __restrict__ Kh, const bf16_t* __restrict__ Vh,
                                          bf16_t* __restrict__ Ob, int seq, char* lds, Hook& hk) {
  constexpr float C = (DK == 96 ? 0.10206207261596577f : 0.08838834764831845f) * 1.4426950408889634f;
  constexpr int NKC = 16, NVC = DV / 8;
  constexpr int NKL = (64 * NKC + 511) / 512, NVL = (64 * NVC + 511) / 512;
  constexpr float THRS = 8.0f * 1.4426950408889634f / C;
  const int tid = threadIdx.x, wid = tid >> 6, lane = tid & 63, r32 = lane & 31, hi = lane >> 5;
  char* V_lds = lds; char* K_lds = lds + 2 * SHM_V;
  float* ws = (float*)(lds + 2 * SHM_V + 2 * SHM_K) + wid * 64; float* li_l = ws; float* al_l = ws + 32;
  float m_reg = -1e30f, l_reg = 0; f32x16 o[DV / 32]; bf16x8 qr[DK / 16];
#pragma unroll
  for (int d = 0; d < DV / 32; ++d) o[d] = f32x16{};
  { const unsigned qoff = (unsigned)((wid * QBLK + r32) * ldq + hi * 8) * 2u;
#pragma unroll
    for (int d0 = 0; d0 < DK / 16; ++d0) qr[d0] = *reinterpret_cast<const bf16x8*>((const char*)Qb + (qoff + d0 * 32)); }
  static_assert(64 * NKC == 512 * NKL && 64 * NVC == 512 * NVL, "every staging chunk is valid");
  int krow[NKL], kch[NKL], vrow[NVL], vch[NVL];
#pragma unroll
  for (int i = 0; i < NKL; ++i) { const int ci = tid + 512 * i; krow[i] = ci / NKC; kch[i] = ci % NKC; }
#pragma unroll
  for (int i = 0; i < NVL; ++i) { const int ci = tid + 512 * i; vrow[i] = ci / NVC; vch[i] = ci % NVC; }
  unsigned koff[NKL], voff[NVL];
#pragma unroll
  for (int i = 0; i < NKL; ++i) koff[i] = (unsigned)(krow[i] * ldk + kch[i] * 8) * 2u;
#pragma unroll
  for (int i = 0; i < NVL; ++i) voff[i] = (unsigned)(vrow[i] * ldv + vch[i] * 8) * 2u;
  const int vb0 = (int)(uintptr_t)V_lds + v_rd_base(lane);
  struct { bf16x8 v[NVL], k[NKL]; } sr_[SDEPTH];
  const __amdgpu_buffer_rsrc_t rsK = make_rsrc(Kh), rsV = make_rsrc(Vh);
#define SLOAD(i, k0) do { const int vso_ = (k0) * (ldv * 2), kso_ = (k0) * (ldk * 2); \
    _Pragma("unroll") for (int q = 0; q < NVL; ++q) sr_[i].v[q] = __builtin_bit_cast(bf16x8, __builtin_amdgcn_raw_buffer_load_b128(rsV, (int)voff[q], vso_, 0)); \
    _Pragma("unroll") for (int q = 0; q < NKL; ++q) sr_[i].k[q] = __builtin_bit_cast(bf16x8, __builtin_amdgcn_raw_buffer_load_b128(rsK, (int)koff[q], kso_, 0)); } while (0)
#define SWRITE(b, i) do { _Pragma("unroll") for (int q = 0; q < NVL; ++q) *(bf16x8*)(V_lds + (b) * SHM_V + v_st(vrow[q], vch[q] * 8)) = sr_[i].v[q]; \
    _Pragma("unroll") for (int q = 0; q < NKL; ++q) *(bf16x8*)(K_lds + (b) * SHM_K + KSWZ(krow[q], kch[q] * 16)) = sr_[i].k[q]; } while (0)
#define SWAIT() asm volatile("s_waitcnt vmcnt(%0)" :: "n"(SDEPTH == 2 ? NVL + NKL : 0) : "memory")
#define SWAIT2() asm volatile("s_waitcnt vmcnt(%0)" :: "n"((SDEPTH == 2 ? NVL + NKL : 0) + Hook::VM_EXTRA) : "memory")
#define RESC(a) do { if (__any((a) < 1.f)) { if (hi == 0) al_l[r32] = (a); asm volatile("s_waitcnt lgkmcnt(0)" ::: "memory"); \
    _Pragma("unroll") for (int d = 0; d < DV / 32; ++d) _Pragma("unroll") for (int r = 0; r < 16; ++r) o[d][r] *= al_l[crow(r, hi)]; } } while (0)
  f32x16 pA0, pA1, pB0, pB1; float mnA, mnB, alA, alB; bf16x8 pa0, pa1, pa2, pa3; const int NT = seq / KVBLK;
#ifdef ATT_PRIO
  if (wid >= 4) __builtin_amdgcn_s_setprio(1);
#endif
  constexpr int SE = 0, SO = SDEPTH - 1;
  SLOAD(SE, 0); asm volatile("s_waitcnt vmcnt(0)" ::: "memory"); SWRITE(0, SE); __syncthreads();
  qkt<DK>(pA0, pA1, K_lds, qr, r32, hi); partialSM(pA0, pA1, m_reg, mnA, alA, C, THRS);
  SLOAD(SO, KVBLK); if constexpr (SDEPTH == 2) SLOAD(SE, 2 * KVBLK);
  SWAIT(); SWRITE(1, SO); __syncthreads();
  for (int j = 1; j + 1 < NT; j += 2) {
    SBAR(); qkt<DK>(pB0, pB1, K_lds + SHM_K, qr, r32, hi);
    finishSM(pA0, pA1, alA, l_reg, pa0, pa1, pa2, pa3);
    hk.step();
    SBAR();
    SLOAD(SO, (j + SDEPTH) * KVBLK); SBAR();
    pv_all<DV>(o, vb0, pa0, pa1, pa2, pa3); partialSM(pB0, pB1, m_reg, mnB, alB, C, THRS);
    __syncthreads(); SWAIT2(); SWRITE(0, SE);
    RESC(alB); __syncthreads();
    SBAR(); qkt<DK>(pA0, pA1, K_lds, qr, r32, hi);
    finishSM(pB0, pB1, alB, l_reg, pa0, pa1, pa2, pa3); SBAR();
    { const int tn = (j + 1 + SDEPTH) < NT ? (j + 1 + SDEPTH) : NT - 1; SLOAD(SE, tn * KVBLK); } SBAR();
    pv_all<DV>(o, vb0 + (int)SHM_V, pa0, pa1, pa2, pa3); partialSM(pA0, pA1, m_reg, mnA, alA, C, THRS);
    __syncthreads(); SWAIT(); SWRITE(1, SO);
    RESC(alA); __syncthreads();
  }
  SBAR(); qkt<DK>(pB0, pB1, K_lds + SHM_K, qr, r32, hi);
  finishSM(pA0, pA1, alA, l_reg, pa0, pa1, pa2, pa3); SBAR();
  pv_all<DV>(o, vb0, pa0, pa1, pa2, pa3); partialSM(pB0, pB1, m_reg, mnB, alB, C, THRS);
  __syncthreads(); RESC(alB);
  finishSM(pB0, pB1, alB, l_reg, pa0, pa1, pa2, pa3); SBAR();
  pv_all<DV>(o, vb0 + (int)SHM_V, pa0, pa1, pa2, pa3);
  if (hi == 0) li_l[r32] = l_reg; asm volatile("s_waitcnt lgkmcnt(0)" ::: "memory");
  unsigned ooff = (unsigned)((wid * QBLK + 4 * hi) * ldo + r32) * 2u;
  asm volatile("" : "+v"(ooff));
#pragma unroll
  for (int r = 0; r < 16; ++r) { const float rl = __builtin_amdgcn_rcpf(li_l[crow(r, hi)]);
    char* orow = (char*)Ob + (size_t)(((r & 3) + 8 * (r >> 2)) * ldo) * 2;
#pragma unroll
    for (int d0 = 0; d0 < DV / 32; ++d0) *(bf16_t*)(orow + (ooff + d0 * 64)) = (bf16_t)(cvt_pk_bf16(o[d0][r] * rl, 0.f) & 0xffffu);
    asm volatile("" ::: "memory"); }
#ifdef ATT_PRIO
  __builtin_amdgcn_s_setprio(0);
#endif
  __syncthreads();
#undef SLOAD
#undef SWRITE
#undef SWAIT
#undef SWAIT2
#undef RESC
}


typedef short v4i16_t __attribute__((ext_vector_type(4)));
typedef __attribute__((address_space(3))) const char* lds_cptr;
__device__ __forceinline__ s16x4 vtr(lds_cptr p) { return __builtin_bit_cast(s16x4, __builtin_amdgcn_ds_read_tr16_b64_v4i16((__attribute__((address_space(3))) v4i16_t*)p)); }
template <int DK, int DV, bool DOQK>
__device__ __forceinline__ void mseg_compute(f32x16& p0, f32x16& p1, f32x16* o, lds_cptr Ks, lds_cptr Vs, const bf16x8* qr, int r32, int hi, int lane, bf16x8 pa0, bf16x8 pa1, bf16x8 pa2, bf16x8 pa3) {
  const lds_cptr vp = Vs + v_rd_base(lane);
#define VFRAG(d0, ks, L, H) const s16x4 L = vtr(vp + v_rd_off(d0, ks, 0)), H = vtr(vp + v_rd_off(d0, ks, 1))
#define PKV(L, H) (bf16x8){L[0], L[1], L[2], L[3], H[0], H[1], H[2], H[3]}
#define LFENCE() asm volatile("" ::: "memory")
#define PVBLK(d, A0, B0, A1, B1, A2, B2, A3, B3) do { o[d] = __builtin_amdgcn_mfma_f32_32x32x16_bf16(pa0, PKV(A0, B0), o[d], 0, 0, 0); o[d] = __builtin_amdgcn_mfma_f32_32x32x16_bf16(pa1, PKV(A1, B1), o[d], 0, 0, 0); \
    o[d] = __builtin_amdgcn_mfma_f32_32x32x16_bf16(pa2, PKV(A2, B2), o[d], 0, 0, 0); o[d] = __builtin_amdgcn_mfma_f32_32x32x16_bf16(pa3, PKV(A3, B3), o[d], 0, 0, 0); } while (0)
  VFRAG(0, 0, l00, h00); VFRAG(0, 1, l01, h01); VFRAG(0, 2, l02, h02); VFRAG(0, 3, l03, h03);
  if constexpr (DOQK) {
    p0 = f32x16{}; p1 = f32x16{};
    bf16x8 ka = *(const __attribute__((address_space(3))) bf16x8*)(Ks + KSWZ(r32, hi * 16)), kb = *(const __attribute__((address_space(3))) bf16x8*)(Ks + KSWZ(32 + r32, hi * 16));
    LFENCE();
#pragma unroll
    for (int d0 = 0; d0 < DK / 16; ++d0) {
      bf16x8 na = ka, nb = kb;
      if (d0 + 1 < DK / 16) { const int cb = ((d0 + 1) * 16 + hi * 8) * 2; na = *(const __attribute__((address_space(3))) bf16x8*)(Ks + KSWZ(r32, cb)); nb = *(const __attribute__((address_space(3))) bf16x8*)(Ks + KSWZ(32 + r32, cb)); }
      LFENCE();
      p0 = __builtin_amdgcn_mfma_f32_32x32x16_bf16(ka, qr[d0], p0, 0, 0, 0);
      p1 = __builtin_amdgcn_mfma_f32_32x32x16_bf16(kb, qr[d0], p1, 0, 0, 0);
      ka = na; kb = nb;
    }
  }
  LFENCE();
  if constexpr (DV == 128) {
    PVBLK(0, l00, h00, l01, h01, l02, h02, l03, h03);
    { VFRAG(1, 0, l10, h10); VFRAG(1, 1, l11, h11); VFRAG(1, 2, l12, h12); VFRAG(1, 3, l13, h13); LFENCE(); PVBLK(1, l10, h10, l11, h11, l12, h12, l13, h13); }
    { VFRAG(2, 0, l20, h20); VFRAG(2, 1, l21, h21); VFRAG(2, 2, l22, h22); VFRAG(2, 3, l23, h23); LFENCE(); PVBLK(2, l20, h20, l21, h21, l22, h22, l23, h23); }
    { VFRAG(3, 0, l30, h30); VFRAG(3, 1, l31, h31); VFRAG(3, 2, l32, h32); VFRAG(3, 3, l33, h33); LFENCE(); PVBLK(3, l30, h30, l31, h31, l32, h32, l33, h33); }
  } else {
    VFRAG(1, 0, l10, h10); VFRAG(1, 1, l11, h11); VFRAG(1, 2, l12, h12); VFRAG(1, 3, l13, h13);
    LFENCE();
    PVBLK(0, l00, h00, l01, h01, l02, h02, l03, h03);
    PVBLK(1, l10, h10, l11, h11, l12, h12, l13, h13);
  }
#undef VFRAG
#undef PKV
#undef LFENCE
#undef PVBLK
}
template <int DK, int DV, int ldq, int ldk, int ldv, int ldo>
__device__ __forceinline__ void attn_unit2(const bf16_t* __restrict__ Qb, const bf16_t* __restrict__ Kh, const bf16_t* __restrict__ Vh,
                                           bf16_t* __restrict__ Ob, int seq, char* lds) {
  constexpr float C = (DK == 96 ? 0.10206207261596577f : 0.08838834764831845f) * 1.4426950408889634f;
  constexpr float THRS = 8.0f * 1.4426950408889634f / C;
  constexpr int NKC = 16, NVC = DV / 8, NKL = 2, NVL = (64 * NVC) / 512;
  const int tid = threadIdx.x, wid = tid >> 6, lane = tid & 63, r32 = lane & 31, hi = lane >> 5;
  const int half = __builtin_amdgcn_readfirstlane(wid >> 2);
  char* V_lds = lds; char* K_lds = lds + 2 * SHM_V;
  float* ws = (float*)(lds + 2 * SHM_V + 2 * SHM_K) + wid * 64; float* li_l = ws; float* al_l = ws + 32;
  float m_reg = -1e30f, l_reg = 0; f32x16 o[DV / 32]; bf16x8 qr[DK / 16];
#pragma unroll
  for (int d = 0; d < DV / 32; ++d) o[d] = f32x16{};
  { const unsigned qoff = (unsigned)((wid * QBLK + r32) * ldq + hi * 8) * 2u;
#pragma unroll
    for (int d0 = 0; d0 < DK / 16; ++d0) qr[d0] = *reinterpret_cast<const bf16x8*>((const char*)Qb + (qoff + d0 * 32)); }
  int krow[NKL], kch[NKL], vrow[NVL], vch[NVL]; unsigned koff[NKL], voff[NVL];
#pragma unroll
  for (int i = 0; i < NKL; ++i) { const int ci = tid + 512 * i; krow[i] = ci / NKC; kch[i] = ci % NKC; koff[i] = (unsigned)(krow[i] * ldk + kch[i] * 8) * 2u; }
#pragma unroll
  for (int i = 0; i < NVL; ++i) { const int ci = tid + 512 * i; vrow[i] = ci / NVC; vch[i] = ci % NVC; voff[i] = (unsigned)(vrow[i] * ldv + vch[i] * 8) * 2u; }
  const int vb0 = (int)(uintptr_t)V_lds + v_rd_base(lane);
  const __amdgpu_buffer_rsrc_t rsK = make_rsrc(Kh), rsV = make_rsrc(Vh);
  const int NT = seq / KVBLK;
  bf16x8 ks[2][NKL], vs[2][NVL];
#define LOADK(set, t) do { const int tn_ = (t) < NT ? (t) : NT - 1; _Pragma("unroll") for (int q = 0; q < NKL; ++q) ks[set][q] = __builtin_bit_cast(bf16x8, __builtin_amdgcn_raw_buffer_load_b128(rsK, (int)koff[q], tn_ * (KVBLK * ldk * 2), 0)); } while (0)
#define LOADV(set, t) do { const int tn_ = (t) < NT ? (t) : NT - 1; _Pragma("unroll") for (int q = 0; q < NVL; ++q) vs[set][q] = __builtin_bit_cast(bf16x8, __builtin_amdgcn_raw_buffer_load_b128(rsV, (int)voff[q], tn_ * (KVBLK * ldv * 2), 0)); } while (0)
#define WRITEK(set, t) do { _Pragma("unroll") for (int q = 0; q < NKL; ++q) *(bf16x8*)(K_lds + ((t) & 1) * SHM_K + KSWZ(krow[q], kch[q] * 16)) = ks[set][q]; } while (0)
#define WRITEV(set, t) do { _Pragma("unroll") for (int q = 0; q < NVL; ++q) *(bf16x8*)(V_lds + ((t) & 1) * SHM_V + v_st(vrow[q], vch[q] * 8)) = vs[set][q]; } while (0)
  f32x16 p0, p1; bf16x8 pa0, pa1, pa2, pa3;
#define SOFTMAX() do { float mn_, al_; partialSM(p0, p1, m_reg, mn_, al_, C, THRS); \
    if (__any(al_ < 1.f)) { if (hi == 0) al_l[r32] = al_; asm volatile("s_waitcnt lgkmcnt(0)" ::: "memory"); \
      _Pragma("unroll") for (int d = 0; d < DV / 32; ++d) _Pragma("unroll") for (int r = 0; r < 16; ++r) o[d][r] *= al_l[crow(r, hi)]; } \
    finishSM(p0, p1, al_, l_reg, pa0, pa1, pa2, pa3); } while (0)
  LOADK(0, 0); LOADV(0, 0); LOADK(1, 1);
  asm volatile("s_waitcnt vmcnt(0)" ::: "memory");
  WRITEK(0, 0); WRITEV(0, 0); WRITEK(1, 1);
  LOADV(1, 1); LOADK(0, 2);
  __syncthreads();
  qkt<DK>(p0, p1, K_lds, qr, r32, hi);
  SOFTMAX();
  if (half == 1) { WRITEV(1, 1); LOADV(0, 2); __syncthreads(); }
#define MSEG(j, JP) do { \
    if (half == 0) { WRITEV((JP) ^ 1, (j) + 1); LOADV(JP, (j) + 2); } else { WRITEK(JP, (j) + 2); LOADK((JP) ^ 1, (j) + 3); } \
    SBAR(); if constexpr (DV == 64) { if ((j) + 1 < NT) mseg_compute<DK, DV, true>(p0, p1, o, (lds_cptr)(K_lds + ((JP) ^ 1) * SHM_K), (lds_cptr)(V_lds + (JP) * SHM_V), qr, r32, hi, lane, pa0, pa1, pa2, pa3); \
      else mseg_compute<DK, DV, false>(p0, p1, o, (lds_cptr)K_lds, (lds_cptr)(V_lds + (JP) * SHM_V), qr, r32, hi, lane, pa0, pa1, pa2, pa3); } \
    else { if ((j) + 1 < NT) qkt<DK>(p0, p1, K_lds + ((JP) ^ 1) * SHM_K, qr, r32, hi); pv_all<DV>(o, vb0 + (JP) * (int)SHM_V, pa0, pa1, pa2, pa3); } SBAR(); } while (0)
#define VSEG(j, JP) do { \
    if (half == 0) { WRITEK(JP, (j) + 2); LOADK((JP) ^ 1, (j) + 3); } else { WRITEV(JP, (j) + 2); LOADV((JP) ^ 1, (j) + 3); } \
    if ((j) + 1 < NT) SOFTMAX(); } while (0)
  for (int j = 0; j < NT; j += 2) {
    MSEG(j, 0); __syncthreads();
    VSEG(j, 0); __syncthreads();
    MSEG(j + 1, 1); __syncthreads();
    VSEG(j + 1, 1); __syncthreads();
  }
  if (half == 0) __syncthreads();
  if (hi == 0) li_l[r32] = l_reg; asm volatile("s_waitcnt lgkmcnt(0)" ::: "memory");
  unsigned ooff = (unsigned)((wid * QBLK + 4 * hi) * ldo + r32) * 2u;
  asm volatile("" : "+v"(ooff));
#pragma unroll
  for (int r = 0; r < 16; ++r) { const float rl = __builtin_amdgcn_rcpf(li_l[crow(r, hi)]);
    char* orow = (char*)Ob + (size_t)(((r & 3) + 8 * (r >> 2)) * ldo) * 2;
#pragma unroll
    for (int d0 = 0; d0 < DV / 32; ++d0) *(bf16_t*)(orow + (ooff + d0 * 64)) = (bf16_t)(cvt_pk_bf16(o[d0][r] * rl, 0.f) & 0xffffu);
    asm volatile("" ::: "memory"); }
  __syncthreads();
#undef LOADK
#undef LOADV
#undef WRITEK
#undef WRITEV
#undef SOFTMAX
#undef MSEG
#undef VSEG
}

template <int DK, int DV, bool DOQK>
__device__ __forceinline__ void mseg_asm(f32x16& p0, f32x16& p1, f32x16* o, lds_cptr Ks, int vb, const bf16x8* qr, int r32, int hi, bf16x8 pa0, bf16x8 pa1, bf16x8 pa2, bf16x8 pa3) {
#define TRR(dst, OFF) asm volatile("ds_read_b64_tr_b16 %0, %1 offset:%2" : "=&v"(dst) : "v"(vb), "i"(OFF) : "memory")
#define RDBLK(d, P) do { TRR(P##l0, v_rd_off(d, 0, 0)); TRR(P##h0, v_rd_off(d, 0, 1)); TRR(P##l1, v_rd_off(d, 1, 0)); TRR(P##h1, v_rd_off(d, 1, 1)); \
    TRR(P##l2, v_rd_off(d, 2, 0)); TRR(P##h2, v_rd_off(d, 2, 1)); TRR(P##l3, v_rd_off(d, 3, 0)); TRR(P##h3, v_rd_off(d, 3, 1)); } while (0)
#define WAITBLK(N, P) asm volatile("s_waitcnt lgkmcnt(" #N ")" : "+v"(P##l0), "+v"(P##h0), "+v"(P##l1), "+v"(P##h1), "+v"(P##l2), "+v"(P##h2), "+v"(P##l3), "+v"(P##h3) :: "memory")
#define PKV(L, H) (bf16x8){L[0], L[1], L[2], L[3], H[0], H[1], H[2], H[3]}
#define PVBLK(d, P) do { o[d] = __builtin_amdgcn_mfma_f32_32x32x16_bf16(pa0, PKV(P##l0, P##h0), o[d], 0, 0, 0); o[d] = __builtin_amdgcn_mfma_f32_32x32x16_bf16(pa1, PKV(P##l1, P##h1), o[d], 0, 0, 0); \
    o[d] = __builtin_amdgcn_mfma_f32_32x32x16_bf16(pa2, PKV(P##l2, P##h2), o[d], 0, 0, 0); o[d] = __builtin_amdgcn_mfma_f32_32x32x16_bf16(pa3, PKV(P##l3, P##h3), o[d], 0, 0, 0); } while (0)
  s16x4 al0, ah0, al1, ah1, al2, ah2, al3, ah3, bl0, bh0, bl1, bh1, bl2, bh2, bl3, bh3;
  RDBLK(0, a); RDBLK(1, b);
  WAITBLK(8, a); SBAR(); PVBLK(0, a);
  if constexpr (DV == 128) {
    RDBLK(2, a);
    WAITBLK(8, b); SBAR(); PVBLK(1, b);
    RDBLK(3, b);
    WAITBLK(8, a); SBAR(); PVBLK(2, a);
    WAITBLK(0, b); SBAR(); PVBLK(3, b);
  } else {
    WAITBLK(0, b); SBAR(); PVBLK(1, b);
  }
  if constexpr (DOQK) qkt<DK>(p0, p1, (const char*)Ks, qr, r32, hi);
#undef TRR
#undef RDBLK
#undef WAITBLK
#undef PKV
#undef PVBLK
}
template <int DK, int DV, int ldq, int ldk, int ldv, int ldo>
__device__ __forceinline__ void attn_unit3(const bf16_t* __restrict__ Qb, const bf16_t* __restrict__ Kh, const bf16_t* __restrict__ Vh,
                                           bf16_t* __restrict__ Ob, int seq, char* lds) {
  constexpr float C = (DK == 96 ? 0.10206207261596577f : 0.08838834764831845f) * 1.4426950408889634f;
  constexpr float THRS = 8.0f * 1.4426950408889634f / C;
  constexpr int NVOP = DV / 64;
  const int tid = threadIdx.x, wid = __builtin_amdgcn_readfirstlane(tid >> 6), lane = tid & 63, r32 = lane & 31, hi = lane >> 5;
  const int half = wid >> 2;
  char* V_lds = lds; char* K_lds = lds + 2 * SHM_V;
  float* ws = (float*)(lds + 2 * SHM_V + 2 * SHM_K) + wid * 64; float* li_l = ws; float* al_l = ws + 32;
  float m_reg = -1e30f, l_reg = 0; f32x16 o[DV / 32]; bf16x8 qr[DK / 16];
#pragma unroll
  for (int d = 0; d < DV / 32; ++d) o[d] = f32x16{};
  { const unsigned qoff = (unsigned)((wid * QBLK + r32) * ldq + hi * 8) * 2u;
#pragma unroll
    for (int d0 = 0; d0 < DK / 16; ++d0) qr[d0] = *reinterpret_cast<const bf16x8*>((const char*)Qb + (qoff + d0 * 32)); }
  unsigned ksrc[2], vsrc[NVOP]; unsigned kdst[2], vdst[NVOP];
#pragma unroll
  for (int i = 0; i < 2; ++i) { const int ch = wid + 8 * i, row = 4 * ch + (lane >> 4), pos = lane & 15; ksrc[i] = (unsigned)(row * ldk * 2 + ((pos ^ (row & 7)) << 4)); kdst[i] = (unsigned)(ch * 1024); }
#pragma unroll
  for (int i = 0; i < NVOP; ++i) { const int ch = (DV == 64) ? 2 * wid : wid + 8 * i;
    const int ob = ch * 1024 + 16 * lane, st = ob >> 9, rem = ob & 511, kk = (st >> 2) * 8 + (rem >> 6), c = (st & 3) * 32 + ((rem & 63) >> 1);
    const int k = (kk & ~0xC) | ((kk & 4) << 1) | ((kk & 8) >> 1);
    vsrc[i] = (unsigned)(k * ldv * 2 + c * 2); vdst[i] = (unsigned)(ch * 1024); }
  const int vb0 = (int)(uintptr_t)V_lds + v_rd_base(lane);
  const int NT = seq / KVBLK;
#define DMAK(t) do { const int tn_ = (t) < NT ? (t) : NT - 1; const char* kt_ = (const char*)Kh + (size_t)tn_ * (KVBLK * ldk * 2); \
    _Pragma("unroll") for (int q = 0; q < 2; ++q) __builtin_amdgcn_global_load_lds((const unsigned*)(kt_ + q * (32 * ldk * 2) + ksrc[0]), (LAS unsigned*)(K_lds + ((t) & 1) * SHM_K + kdst[q]), 16, 0, 0); } while (0)
#define DMAV(t) do { const int tn_ = (t) < NT ? (t) : NT - 1; const char* vt_ = (const char*)Vh + (size_t)tn_ * (KVBLK * ldv * 2); \
    _Pragma("unroll") for (int q = 0; q < NVOP; ++q) __builtin_amdgcn_global_load_lds((const unsigned*)(vt_ + q * (32 * ldv * 2) + vsrc[0]), (LAS unsigned*)(V_lds + ((t) & 1) * SHM_V + vdst[q]), 16, 0, 0); } while (0)
#define BAR_PLAIN() asm volatile("s_waitcnt lgkmcnt(0)\n\ts_barrier" ::: "memory")
#define BAR_DMA() asm volatile("s_waitcnt vmcnt(0) lgkmcnt(0)\n\ts_barrier" ::: "memory")
  f32x16 p0, p1; bf16x8 pa0, pa1, pa2, pa3;
#define SOFTMAX() do { float mn_, al_; partialSM(p0, p1, m_reg, mn_, al_, C, THRS); \
    if (__any(al_ < 1.f)) { if (hi == 0) al_l[r32] = al_; asm volatile("s_waitcnt lgkmcnt(0)" ::: "memory"); \
      _Pragma("unroll") for (int d = 0; d < DV / 32; ++d) _Pragma("unroll") for (int r = 0; r < 16; ++r) o[d][r] *= al_l[crow(r, hi)]; } \
    finishSM(p0, p1, al_, l_reg, pa0, pa1, pa2, pa3); } while (0)
  DMAK(0); DMAV(0); DMAK(1);
  BAR_DMA();
  qkt<DK>(p0, p1, K_lds, qr, r32, hi);
  BAR_PLAIN();
  SOFTMAX();
  if (half == 1) { DMAK(2); DMAV(1); BAR_PLAIN(); }
#define MSEG(j, JP) do { if (half == 0) { DMAK((j) + 2); DMAV((j) + 1); } \
    SBAR(); if (false) {} \
    else if (ATT3_PLAIN == 2 && DV == 128) { if ((j) + 1 < NT) mseg_asm<DK, DV, true>(p0, p1, o, (lds_cptr)(K_lds + ((JP) ^ 1) * SHM_K), vb0 + (JP) * (int)SHM_V, qr, r32, hi, pa0, pa1, pa2, pa3); else mseg_asm<DK, DV, false>(p0, p1, o, (lds_cptr)K_lds, vb0 + (JP) * (int)SHM_V, qr, r32, hi, pa0, pa1, pa2, pa3); } \
    else if ((ATT3_PLAIN && DV == 128) || ATT3_PLAIN == 4) { if ((j) + 1 < NT) qkt<DK>(p0, p1, K_lds + ((JP) ^ 1) * SHM_K, qr, r32, hi); pv_all<DV>(o, vb0 + (JP) * (int)SHM_V, pa0, pa1, pa2, pa3); } \
    else if ((j) + 1 < NT) mseg_compute<DK, DV, true>(p0, p1, o, (lds_cptr)(K_lds + ((JP) ^ 1) * SHM_K), (lds_cptr)(V_lds + (JP) * SHM_V), qr, r32, hi, lane, pa0, pa1, pa2, pa3); \
    else mseg_compute<DK, DV, false>(p0, p1, o, (lds_cptr)K_lds, (lds_cptr)(V_lds + (JP) * SHM_V), qr, r32, hi, lane, pa0, pa1, pa2, pa3); SBAR(); \
    if (half == 0) BAR_PLAIN(); else BAR_DMA(); } while (0)
#define VSEG(j, JP) do { if (half == 1) { DMAK((j) + 3); DMAV((j) + 2); } \
    if ((j) + 1 < NT) SOFTMAX(); \
    if (half == 0) BAR_DMA(); else BAR_PLAIN(); } while (0)
  for (int j = 0; j < NT; j += 2) { MSEG(j, 0); VSEG(j, 0); MSEG(j + 1, 1); VSEG(j + 1, 1); }
  if (half == 0) BAR_PLAIN();
  asm volatile("s_waitcnt vmcnt(0)" ::: "memory");
  if (hi == 0) li_l[r32] = l_reg; asm volatile("s_waitcnt lgkmcnt(0)" ::: "memory");
  unsigned ooff = (unsigned)((wid * QBLK + 4 * hi) * ldo + r32) * 2u;
  asm volatile("" : "+v"(ooff));
#pragma unroll
  for (int r = 0; r < 16; ++r) { const float rl = __builtin_amdgcn_rcpf(li_l[crow(r, hi)]);
    char* orow = (char*)Ob + (size_t)(((r & 3) + 8 * (r >> 2)) * ldo) * 2;
#pragma unroll
    for (int d0 = 0; d0 < DV / 32; ++d0) *(bf16_t*)(orow + (ooff + d0 * 64)) = (bf16_t)(cvt_pk_bf16(o[d0][r] * rl, 0.f) & 0xffffu);
    asm volatile("" ::: "memory"); }
  asm volatile("s_waitcnt vmcnt(0) lgkmcnt(0)\n\ts_barrier" ::: "memory");
#undef DMAK
#undef DMAV
#undef BAR_PLAIN
#undef BAR_DMA
#undef SOFTMAX
#undef MSEG
#undef VSEG
}
#undef KSWZ
#undef SBAR
}

struct Params { const float* in[23]; float* out; unsigned char* ws; int ph_lo, ph_hi, bar_region, use_cg; };
enum { IN_X = 0, IN_C, IN_CTX, IN_CCTX, IN_ADAW, IN_ADAB, IN_NORM1, IN_NORM2, IN_ABWIN, IN_ABQN, IN_ABWUQ, IN_ABKVN, IN_ABWUKV, IN_ABWO, IN_CWIN, IN_CQG, IN_CKG, IN_CWO, IN_ROUTER, IN_WG, IN_WU, IN_WD, IN_FNORM };
constexpr int NPH = 20;
#define LDS_WAIT() asm volatile("s_waitcnt lgkmcnt(0)" ::: "memory")

__device__ __forceinline__ void transpose_item(const float* W, int ldw, bf16_t* WT, int ldt, const float* kscale, LAS float* scr, int lane) {
#pragma unroll 8
  for (int i = 0; i < 32; ++i) { const int kk = 2 * i + (lane >> 5); float v = W[(size_t)kk * ldw + (lane & 31)]; if (kscale) v *= kscale[kk]; scr[kk * 33 + (lane & 31)] = v; }
  LDS_WAIT(); asm volatile("" ::: "memory");
  const int c = lane & 7;
#pragma unroll
  for (int j = 0; j < 4; ++j) { const int n = (lane >> 3) + 8 * j; const LAS float* s = scr + (8 * c) * 33 + n;
    u32x4 o; o.x = cvt_pk_bf16(s[0 * 33], s[1 * 33]); o.y = cvt_pk_bf16(s[2 * 33], s[3 * 33]); o.z = cvt_pk_bf16(s[4 * 33], s[5 * 33]); o.w = cvt_pk_bf16(s[6 * 33], s[7 * 33]);
    *(u32x4*)(WT + (size_t)n * ldt + 8 * c) = o; }
  LDS_WAIT(); asm volatile("" ::: "memory");
}
__device__ __forceinline__ void transpose_item8(const float* W, int ldw, unsigned char* WT, int ldt, LAS float* scr, int lane) {
#pragma unroll 8
  for (int i = 0; i < 32; ++i) { const int kk = 2 * i + (lane >> 5); scr[kk * 33 + (lane & 31)] = W[(size_t)kk * ldw + (lane & 31)] * W8_SCALE; }
  LDS_WAIT(); asm volatile("" ::: "memory");
#pragma unroll
  for (int u = 0; u < 2; ++u) { const int p = lane + 64 * u, n = p >> 2, c = p & 3; const LAS float* s = scr + (16 * c) * 33 + n;
    u32x4 o; o.x = pack4_fp8(s[0 * 33], s[1 * 33], s[2 * 33], s[3 * 33]); o.y = pack4_fp8(s[4 * 33], s[5 * 33], s[6 * 33], s[7 * 33]);
    o.z = pack4_fp8(s[8 * 33], s[9 * 33], s[10 * 33], s[11 * 33]); o.w = pack4_fp8(s[12 * 33], s[13 * 33], s[14 * 33], s[15 * 33]);
    *(u32x4*)(WT + (size_t)n * ldt + 16 * c) = o; }
  LDS_WAIT(); asm volatile("" ::: "memory");
}
#ifndef MOE_FP8
#define MOE_FP8 1
#endif
__device__ __forceinline__ void moe_item(const Params& P, int r, LAS float* scr, int lane) {
  unsigned char* ws = P.ws;
  const int le = r / 3072, q = r % 3072, which = q >> 10, t = q & 1023;
  if (which < 2) { const int kb = t >> 6, nb = t & 63, n0 = nb * 32;
    const float* src = P.in[which == 0 ? IN_WG : IN_WU] + (size_t)le * 1024 * 2048 + (size_t)kb * 64 * 2048 + n0;
    const size_t doff = (size_t)le * 4096 * 1024 + (size_t)((n0 >> 7) * 256 + which * 128 + (n0 & 127)) * 1024 + kb * 64;
    if (MOE_FP8) transpose_item8(src, 2048, ws + WS_WGU + doff, 1024, scr, lane); else transpose_item(src, 2048, (bf16_t*)(ws + WS_WGU) + doff, 1024, nullptr, scr, lane);
  } else { const int kb = t >> 5, nb = t & 31;
    const float* src = P.in[IN_WD] + (size_t)le * 2048 * 1024 + (size_t)kb * 64 * 1024 + nb * 32;
    const size_t doff = (size_t)le * 1024 * 2048 + (size_t)nb * 32 * 2048 + kb * 64;
    if (MOE_FP8) transpose_item8(src, 1024, ws + WS_WD + doff, 2048, scr, lane); else transpose_item(src, 1024, (bf16_t*)(ws + WS_WD) + doff, 2048, nullptr, scr, lane);
  }
}
#ifndef FQ_GEMM
#define FQ_GEMM 64
#endif
#ifndef FQ_TOPK
#define FQ_TOPK 44
#endif
constexpr int FS_NWG[7] = {248, 248, 192, 192, 116, 224, 124};
constexpr int FS_QUOTA[7] = {FQ_GEMM, FQ_GEMM, FQ_TOPK, FQ_GEMM, FQ_GEMM, FQ_TOPK, FQ_GEMM};
constexpr int FS_L0 = FS_NWG[0] * FS_QUOTA[0] + FS_NWG[1] * FS_QUOTA[1] + FS_NWG[2] * FS_QUOTA[2];
constexpr int FS_L1 = FS_NWG[3] * FS_QUOTA[3] + FS_NWG[4] * FS_QUOTA[4] + FS_NWG[5] * FS_QUOTA[5] + FS_NWG[6] * FS_QUOTA[6];
static_assert(FS_L0 <= 49152 && FS_L1 <= 49152, "filler quotas");
__device__ __forceinline__ int fs_base(int s) {
  int b = s < 3 ? 0 : 49152;
  for (int q = (s < 3 ? 0 : 3); q < s; ++q) b += FS_NWG[q] * FS_QUOTA[q];
  return b;
}
__device__ __forceinline__ void filler(const Params& P, LAS unsigned char* lds, int s, int f, int lane, int wave) {
  LAS float* scr = (LAS float*)(lds + wave * 16384);
  const int base = fs_base(s), nwg = FS_NWG[s], quota = FS_QUOTA[s];
  for (int k = wave; k < quota; k += NWAVES) moe_item(P, base + f + k * nwg, scr, lane);
}
constexpr int GEMV_ITEMS = 2 * 16 * 24;
constexpr int MOE_ITEMS = 2 * 16 * 3072;
constexpr int SM_WIN0 = 16 * 29, SM_WUQ = 4 * 24, SM_WUKV = 2 * 32, SM_WO = 16 * 32, SM_WIN1 = 16 * 48;
constexpr int SMALL_ITEMS = SM_WIN0 + SM_WUQ + SM_WUKV + SM_WO + SM_WIN1 + SM_WO;
__device__ __forceinline__ void p0_prologue(const Params& P, LAS unsigned char* lds, int gw, int NGW, int lane, int wave, bool skip_gemv = false) {
  unsigned char* ws = P.ws;
  float* MOD = (float*)(ws + WS_CTL) + CW_MOD;
  LAS float* scr = (LAS float*)(lds + wave * 16384);
  for (int it = gw; it < GEMV_ITEMS + SM_WIN0 + SM_WUQ + SM_WUKV; it += NGW) {
    if (it < GEMV_ITEMS) {
      if (skip_gemv) continue;
      const int l = it / 384, r0 = it % 384, kc = r0 / 24, nc = r0 % 24, k0 = kc * 64, n = nc * 256 + 4 * lane;
      const float s0 = siluf(P.in[IN_C][k0 + lane]), s1 = siluf(P.in[IN_C][1024 + k0 + lane]), s2 = siluf(P.in[IN_CCTX][k0 + lane]);
      const float* w = P.in[IN_ADAW] + ((size_t)l * 1024 + k0) * 6144 + n;
      f32x4 a0 = {0.f, 0.f, 0.f, 0.f}, a1 = a0, a2 = a0;
#pragma unroll 8
      for (int kk = 0; kk < 64; ++kk) { const f32x4 wv = *(const f32x4*)(w + (size_t)kk * 6144);
        a0 += wv * __shfl(s0, kk); a1 += wv * __shfl(s1, kk); a2 += wv * __shfl(s2, kk); }
      float* part = (float*)(ws + WS_MODP) + ((size_t)(l * 24 + nc) * 16) * 768 + 4 * lane;
      { float* pp = part + (size_t)kc * 768; *(f32x4*)pp = a0; *(f32x4*)(pp + 256) = a1; *(f32x4*)(pp + 512) = a2; }
      __threadfence();
      unsigned old = 0u; if (lane == 0) old = atomicAdd((unsigned*)(ws + WS_CTL) + CW_CNT + 64 * (l * 24 + nc), 1u);
      old = __builtin_amdgcn_readfirstlane(old);
      if (old == 15u) {
        __threadfence();
        const f32x4 bv = *(const f32x4*)(P.in[IN_ADAB] + l * 6144 + n); f32x4 t0 = bv, t1 = bv, t2 = bv;
#pragma unroll 4
        for (int q = 0; q < 16; ++q) { const float* pp = part + (size_t)q * 768; t0 += *(const f32x4*)pp; t1 += *(const f32x4*)(pp + 256); t2 += *(const f32x4*)(pp + 512); }
        float* m0 = MOD + (size_t)(l * 3) * 6144 + n;
        *(f32x4*)m0 = t0; *(f32x4*)(m0 + 6144) = t1; *(f32x4*)(m0 + 2 * 6144) = t2;
      }
      continue;
    }
    int r = it - GEMV_ITEMS;
    if (r < SM_WIN0) { const int kb = r / 29, nb = r % 29; transpose_item(P.in[IN_ABWIN] + (size_t)kb * 64 * 928 + nb * 32, 928, (bf16_t*)(ws + WS_WIN0) + (size_t)nb * 32 * 1024 + kb * 64, 1024, nullptr, scr, lane); continue; } r -= SM_WIN0;
    if (r < SM_WUQ) { const int kb = r / 24, nb = r % 24; transpose_item(P.in[IN_ABWUQ] + (size_t)kb * 64 * 768 + nb * 32, 768, (bf16_t*)(ws + WS_WUQ) + (size_t)nb * 32 * 256 + kb * 64, 256, P.in[IN_ABQN] + kb * 64, scr, lane); continue; } r -= SM_WUQ;
    { const int kb = r / 32, nb = r % 32; transpose_item(P.in[IN_ABWUKV] + (size_t)kb * 64 * 1024 + nb * 32, 1024, (bf16_t*)(ws + WS_WUKV) + (size_t)nb * 32 * 256 + 128 + kb * 64, 256, P.in[IN_ABKVN] + kb * 64, scr, lane); }
  }
  const bool fill = NGW == 2048;
  const int nrest = fill ? (49152 - FS_L0) + (49152 - FS_L1) : MOE_ITEMS;
  for (int it = gw; it < SM_WO + SM_WIN1 + SM_WO + nrest; it += NGW) {
    int r = it;
    if (r < SM_WO) { const int kb = r / 32, nb = r % 32; transpose_item(P.in[IN_ABWO] + (size_t)kb * 64 * 1024 + nb * 32, 1024, (bf16_t*)(ws + WS_WO0) + (size_t)nb * 32 * 1024 + kb * 64, 1024, nullptr, scr, lane); continue; } r -= SM_WO;
    if (r < SM_WIN1) { const int kb = r / 48, nb = r % 48; transpose_item(P.in[IN_CWIN] + (size_t)kb * 64 * 1536 + nb * 32, 1536, (bf16_t*)(ws + WS_WIN1) + (size_t)nb * 32 * 1024 + kb * 64, 1024, nullptr, scr, lane); continue; } r -= SM_WIN1;
    if (r < SM_WO) { const int kb = r / 32, nb = r % 32; transpose_item(P.in[IN_CWO] + (size_t)kb * 64 * 1024 + nb * 32, 1024, (bf16_t*)(ws + WS_WO1) + (size_t)nb * 32 * 1024 + kb * 64, 1024, nullptr, scr, lane); continue; } r -= SM_WO;
    moe_item(P, !fill ? r : r < 49152 - FS_L0 ? FS_L0 + r : 49152 + FS_L1 + (r - (49152 - FS_L0)), scr, lane);
  }
  const int NT_ = NGW * 64;
  for (int g = gw * 64 + lane; g < 1024 + 4096 + 65536 + 12288 + 16384; g += NT_) {
    int q = g;
    if (q < 1024) { const int pos = q >> 3, i = q & 7; const float inv = powf(10000.f, -(float)i / 8.f); float s, c; sincos_acc((double)((float)pos * inv), s, c); ((f32x2*)(ws + WS_ROPEA))[q] = (f32x2){c, s}; continue; } q -= 1024;
    if (q < 4096) { const int pos = q >> 5, i = q & 31; const float inv = powf(10000.f, -(float)i / 32.f); float s, c; sincos_acc((double)((float)pos * inv), s, c); ((f32x2*)(ws + WS_ROPEC))[q] = (f32x2){c, s}; continue; } q -= 4096;
    if (q < 65536) {
      const int n = q >> 7, k0 = (q & 127) * 8; u32x4 o = {0u, 0u, 0u, 0u};
      if ((k0 >> 8) == (n >> 7)) { const int cp = n & 127, c0 = (k0 & 255) >> 1; float sv[4], cv[4];
#pragma unroll
        for (int j = 0; j < 4; ++j) sincos_acc(6.283185307179586476925 * (double)(((c0 + j) * cp) & 127) / 128.0, sv[j], cv[j]);
        o.x = cvt_pk_bf16(cv[0], sv[0]); o.y = cvt_pk_bf16(cv[1], sv[1]); o.z = cvt_pk_bf16(cv[2], sv[2]); o.w = cvt_pk_bf16(cv[3], sv[3]); }
      *(u32x4*)((bf16_t*)(ws + WS_WDFT) + (size_t)n * 1024 + k0) = o; continue; } q -= 65536;
    if (q < 12288) { *(u32x4*)((bf16_t*)(ws + WS_WIN0) + (size_t)928 * 1024 + (size_t)q * 8) = (u32x4){0u, 0u, 0u, 0u}; continue; } q -= 12288;
    { const int n = q >> 4, k0 = (q & 15) * 8; *(u32x4*)((bf16_t*)(ws + WS_WUKV) + (size_t)n * 256 + k0) = (u32x4){0u, 0u, 0u, 0u}; }
  }
}

__device__ __forceinline__ int mod_row(int row) { return (row % T) < L ? 2 : row / T; }
__device__ __forceinline__ void modulate4(f32x4 (&y)[4], const f32x4 (&v)[4], float rstd, const float* g, const float* sh, const float* sc, int lane) {
#pragma unroll
  for (int j = 0; j < 4; ++j) { const int o = 256 * j + 4 * lane; const f32x4 gv = *(const f32x4*)(g + o), sv = *(const f32x4*)(sh + o), cv = *(const f32x4*)(sc + o);
    y[j] = v[j] * rstd * gv * (1.f + cv) + sv; }
}
__device__ __forceinline__ void store_bf16_row(bf16_t* orow, const f32x4 (&y)[4], int lane) {
#pragma unroll
  for (int j = 0; j < 4; ++j) { u32x2 w; w.x = cvt_pk_bf16(y[j][0], y[j][1]); w.y = cvt_pk_bf16(y[j][2], y[j][3]); *(u32x2*)(orow + 256 * j + 4 * lane) = w; }
}
__device__ __forceinline__ float sumsq4(const f32x4 (&v)[4]) {
  float s = 0.f;
#pragma unroll
  for (int j = 0; j < 4; ++j) s += (v[j][0] * v[j][0] + v[j][1] * v[j][1]) + (v[j][2] * v[j][2] + v[j][3] * v[j][3]);
  return wave_sum(s);
}
__device__ __forceinline__ void phase_r0(const Params& P, int gw, int NGW, int lane) {
  float* H = (float*)(P.ws + WS_H); bf16_t* XN = (bf16_t*)(P.ws + WS_XN); const float* MOD = (const float*)(P.ws + WS_CTL) + CW_MOD;
  auto srcp = [&](int row) { const int b = row / T, i = row % T; return i < L ? P.in[IN_CTX] + ((size_t)b * L + i) * D : P.in[IN_X] + ((size_t)b * S + (i - L)) * D; };
  f32x4 v[4], vn[4];
  if (gw < M) { const float* s = srcp(gw);
#pragma unroll
    for (int j = 0; j < 4; ++j) v[j] = *(const f32x4*)(s + 256 * j + 4 * lane); }
#pragma unroll 1
  for (int row = gw; row < M; row += NGW) {
    const int nrow = row + NGW < M ? row + NGW : row;
    { const float* s = srcp(nrow);
#pragma unroll
      for (int j = 0; j < 4; ++j) vn[j] = *(const f32x4*)(s + 256 * j + 4 * lane); }
    f32x4 y[4];
    const float rstd = rsqrtf(sumsq4(v) * (1.f / D) + EPS);
    const float* mr = MOD + (size_t)mod_row(row) * 6144;
    modulate4(y, v, rstd, P.in[IN_NORM1], mr, mr + 1024, lane);
    store_bf16_row(XN + (size_t)row * D, y, lane);
#pragma unroll
    for (int j = 0; j < 4; ++j) v[j] = vn[j];
  }
}
__device__ __forceinline__ int lane_expert(int lane) { return ((lane >> 5) & 1) * 8 + ((lane >> 4) & 1) * 4 + ((lane >> 3) & 1) * 2 + ((lane >> 2) & 1); }
__device__ __forceinline__ float router_reduce(float (&p)[16], int lane) {
  float q[8], r[4], s[2], t;
  { const bool up = lane & 32;
#pragma unroll
    for (int i = 0; i < 8; ++i) { const float snd = up ? p[i] : p[i + 8], kp = up ? p[i + 8] : p[i]; q[i] = kp + __shfl_xor(snd, 32); } }
  { const bool up = lane & 16;
#pragma unroll
    for (int i = 0; i < 4; ++i) { const float snd = up ? q[i] : q[i + 4], kp = up ? q[i + 4] : q[i]; r[i] = kp + __shfl_xor(snd, 16); } }
  { const bool up = lane & 8;
#pragma unroll
    for (int i = 0; i < 2; ++i) { const float snd = up ? r[i] : r[i + 2], kp = up ? r[i + 2] : r[i]; s[i] = kp + __shfl_xor(snd, 8); } }
  { const bool up = lane & 4; const float snd = up ? s[0] : s[1], kp = up ? s[1] : s[0]; t = kp + __shfl_xor(snd, 4); }
  t += __shfl_xor(t, 2); t += __shfl_xor(t, 1);
  float mx = t;
#pragma unroll
  for (int o = 4; o < 64; o <<= 1) mx = fmaxf(mx, __shfl_xor(mx, o));
  const float ex = expf(t - mx); float sm = ex;
#pragma unroll
  for (int o = 4; o < 64; o <<= 1) sm += __shfl_xor(sm, o);
  return ex / sm;
}
__device__ __forceinline__ void router_aff2(const f32x4 (&ya)[4], const f32x4 (&yb)[4], const LAS float* WrT, int lane, float& aa, float& ab) {
  asm volatile("" : "+v"(lane));
  float pa[16], pb[16];
#pragma unroll
  for (int e = 0; e < 16; ++e) { float a = 0.f, b = 0.f;
#pragma unroll
    for (int j = 0; j < 4; ++j) { const f32x4 w = *(const LAS f32x4*)(WrT + e * 1024 + 256 * j + 4 * lane);
      a += (ya[j][0] * w[0] + ya[j][1] * w[1]) + (ya[j][2] * w[2] + ya[j][3] * w[3]); b += (yb[j][0] * w[0] + yb[j][1] * w[1]) + (yb[j][2] * w[2] + yb[j][3] * w[3]); }
    pa[e] = a; pb[e] = b; }
  aa = router_reduce(pa, lane); ab = router_reduce(pb, lane);
}
__device__ __forceinline__ void phase_router(const Params& P, LAS unsigned char* lds, int layer, int gw, int NGW, int lane) {
  const float* H = (const float*)(P.ws + WS_H); bf16_t* XN = (bf16_t*)(P.ws + WS_XN); const float* MOD = (const float*)(P.ws + WS_CTL) + CW_MOD + layer * 3 * 6144;
  float* AFFL = (float*)(P.ws + WS_AFFL); float* AFFC = (float*)(P.ws + WS_AFFC); int* INV = (int*)(P.ws + WS_INV);
  LAS float* WrT = (LAS float*)lds;
  { const float* Wr = P.in[IN_ROUTER] + (size_t)layer * D * 16;
    for (int q = threadIdx.x; q < D * 4; q += NTHR) { const int d = q >> 2, e4 = (q & 3) * 4; const f32x4 w = *(const f32x4*)(Wr + d * 16 + e4);
#pragma unroll
      for (int t = 0; t < 4; ++t) WrT[(e4 + t) * 1024 + d] = w[t]; }
    __syncthreads(); }
  const float* g = P.in[IN_NORM2] + layer * D;
  const int NR = layer == 1 ? NB * S : M;
  auto rowof = [&](int r) { return layer == 1 ? (r / S) * T + L + (r % S) : r; };
  f32x4 vA[4], vB[4], nA[4], nB[4];
  auto ldrow = [&](int r, f32x4 (&v)[4]) { const int row = rowof(r < NR ? r : NR - 1);
#pragma unroll
    for (int j = 0; j < 4; ++j) v[j] = *(const f32x4*)(H + (size_t)row * D + 256 * j + 4 * lane); };
  auto modrow = [&](int r, const f32x4 (&v)[4], f32x4 (&y)[4]) {
    const int row = rowof(r), b = row / T, i = row % T;
    const float rstd = rsqrtf(sumsq4(v) * (1.f / D) + EPS);
    const float* mr = MOD + (size_t)(i < L ? 2 : b) * 6144;
    modulate4(y, v, rstd, g, mr + 3 * 1024, mr + 4 * 1024, lane);
    if (!MOE_FP8) store_bf16_row(XN + (size_t)row * D, y, lane);
    if (MOE_FP8) {
#pragma unroll
      for (int j = 0; j < 4; ++j) *(unsigned*)(P.ws + WS_XN8 + (size_t)row * D + 256 * j + 4 * lane) = pack4_fp8(y[j][0], y[j][1], y[j][2], y[j][3]);
    } };
  auto putaff = [&](int r, float a) { const int row = rowof(r), b = row / T, i = row % T;
    if ((lane & 3) == 0) { const int e = lane_expert(lane); if (i < L) AFFC[((size_t)b * 16 + e) * L + i] = a; else AFFL[((size_t)b * 16 + e) * S + (i - L)] = a; }
    if (lane < 16) INV[(size_t)row * 16 + lane] = -1; };
  if (gw < NR) { ldrow(gw, vA); ldrow(gw + NGW, vB); }
#pragma unroll 1
  for (int r = gw; r < NR; r += 2 * NGW) {
    const bool hasB = r + NGW < NR;
    ldrow(r + 2 * NGW, nA); ldrow(r + 3 * NGW, nB);
    f32x4 yA[4], yB[4]; float aA, aB;
    modrow(r, vA, yA);
    if (hasB) modrow(r + NGW, vB, yB); else {
#pragma unroll
      for (int j = 0; j < 4; ++j) yB[j] = yA[j]; }
    router_aff2(yA, yB, WrT, lane, aA, aB);
    putaff(r, aA); if (hasB) putaff(r + NGW, aB);
#pragma unroll
    for (int j = 0; j < 4; ++j) { vA[j] = nA[j]; vB[j] = nB[j]; }
  }
}
__device__ __forceinline__ void phase_combine(const Params& P, int layer, int gw, int NGW, int lane) {
  float* H = (float*)(P.ws + WS_H); bf16_t* XN = (bf16_t*)(P.ws + WS_XN); const float* MODL = (const float*)(P.ws + WS_CTL) + CW_MOD + layer * 3 * 6144;
  const int* INV = (const int*)(P.ws + WS_INV); const float* GATE = (const float*)(P.ws + WS_GATE); const bf16_t* Y2 = (const bf16_t*)(P.ws + WS_Y2);
  const int NR = layer == 1 ? NB * S : M;
  auto rowof = [&](int r) { return layer == 1 ? (r / S) * T + L + (r % S) : r; };
  f32x4 hA[4], hB[4], nA[4], nB[4]; int peA = -1, peB = -1, pnA, pnB;
  auto ldrow = [&](int r, f32x4 (&h)[4], int& pe) { const int row = rowof(r < NR ? r : NR - 1); pe = INV[(size_t)row * 16 + (lane & 15)];
#pragma unroll
    for (int j = 0; j < 4; ++j) h[j] = *(const f32x4*)(H + (size_t)row * D + 256 * j + 4 * lane); };
  auto finish = [&](int r, f32x4 (&hv)[4], const f32x4 (&acc)[4]) {
    const int row = rowof(r), b = row / T, i = row % T;
    const float* mr = MODL + (size_t)(i < L ? 2 : b) * 6144 + 5 * 1024;
#pragma unroll
    for (int j = 0; j < 4; ++j) hv[j] += *(const f32x4*)(mr + 256 * j + 4 * lane) * acc[j];
    const float rstd = rsqrtf(sumsq4(hv) * (1.f / D) + EPS);
    if (layer == 0) {
#pragma unroll
      for (int j = 0; j < 4; ++j) *(f32x4*)(H + (size_t)row * D + 256 * j + 4 * lane) = hv[j];
      f32x4 y[4]; const float* m1 = MODL + 3 * 6144 + (size_t)(i < L ? 2 : b) * 6144;
      modulate4(y, hv, rstd, P.in[IN_NORM1] + D, m1, m1 + 1024, lane);
      store_bf16_row(XN + (size_t)row * D, y, lane);
    } else {
      float* o = P.out + ((size_t)b * S + (i - L)) * D;
#pragma unroll
      for (int j = 0; j < 4; ++j) *(f32x4*)(o + 256 * j + 4 * lane) = hv[j] * rstd * *(const f32x4*)(P.in[IN_FNORM] + 256 * j + 4 * lane);
    }
  };
  if (gw < NR) { ldrow(gw, hA, peA); ldrow(gw + NGW, hB, peB); }
#pragma unroll 1
  for (int r = gw; r < NR; r += 2 * NGW) {
    const bool hasB = r + NGW < NR;
    ldrow(r + 2 * NGW, nA, pnA); ldrow(r + 3 * NGW, nB, pnB);
    f32x4 aA[4], aB[4];
#pragma unroll
    for (int j = 0; j < 4; ++j) { aA[j] = (f32x4){0.f, 0.f, 0.f, 0.f}; aB[j] = (f32x4){0.f, 0.f, 0.f, 0.f}; }
#pragma unroll
    for (int e = 0; e < 16; ++e) {
      const int pa = __builtin_amdgcn_readlane(peA, e), pb = hasB ? __builtin_amdgcn_readlane(peB, e) : -1;
      u32x2 wa[4], wb[4]; float ga = 0.f, gb = 0.f;
      if (pa >= 0) { ga = GATE[pa];
#pragma unroll
        for (int j = 0; j < 4; ++j) wa[j] = *(const u32x2*)(Y2 + (size_t)pa * D + 256 * j + 4 * lane); }
      if (pb >= 0) { gb = GATE[pb];
#pragma unroll
        for (int j = 0; j < 4; ++j) wb[j] = *(const u32x2*)(Y2 + (size_t)pb * D + 256 * j + 4 * lane); }
      if (pa >= 0) {
#pragma unroll
        for (int j = 0; j < 4; ++j) { aA[j][0] += ga * bflo(wa[j].x); aA[j][1] += ga * bfhi(wa[j].x); aA[j][2] += ga * bflo(wa[j].y); aA[j][3] += ga * bfhi(wa[j].y); } }
      if (pb >= 0) {
#pragma unroll
        for (int j = 0; j < 4; ++j) { aB[j][0] += gb * bflo(wb[j].x); aB[j][1] += gb * bfhi(wb[j].x); aB[j][2] += gb * bflo(wb[j].y); aB[j][3] += gb * bfhi(wb[j].y); } }
    }
    finish(r, hA, aA);
    if (hasB) finish(r + NGW, hB, aB);
    peA = pnA; peB = pnB;
#pragma unroll
    for (int j = 0; j < 4; ++j) { hA[j] = nA[j]; hB[j] = nB[j]; }
  }
}
__device__ __forceinline__ void phase_qkpost(const Params& P, int gw, int NGW, int lane) {
  const bf16_t* QKR = (const bf16_t*)(P.ws + WS_QKR); bf16_t* Q = (bf16_t*)(P.ws + WS_Q); bf16_t* Kb = (bf16_t*)(P.ws + WS_K); const f32x2* ropeC = (const f32x2*)(P.ws + WS_ROPEC);
  const float gq1 = P.in[IN_CQG][lane], gq2 = P.in[IN_CQG][64 + lane], gk1 = P.in[IN_CKG][lane], gk2 = P.in[IN_CKG][64 + lane];
  float v1[10], v2[10], n1_[10], n2_[10];
  if (gw < M) {
#pragma unroll
    for (int s = 0; s < 10; ++s) { v1[s] = bf2f(QKR[(size_t)gw * 1280 + s * 128 + lane]); v2[s] = bf2f(QKR[(size_t)gw * 1280 + s * 128 + 64 + lane]); } }
#pragma unroll 1
  for (int row = gw; row < M; row += NGW) {
    const int nrow = row + NGW < M ? row + NGW : row;
#pragma unroll
    for (int s = 0; s < 10; ++s) { n1_[s] = bf2f(QKR[(size_t)nrow * 1280 + s * 128 + lane]); n2_[s] = bf2f(QKR[(size_t)nrow * 1280 + s * 128 + 64 + lane]); }
    const int i = row % T; const bool lat = i >= L; const int sp = i - L;
    f32x2 cs1 = {1.f, 0.f}, cs2 = {1.f, 0.f};
    if (lat) { cs1 = ropeC[(sp >> 6) * 32 + (lane & 31)]; cs2 = ropeC[(sp & 63) * 32 + (lane & 31)]; }
#pragma unroll
    for (int slot = 0; slot < 10; ++slot) {
      if (slot < 8 && !lat) continue;
      const float a1 = v1[slot], a2 = v2[slot];
      const float rstd = rsqrtf(wave_sum(a1 * a1 + a2 * a2) * (1.f / 128.f) + EPS);
      const float m1 = a1 * rstd * (slot < 8 ? gq1 : gk1), m2 = a2 * rstd * (slot < 8 ? gq2 : gk2);
      const float p1 = __shfl_xor(m1, 32), p2 = __shfl_xor(m2, 32);
      const float o1 = lat ? ((lane < 32) ? m1 * cs1.x - p1 * cs1.y : p1 * cs1.y + m1 * cs1.x) : m1;
      const float o2 = lat ? ((lane < 32) ? m2 * cs2.x - p2 * cs2.y : p2 * cs2.y + m2 * cs2.x) : m2;
      bf16_t* dst = slot < 8 ? Q + (size_t)row * 1024 + slot * 128 : Kb + (size_t)row * 256 + (slot - 8) * 128;
      dst[lane] = (bf16_t)(cvt_pk_bf16(o1, 0.f) & 0xffffu); dst[64 + lane] = (bf16_t)(cvt_pk_bf16(o2, 0.f) & 0xffffu);
    }
#pragma unroll
    for (int s = 0; s < 10; ++s) { v1[s] = n1_[s]; v2[s] = n2_[s]; }
  }
}

__device__ __forceinline__ void topk_problem(const float* vals, int N, int cap, int row_base, int pbase, int e, int* IDX, float* GATE, int* INV, LAS unsigned* hist, LAS unsigned* misc) {
  const int tid = threadIdx.x, lane = tid & 63, wave = tid >> 6; const bool act = 16 * tid < N;
  unsigned v[16];
#pragma unroll
  for (int q = 0; q < 4; ++q) { u32x4 w = {0u, 0u, 0u, 0u}; if (act) w = *(const u32x4*)(vals + 16 * tid + 4 * q); v[4 * q] = w.x; v[4 * q + 1] = w.y; v[4 * q + 2] = w.z; v[4 * q + 3] = w.w; }
  unsigned prefix = 0u, pmask = 0u; int krem = cap;
#pragma unroll 1
  for (int pass = 0; pass < 4; ++pass) {
    const int shift = 24 - 8 * pass;
    if (tid < 256) hist[tid] = 0u;
    __syncthreads();
    if (act) {
#pragma unroll
      for (int i = 0; i < 16; ++i) if ((v[i] & pmask) == prefix) atomicAdd((unsigned*)(hist + ((v[i] >> shift) & 255u)), 1u);
    }
    __syncthreads();
    if (wave == 0) {
      const unsigned a0 = hist[255 - 4 * lane], a1 = hist[254 - 4 * lane], a2 = hist[253 - 4 * lane], a3 = hist[252 - 4 * lane];
      const int c0 = (int)a0, c1 = c0 + (int)a1, c2 = c1 + (int)a2, c3 = c2 + (int)a3;
      int incl = c3;
#pragma unroll
      for (int o = 1; o < 64; o <<= 1) { const int t = __shfl_up(incl, o); if (lane >= o) incl += t; }
      const int excl = incl - c3;
      if (excl < krem && krem <= incl) {
        const int j = (excl + c0 >= krem) ? 0 : (excl + c1 >= krem) ? 1 : (excl + c2 >= krem) ? 2 : 3;
        const int above = excl + (j == 0 ? 0 : j == 1 ? c0 : j == 2 ? c1 : c2);
        misc[0] = (unsigned)(255 - 4 * lane - j); misc[1] = (unsigned)(krem - above);
      }
    }
    __syncthreads();
    prefix |= misc[0] << shift; pmask |= 255u << shift; krem = (int)misc[1];
    __syncthreads();
  }
  int ngt = 0, neq = 0;
  if (act) {
#pragma unroll
    for (int i = 0; i < 16; ++i) { ngt += v[i] > prefix ? 1 : 0; neq += v[i] == prefix ? 1 : 0; }
  }
  int packed = ngt | (neq << 16), incl = packed;
#pragma unroll
  for (int o = 1; o < 64; o <<= 1) { const int t = __shfl_up(incl, o); if (lane >= o) incl += t; }
  if (lane == 63) misc[2 + wave] = (unsigned)incl;
  __syncthreads();
  int wpre = 0;
#pragma unroll
  for (int w = 0; w < 8; ++w) if (w < wave) wpre += (int)misc[2 + w];
  const int excl = wpre + incl - packed, gt_before = excl & 0xffff, eq_before = excl >> 16;
  if (act) {
    int slot = gt_before + (eq_before < krem ? eq_before : krem), eqi = eq_before;
#pragma unroll
    for (int i = 0; i < 16; ++i) {
      bool sel = v[i] > prefix;
      if (v[i] == prefix) { sel = eqi < krem; ++eqi; }
      if (sel) { const int row = row_base + 16 * tid + i; IDX[pbase + slot] = row; GATE[pbase + slot] = __uint_as_float(v[i]); INV[(size_t)row * 16 + e] = pbase + slot; ++slot; }
    }
  }
  __syncthreads();
}
__device__ __forceinline__ void phase_topk(const Params& P, LAS unsigned char* lds, int layer, int G) {
  const float* AFFL = (const float*)(P.ws + WS_AFFL); const float* AFFC = (const float*)(P.ws + WS_AFFC);
  int* IDX = (int*)(P.ws + WS_IDX); float* GATE = (float*)(P.ws + WS_GATE); int* INV = (int*)(P.ws + WS_INV);
  LAS unsigned* hist = (LAS unsigned*)(lds + LDS_TAB); LAS unsigned* misc = hist + 256;
  const int nprob = layer == 0 ? 64 : 32;
  for (int id = blockIdx.x; id < nprob; id += G) {
    const int ty = id >> 5, b = (id >> 4) & 1, e = id & 15;
    if (ty == 0) topk_problem(AFFL + ((size_t)b * 16 + e) * S, S, CAPL, b * T + L, e * PR + b * CAPL, e, IDX, GATE, INV, hist, misc);
    else {
      topk_problem(AFFC + ((size_t)b * 16 + e) * L, L, CAPC, b * T, e * PR + 2 * CAPL + b * CAPC, e, IDX, GATE, INV, hist, misc);
      if (b == 1) for (int q = threadIdx.x; q < PR - 2 * CAPL - 2 * CAPC; q += NTHR) { IDX[e * PR + 2 * CAPL + 2 * CAPC + q] = 0; GATE[e * PR + 2 * CAPL + 2 * CAPC + q] = 0.f; }
    }
  }
}


struct CvtStream {
  static constexpr int VM_EXTRA = 6;
  const float* const* in; unsigned char* ws; LAS float* scr; int lane;
  int s, le, which;
  int sgu, dgu, sd, dd;
  bf16_t* pdst; int pldt;
  f32x4 st[4];
  __device__ __forceinline__ void init(const Params& P, LAS unsigned char* lds, int t, int lane_, int wave) {
    in = P.in; ws = P.ws; scr = (LAS float*)(lds + 67584 + wave * 4224); lane = lane_; s = 0; le = 0; which = 0;
    { const int kb = t >> 6, n0 = (t & 63) * 32; sgu = kb * 32 * 2048 + n0; dgu = ((n0 >> 7) * 256 + (n0 & 127)) * 1024 + kb * 32; }
    { const int kb = t >> 5, n0 = (t & 31) * 32; sd = kb * 32 * 1024 + n0; dd = n0 * 2048 + kb * 32; }
    issue_point();
  }
  __device__ __forceinline__ void issue_point() {
    const bool dn = which == 2;
    const float* src = in[IN_WG + which] + (size_t)le * (1024 * 2048) + (dn ? sd : sgu);
    const int ldw = dn ? 1024 : 2048;
    pdst = dn ? (bf16_t*)(ws + WS_WD) + (size_t)le * (1024 * 2048) + dd : (bf16_t*)(ws + WS_WGU) + (size_t)le * (4096 * 1024) + which * (128 * 1024) + dgu;
    pldt = dn ? 2048 : 1024;
#if defined(EXP_FAKELD)
    const __amdgpu_buffer_rsrc_t rs = att::make_rsrc(in[IN_ABWO]);
#else
    const __amdgpu_buffer_rsrc_t rs = att::make_rsrc(src);
#endif
    const int voff = ((lane >> 3) * ldw + 4 * (lane & 7)) * 4, so = 8 * ldw * 4;
#pragma unroll
    for (int q = 0; q < 4; ++q) st[q] = __builtin_bit_cast(f32x4, __builtin_amdgcn_raw_buffer_load_b128(rs, voff, q * so, 2  ));
    if (s < 95) { ++s; if (++which == 3) { which = 0; ++le; } }
    else s = 96;
  }
  __device__ __forceinline__ void flush_point() {
    const int r = lane >> 3, c4 = (lane & 7) * 4;
#pragma unroll
    for (int q = 0; q < 4; ++q)
#pragma unroll
      for (int t = 0; t < 4; ++t) scr[(8 * q + r) * 33 + c4 + t] = st[q][t];
    LDS_WAIT(); asm volatile("" ::: "memory");
#if defined(EXP_FAKEST)
    const __amdgpu_buffer_rsrc_t rd = att::make_rsrc(ws + WS_H1 + (size_t)(blockIdx.x * 8 + (scr - (LAS float*)0) / 1056 % 8) * 2048); pldt = 32;
#else
    const __amdgpu_buffer_rsrc_t rd = att::make_rsrc(pdst);
#endif
#pragma unroll
    for (int u = 0; u < 2; ++u) { const int ii = lane + 64 * u, n = ii >> 2, c = ii & 3; const LAS float* sp = scr + (8 * c) * 33 + n;
      u32x4 o; o.x = cvt_pk_bf16(sp[0 * 33], sp[1 * 33]); o.y = cvt_pk_bf16(sp[2 * 33], sp[3 * 33]); o.z = cvt_pk_bf16(sp[4 * 33], sp[5 * 33]); o.w = cvt_pk_bf16(sp[6 * 33], sp[7 * 33]);
      __builtin_amdgcn_raw_buffer_store_b128(o, rd, (n * pldt + 8 * c) * 2, 0, 0); }
    LDS_WAIT(); asm volatile("" ::: "memory");
  }
  __device__ __forceinline__ void step() { flush_point(); issue_point(); }
  __device__ __forceinline__ void drain() { flush_point(); while (s < 96) { issue_point(); flush_point(); } }
};

template <class Hook> __device__ __forceinline__ void phase_attn(const Params& P, LAS unsigned char* lds, int layer, int G, Hook& hk) {
  const bf16_t* Q = (const bf16_t*)(P.ws + WS_Q); const bf16_t* Kb = (const bf16_t*)(P.ws + WS_K); const bf16_t* Vb = (const bf16_t*)(P.ws + WS_V); bf16_t* AC = (bf16_t*)(P.ws + WS_AC);
  const int bx = blockIdx.x; const int nunits = layer == 0 ? 528 : 512;
  for (int i = 0;; ++i) {
    int p, qb; bool isctx = false;
    if (G == 256) { const int xcd = bx & 7, loc = bx >> 3;
      if (i < 2) { p = xcd * 2 + i; qb = loc; } else if (i == 2 && layer == 0 && loc < 2) { p = xcd * 2 + loc; qb = 0; isctx = true; } else break;
    } else { const int uid = i * G + bx; if (uid >= nunits) break; if (uid < 512) { p = uid >> 5; qb = uid & 31; } else { p = uid - 512; qb = 0; isctx = true; } }
    const int b = p >> 3, h = p & 7;
    const size_t krow0 = (size_t)b * T, qrow0 = krow0 + (isctx ? 0 : L + qb * 256);
    const int seq = isctx ? L : T;
#ifndef ATT2
#define ATT2 1
#endif
#ifndef ATT3M
#define ATT3M 1
#endif
    if (ATT3M && layer == 0) att::attn_unit3<96, 64, 768, 768, 512, 1024>(Q + qrow0 * 768 + h * 96, Kb + krow0 * 768 + h * 96, Vb + krow0 * 512 + h * 64, AC + qrow0 * 1024 + 512 + h * 64, seq, (char*)lds);
    else if (ATT2 && layer == 0) att::attn_unit2<96, 64, 768, 768, 512, 1024>(Q + qrow0 * 768 + h * 96, Kb + krow0 * 768 + h * 96, Vb + krow0 * 512 + h * 64, AC + qrow0 * 1024 + 512 + h * 64, seq, (char*)lds);
#ifndef ATT3
#define ATT3 1
#endif
    else if (ATT3) att::attn_unit3<128, 128, 1024, 256, 256, 1024>(Q + qrow0 * 1024 + h * 128, Kb + krow0 * 256 + (h >> 2) * 128, Vb + krow0 * 256 + (h >> 2) * 128, AC + qrow0 * 1024 + h * 128, seq, (char*)lds);
    else if (ATT2) att::attn_unit2<128, 128, 1024, 256, 256, 1024>(Q + qrow0 * 1024 + h * 128, Kb + krow0 * 256 + (h >> 2) * 128, Vb + krow0 * 256 + (h >> 2) * 128, AC + qrow0 * 1024 + h * 128, seq, (char*)lds);
    else if (layer == 0)
      att::attn_unit<96, 64, 768, 768, 512, 1024, 2>(Q + qrow0 * 768 + h * 96, Kb + krow0 * 768 + h * 96, Vb + krow0 * 512 + h * 64, AC + qrow0 * 1024 + 512 + h * 64, seq, (char*)lds, hk);
    else
      att::attn_unit<128, 128, 1024, 256, 256, 1024, 2>(Q + qrow0 * 1024 + h * 128, Kb + krow0 * 256 + (h >> 2) * 128, Vb + krow0 * 256 + (h >> 2) * 128, AC + qrow0 * 1024 + h * 128, seq, (char*)lds, hk);
  }
}

__global__ void __launch_bounds__(NTHR, 2) mega_fwd(Params P_) {
  const Params& P = *(const Params*)__builtin_amdgcn_kernarg_segment_ptr(); (void)P_;
  extern __shared__ __attribute__((aligned(16))) unsigned char lds_raw[];
  LAS unsigned char* lds = (LAS unsigned char*)lds_raw;
  const int tid = threadIdx.x, lane = tid & 63, wave = __builtin_amdgcn_readfirstlane(tid >> 6);
  const int G = gridDim.x, bx = blockIdx.x;
  const int vcu = (G % 8 == 0) ? (bx % 8) * (G / 8) + bx / 8 : bx;
  const int gw = vcu * NWAVES + wave, NGW = G * NWAVES;
  volatile LAS unsigned* MISC = (volatile LAS unsigned*)(lds + LDS_MISC);
  if (tid < 64) MISC[tid] = 0u;
  __syncthreads();
  unsigned char* ws = P.ws;
  unsigned* ctl = (unsigned*)(ws + WS_CTL);
  XcdBarrier bar = xcd_barrier_post(ctl + CW_BAR + P.bar_region * XCD_BAR_WORDS, MISC + 8);
  const int lo = P.ph_lo, hi = P.ph_hi;
#ifndef ONLY_PH
#define ONLY_PH -1
#endif
#define IN(k) ((ONLY_PH < 0 || ONLY_PH == (k)) && lo <= (k) && (k) < hi)
#ifndef USE_CG
#define USE_CG 1
#endif
#if USE_CG
#define SEAM(k) do { if (IN(k) && IN((k) + 1)) { if ((k) == 0 && P.use_cg) cg::this_grid().sync(); else xcd_barrier(bar); if (DUP(25)) { xcd_barrier(bar); xcd_barrier(bar); } } } while (0)
#else
#define SEAM(k) do { if (IN(k) && IN((k) + 1)) xcd_barrier(bar); } while (0)
#endif
  float* SSQ = (float*)ctl + CW_SSQ; const float* MOD = (const float*)ctl + CW_MOD;
  const f32x2* ropeA = (const f32x2*)(ws + WS_ROPEA);

#ifndef DUP_MASK
#define DUP_MASK 0
#endif
#define DUP(k) ((DUP_MASK >> (k)) & 1)
  if (IN(0)) { p0_prologue(P, lds, gw, NGW, lane, wave); if (DUP(0)) { __syncthreads(); p0_prologue(P, lds, gw, NGW, lane, wave, true); } }
  SEAM(0);
  if (IN(1)) phase_r0(P, gw, NGW, lane);
  SEAM(1);
  if (IN(2)) {
    pg8::PlainSched Sd; Sd.init(ws + WS_XN, 1024, ws + WS_WIN0, 1024, M, 1024, G, bx);
    EpiInProj0 E{(bf16_t*)(ws + WS_FTL), (bf16_t*)(ws + WS_FTC), (bf16_t*)(ws + WS_P2), (bf16_t*)(ws + WS_K), SSQ, ropeA};
    pg8::gemm_phase(lds, 1024, Sd, E);
    if (G == 256 && bx >= 8) filler(P, lds, 0, bx - 8, lane, wave);
  }
  SEAM(2);
  if (IN(3)) {
    { pg8::QKVSched Sd; Sd.init(ws + WS_P2, ws + WS_WUQ, ws + WS_WUKV, G, bx); EpiQKV E{EpiQ{(bf16_t*)(ws + WS_Q), SSQ, ropeA}, EpiKV{(bf16_t*)(ws + WS_K), (bf16_t*)(ws + WS_V), SSQ}}; pg8::gemm_phase(lds, 256, Sd, E); }
#ifndef NO_FFT
    fft_phase(lds, (const bf16_t*)(ws + WS_FTL), (const bf16_t*)(ws + WS_FTC), (bf16_t*)(ws + WS_YC), G);
    if (DUP(21)) { for (int q_ = 0; q_ < 4; ++q_) fft_phase(lds, (const bf16_t*)(ws + WS_FTL), (const bf16_t*)(ws + WS_FTC), (bf16_t*)(ws + WS_YC), G); }
#endif
  }
  SEAM(3);
  if (IN(4)) {
    { att::NoHook nh; phase_attn(P, lds, 0, G, nh); if (DUP(4)) phase_attn(P, lds, 0, G, nh); }
    { pg8::PlainSched Sd; Sd.init(ws + WS_YC, 1024, ws + WS_WDFT, 1024, M, 512, G, bx); EpiBf16 E{(bf16_t*)(ws + WS_AC), 1024}; pg8::gemm_phase(lds, 1024, Sd, E); }
    if (G == 256 && bx >= 132) filler(P, lds, 6, bx - 132, lane, wave);
  }
  SEAM(4);
  if (IN(5)) { pg8::PlainSched Sd; Sd.init(ws + WS_AC, 1024, ws + WS_WO0, 1024, M, 1024, G, bx); EpiResid<true> E{(float*)(ws + WS_H), MOD, P.in[IN_X], P.in[IN_CTX]}; pg8::gemm_phase(lds, 1024, Sd, E); if (G == 256 && bx >= 8) filler(P, lds, 1, bx - 8, lane, wave); }
  SEAM(5);
  if (IN(6)) { phase_router(P, lds, 0, gw, NGW, lane); if (DUP(23)) { for (int q_ = 0; q_ < 4; ++q_) { __syncthreads(); phase_router(P, lds, 0, gw, NGW, lane); } } }
  SEAM(6);
  if (IN(7)) { phase_topk(P, lds, 0, G); if (DUP(22)) { for (int q_ = 0; q_ < 4; ++q_) phase_topk(P, lds, 0, G); } if (G == 256 && bx >= 64) filler(P, lds, 2, bx - 64, lane, wave); }
  SEAM(7);
  constexpr int MES = MOE_FP8 ? 1 : 2;
  if (IN(8)) { pg8::MoeSched<true, MES> Sd; Sd.init(ws + (MOE_FP8 ? WS_XN8 : WS_XN), 1024, 0, ws + WS_WGU, 1024, (size_t)4096 * 1024 * MES, (const int*)(ws + WS_IDX), 9, 16, G, bx); Sd.stage_idx((LAS int*)(lds + LDS_TAB)); EpiGateUp<MOE_FP8> E{ws + WS_H1}; pg8::gemm_phase(lds, 1024, Sd, E); if (DUP(8)) pg8::gemm_phase(lds, 1024, Sd, E);
    if (DUP(20)) { pg8::MoeSched<false, MES> S2; S2.init(ws + WS_XN8, 1024, (size_t)256 * 1024 * MES, ws + WS_WGU, 1024, (size_t)4096 * 1024 * MES, nullptr, 9, 16, G, bx); EpiGateUp<MOE_FP8> E2{ws + WS_Y2}; pg8::gemm_phase(lds, 1024, S2, E2); } }
  SEAM(8);
  if (IN(9)) { pg8::MoeSched<false, MES> Sd; Sd.init(ws + WS_H1, 2048, (size_t)PR * 2048 * MES, ws + WS_WD, 2048, (size_t)1024 * 2048 * MES, nullptr, 9, 4, G, bx); EpiDown<MOE_FP8> E{(bf16_t*)(ws + WS_Y2)}; pg8::gemm_phase(lds, 2048, Sd, E); if (DUP(9)) pg8::gemm_phase(lds, 2048, Sd, E);
    if (G == 256 && (bx >> 3) >= 8) filler(P, lds, 3, (bx & 7) * 24 + ((bx >> 3) - 8), lane, wave); }
  SEAM(9);
  if (IN(10)) phase_combine(P, 0, gw, NGW, lane);
  SEAM(10);
  if (IN(11)) { pg8::PlainSched Sd; Sd.init(ws + WS_XN, 1024, ws + WS_WIN1, 1024, M, 1536, G, bx); EpiInProj1 E{(bf16_t*)(ws + WS_QKR), (bf16_t*)(ws + WS_V)}; pg8::gemm_phase(lds, 1024, Sd, E); if (G == 256 && bx >= 140) filler(P, lds, 4, bx - 140, lane, wave); }
  SEAM(11);
  if (IN(12)) { phase_qkpost(P, gw, NGW, lane); if (DUP(24)) { for (int q_ = 0; q_ < 4; ++q_) phase_qkpost(P, gw, NGW, lane); } }
  SEAM(12);
  if (IN(13)) { att::NoHook nh; phase_attn(P, lds, 1, G, nh); if (DUP(13)) phase_attn(P, lds, 1, G, nh); }
  SEAM(13);
  if (IN(14)) { pg8::PlainSched Sd; Sd.init(ws + WS_AC, 1024, ws + WS_WO1, 1024, M, 1024, G, bx, 1); EpiResid<false> E{(float*)(ws + WS_H), MOD + 3 * 6144, nullptr, nullptr}; pg8::gemm_phase(lds, 1024, Sd, E); }
  SEAM(14);
  if (IN(15)) phase_router(P, lds, 1, gw, NGW, lane);
  SEAM(15);
  if (IN(16)) { phase_topk(P, lds, 1, G); if (G == 256 && bx >= 32) filler(P, lds, 5, bx - 32, lane, wave); }
  SEAM(16);
  if (IN(17)) { pg8::MoeSched<true, MES> Sd; Sd.init(ws + (MOE_FP8 ? WS_XN8 : WS_XN), 1024, 0, ws + WS_WGU + (size_t)16 * 4096 * 1024 * MES, 1024, (size_t)4096 * 1024 * MES, (const int*)(ws + WS_IDX), 8, 16, G, bx); Sd.stage_idx((LAS int*)(lds + LDS_TAB)); EpiGateUp<MOE_FP8> E{ws + WS_H1}; pg8::gemm_phase(lds, 1024, Sd, E); }
  SEAM(17);
  if (IN(18)) { pg8::MoeSched<false, MES> Sd; Sd.init(ws + WS_H1, 2048, (size_t)PR * 2048 * MES, ws + WS_WD + (size_t)16 * 1024 * 2048 * MES, 2048, (size_t)1024 * 2048 * MES, nullptr, 8, 4, G, bx); EpiDown<MOE_FP8> E{(bf16_t*)(ws + WS_Y2)}; pg8::gemm_phase(lds, 2048, Sd, E); }
  SEAM(18);
  if (IN(19)) phase_combine(P, 1, gw, NGW, lane);
#undef IN
#undef SEAM
}

struct Host { int grid; bool ok; };
inline Host& host_state() { static Host h{0, false}; return h; }
inline bool host_init(size_t ws_size) {
  Host& h = host_state();
  if (h.grid != 0) return h.ok;
  h.grid = -1; h.ok = false;
  if (ws_size < WS_END) { fprintf(stderr, "fk: workspace too small: %zu < %zu\n", ws_size, (size_t)WS_END); return false; }
  int dev = 0, cus = 0, per_cu = 0;
  if (hipGetDevice(&dev) != hipSuccess || hipDeviceGetAttribute(&cus, hipDeviceAttributeMultiprocessorCount, dev) != hipSuccess) return false;
  if (hipFuncSetAttribute((const void*)mega_fwd, hipFuncAttributeMaxDynamicSharedMemorySize, LDS_BYTES) != hipSuccess) { fprintf(stderr, "fk: hipFuncSetAttribute failed\n"); return false; }
  if (hipOccupancyMaxActiveBlocksPerMultiprocessor(&per_cu, (const void*)mega_fwd, NTHR, LDS_BYTES) != hipSuccess || per_cu < 1) { fprintf(stderr, "fk: occupancy query failed (%d)\n", per_cu); (void)hipGetLastError(); return false; }
  h.grid = cus * (per_cu > 1 ? 1 : per_cu);
  h.ok = true; return true;
}
inline void launch(hipStream_t st, void* const* d_in, float* out, void* ws, int lo, int hi, int region) {
  Params p; memset(&p, 0, sizeof(p));
  for (int i = 0; i < 23; ++i) p.in[i] = (const float*)d_in[i];
  p.out = out; p.ws = (unsigned char*)ws; p.ph_lo = lo; p.ph_hi = hi; p.bar_region = region; p.use_cg = 1;
  void* args[] = {&p};
  const hipError_t e = hipLaunchCooperativeKernel((const void*)mega_fwd, dim3(host_state().grid), dim3(NTHR), args, LDS_BYTES, st);
  if (e != hipSuccess) fprintf(stderr, "fk: cooperative launch failed: %s (grid %d)\n", hipGetErrorString(e), host_state().grid);
}
}


extern "C" void kernel_launch(void* const* d_in, const int* in_sizes, int n_in, void* d_out, int out_size, void* d_ws, size_t ws_size, hipStream_t stream) {
  if (n_in != 23 || out_size != fk::NB * fk::S * fk::D) { fprintf(stderr, "kernel_launch: unexpected shapes\n"); return; }
  if (!fk::host_init(ws_size)) return;
  hipMemsetAsync((char*)d_ws + fk::WS_CTL, 0, fk::CTL_BYTES, stream);
  fk::launch(stream, d_in, (float*)d_out, d_ws, 0, fk::NPH, 0);
}
```

```cpp
#include <hip/hip_runtime.h>
#include <cstdio>
#include <cstring>
#include <cstdint>

namespace nv {
__device__ __forceinline__ void sincos_acc(double x, float& s, float& c) {
  const double k = rint(x * 0.63661977236758134308);
  double r = fma(-k, 1.57079632679489655800e+00, x);
  r = fma(-k, 6.12323399573676603587e-17, r);
  const double r2 = r * r;
  double sp = 1.0 / 6227020800.0;
  sp = fma(sp, r2, -1.0 / 39916800.0);
  sp = fma(sp, r2, 1.0 / 362880.0);
  sp = fma(sp, r2, -1.0 / 5040.0);
  sp = fma(sp, r2, 1.0 / 120.0);
  sp = fma(sp, r2, -1.0 / 6.0);
  sp = fma(sp * r2, r, r);
  double cp = -1.0 / 87178291200.0;
  cp = fma(cp, r2, 1.0 / 479001600.0);
  cp = fma(cp, r2, -1.0 / 3628800.0);
  cp = fma(cp, r2, 1.0 / 40320.0);
  cp = fma(cp, r2, -1.0 / 720.0);
  cp = fma(cp, r2, 1.0 / 24.0);
  cp = fma(cp, r2, -0.5);
  cp = fma(cp, r2, 1.0);
  const int q = ((int)k) & 3;
  const double ss = (q == 0) ? sp : (q == 1) ? cp : (q == 2) ? -sp : -cp;
  const double cc = (q == 0) ? cp : (q == 1) ? -sp : (q == 2) ? -cp : sp;
  s = (float)ss; c = (float)cc;
}

}

#include <hip/hip_cooperative_groups.h>
namespace fk {
namespace cg = cooperative_groups;
#define LAS __attribute__((address_space(3)))
#define GAS __attribute__((address_space(1)))
typedef unsigned short bf16_t;
typedef short bf16x8 __attribute__((ext_vector_type(8)));
typedef short s16x4 __attribute__((ext_vector_type(4)));
typedef float f32x4 __attribute__((ext_vector_type(4)));
typedef float f32x2 __attribute__((ext_vector_type(2)));
typedef float f32x16 __attribute__((ext_vector_type(16)));
typedef unsigned u32x4 __attribute__((ext_vector_type(4)));
typedef unsigned u32x2 __attribute__((ext_vector_type(2)));

constexpr int D = 1024, NB = 2, S = 8192, L = 256, T = S + L, M = NB * T, MT = M / 256;
constexpr int NE = 16, FF = 2048, CAPL = 1024, CAPC = 32, PR = 2304;
constexpr float EPS = 1e-6f;
constexpr int NWAVES = 8, NTHR = 512;

constexpr size_t al256(size_t x) { return (x + 255) / 256 * 256; }
constexpr size_t WS_CTL = 0, CTL_BYTES = 1u << 20;
constexpr int CW_BAR = 1024;
constexpr int CW_MOD = 8192;
constexpr int CW_SSQ = CW_MOD + 36864;
constexpr int CW_CNT = CW_SSQ + 8 * M;
static_assert((CW_CNT + 48 * 64) * 4 <= (int)CTL_BYTES, "ctl");
constexpr size_t WS_WIN0 = CTL_BYTES;
constexpr size_t WS_WUQ = WS_WIN0 + (size_t)1024 * 1024 * 2;
constexpr size_t WS_WUKV = WS_WUQ + (size_t)768 * 256 * 2;
constexpr size_t WS_WDFT = WS_WUKV + (size_t)1024 * 256 * 2;
constexpr size_t WS_WO0 = WS_WDFT + (size_t)512 * 1024 * 2;
constexpr size_t WS_WIN1 = WS_WO0 + (size_t)1024 * 1024 * 2;
constexpr size_t WS_WO1 = WS_WIN1 + (size_t)1536 * 1024 * 2;
constexpr size_t WS_WGU = WS_WO1 + (size_t)1024 * 1024 * 2;
constexpr size_t WS_WD = WS_WGU + (size_t)2 * 16 * 4096 * 1024 * 2;
constexpr size_t WS_MODP = WS_WD + (size_t)2 * 16 * 1024 * 2048 * 2;
constexpr size_t WS_ROPEA = WS_MODP + (size_t)48 * 16 * 768 * 4;
constexpr size_t WS_ROPEC = WS_ROPEA + 128 * 8 * 8;
constexpr size_t WS_H = al256(WS_ROPEC + 128 * 32 * 8);
constexpr size_t WS_XN = WS_H + (size_t)M * D * 4;
constexpr size_t WS_XN8 = WS_XN + (size_t)M * D * 2;
constexpr size_t WS_P2 = WS_XN8 + (size_t)M * D;
constexpr size_t WS_FTL = WS_P2 + (size_t)M * 384 * 2;
constexpr size_t WS_FTC = WS_FTL + (size_t)2 * 128 * 8192 * 4 * 2;
constexpr size_t WS_YC = WS_FTC + (size_t)2 * 128 * 256 * 4 * 2;
constexpr size_t WS_AC = WS_YC + (size_t)M * D * 2;
constexpr size_t WS_Q = WS_AC + (size_t)M * D * 2;
constexpr size_t WS_K = WS_Q + (size_t)M * D * 2;
constexpr size_t WS_V = WS_K + (size_t)M * 768 * 2;
constexpr size_t WS_AFFL = WS_V + (size_t)M * 512 * 2;
constexpr size_t WS_AFFC = WS_AFFL + (size_t)2 * 16 * 8192 * 4;
constexpr size_t WS_IDX = WS_AFFC + (size_t)2 * 16 * 256 * 4;
constexpr size_t WS_GATE = WS_IDX + (size_t)16 * PR * 4;
constexpr size_t WS_INV = WS_GATE + (size_t)16 * PR * 4;
constexpr size_t WS_H1 = al256(WS_INV + (size_t)M * 16 * 4);
constexpr size_t WS_END = WS_H1 + (size_t)16 * PR * 2048 * 2;
constexpr size_t WS_QKR = WS_H1;
constexpr size_t WS_Y2 = WS_YC;
static_assert(WS_Y2 + (size_t)16 * PR * 1024 * 2 <= WS_K && (size_t)M * 1280 * 4 <= (size_t)16 * PR * 2048 * 2, "aliases");

constexpr int RING_BYTES = 131072;
constexpr int LDS_MISC = RING_BYTES;
constexpr int LDS_TAB = RING_BYTES + 1024;
constexpr int LDS_BYTES = 147456;

__device__ __forceinline__ unsigned cvt_pk_bf16(float lo, float hi) { unsigned r; asm volatile("v_cvt_pk_bf16_f32 %0, %1, %2" : "=v"(r) : "v"(lo), "v"(hi)); return r; }
__device__ __forceinline__ float bf2f(unsigned short b) { return __uint_as_float((unsigned)b << 16); }
__device__ __forceinline__ float bflo(unsigned w) { return __uint_as_float(w << 16); }
__device__ __forceinline__ float bfhi(unsigned w) { return __uint_as_float(w & 0xffff0000u); }
__device__ __forceinline__ float wave_sum(float v) {
#pragma unroll
  for (int o = 1; o < 64; o <<= 1) v += __shfl_xor(v, o);
  return v;
}
__device__ __forceinline__ float siluf(float x) { return x * __builtin_amdgcn_rcpf(1.f + __expf(-x)); }
using nv::sincos_acc;

#define XB_TMO      128
#define XB_XCNT(j)  (256  + 64 * (j))
#define XB_XSUB(j)  (1280 + 64 * (j))
#define XB_XGEN(j)  (2304 + 64 * (j))
#define XB_TOP      3328
#define XB_TOPGEN   3392
#define XCD_BAR_WORDS 3456
#define XB_SPIN_CAP (1u << 20)
__device__ __forceinline__ unsigned xb_ld(unsigned* p)              { return __hip_atomic_load(p, __ATOMIC_RELAXED, __HIP_MEMORY_SCOPE_AGENT); }
__device__ __forceinline__ unsigned xb_add(unsigned* p, unsigned v) { return __hip_atomic_fetch_add(p, v, __ATOMIC_RELAXED, __HIP_MEMORY_SCOPE_AGENT); }
__device__ __forceinline__ unsigned xb_xcc_id() { return (unsigned)__builtin_amdgcn_s_getreg((3 << 11) | 20) & 0xFu; }
#define XB_SPIN(cond, bar) do { unsigned _sp = 0; while (cond) { __builtin_amdgcn_s_sleep(1); \
    if ((++_sp & 255u) == 0u) { if (xb_ld(&(bar)[XB_TMO])) break; if (_sp > XB_SPIN_CAP) { atomicAdd(&(bar)[XB_TMO], 1u); break; } } } } while (0)
struct XcdBarrier { unsigned* bar; unsigned x; volatile LAS unsigned* st; };
__device__ __forceinline__ XcdBarrier xcd_barrier_post(unsigned* bar, volatile LAS unsigned* st) {
  XcdBarrier b; b.bar = bar; b.x = xb_xcc_id(); b.st = st;
  if (threadIdx.x == 0) (void)xb_add(&bar[XB_XCNT(b.x)], 1u);
  return b;
}
__device__ __forceinline__ void xcd_barrier_complete(unsigned* bar, unsigned x, unsigned& nloc, unsigned& nx) {
  const unsigned G = gridDim.x * gridDim.y * gridDim.z;
  unsigned sum, cnt, mine, sp = 0u;
  for (;;) {
    sum = 0u; cnt = 0u; mine = 0u;
#pragma unroll
    for (unsigned j = 0; j < 16; ++j) { const unsigned c = xb_ld(&bar[XB_XCNT(j)]); sum += c; cnt += (c > 0u) ? 1u : 0u; mine = (j == x) ? c : mine; }
    if (sum == G) break;
    __builtin_amdgcn_s_sleep(1);
    if ((++sp & 255u) == 0u) { if (xb_ld(&bar[XB_TMO])) break; if (sp > XB_SPIN_CAP) { atomicAdd(&bar[XB_TMO], 1u); break; } }
  }
  nloc = mine > 0u ? mine : 1u; nx = cnt > 0u ? cnt : 1u;
}
__device__ __forceinline__ void xcd_barrier(const XcdBarrier& b) {
  asm volatile("s_waitcnt vmcnt(0)" ::: "memory");
  __syncthreads();
  if (threadIdx.x == 0) {
    unsigned* bar = b.bar;
    __builtin_amdgcn_s_waitcnt(0);
    unsigned nloc = b.st[0], nx = b.st[1];
    if (nloc == 0u) { xcd_barrier_complete(bar, b.x, nloc, nx); b.st[0] = nloc; b.st[1] = nx; }
    const unsigned old = xb_add(&bar[XB_XSUB(b.x)], 1u);
    const unsigned gen = old / nloc;
    if (old + 1u == (gen + 1u) * nloc) {
      __builtin_amdgcn_fence(__ATOMIC_RELEASE, "agent");
      asm volatile("s_waitcnt vmcnt(0)" ::: "memory");
      const unsigned og = xb_add(&bar[XB_TOP], 1u);
      const unsigned tg = og / nx;
      if (og + 1u == (tg + 1u) * nx) xb_add(&bar[XB_TOPGEN], 1u);
      else XB_SPIN(xb_ld(&bar[XB_TOPGEN]) == tg, bar);
      __builtin_amdgcn_fence(__ATOMIC_ACQUIRE, "agent");
      xb_add(&bar[XB_XGEN(b.x)], 1u);
      asm volatile("s_waitcnt vmcnt(0)" ::: "memory");
    } else {
      XB_SPIN(xb_ld(&bar[XB_XGEN(b.x)]) == gen, bar);
      __builtin_amdgcn_fence(__ATOMIC_ACQUIRE, "agent");
      asm volatile("s_waitcnt vmcnt(0)" ::: "memory");
    }
  }
  __syncthreads();
}

namespace pg8 {
typedef int v4i_t __attribute__((ext_vector_type(4)));
typedef int v8i_t __attribute__((ext_vector_type(8)));
constexpr int BM = 256, BK = 64, HALF = 128, HTB = HALF * BK * 2, STAGE_BYTES = 8 * HTB, NXCD = 8, WGM = 8;
__host__ __device__ __forceinline__ int lds_byte(int r, int c) { const int st = (r >> 4) * 2 + (c >> 5), rr = r & 15, cc = c & 31, ob = rr * 64 + cc * 2; return st * 1024 + (ob ^ (((ob >> 9) & 1) << 5)); }
__host__ __device__ __forceinline__ void stage_rc(int b, int& R, int& C) { const int st = b / 1024, sb = b % 1024, swz = sb ^ (((sb >> 9) & 1) << 5); R = (st >> 1) * 16 + swz / 64; C = (st & 1) * 32 + (swz % 64) / 2; }
__host__ __device__ __forceinline__ int perm32(int rho) { const int n = rho >> 4, i = rho & 15; return 8 * (i >> 2) + 4 * n + (i & 3); }

struct Unit { int pm, pn, z, ord; };

struct PlainSched {
  const char* A; const char* Bt; int lda, ldb;
  static constexpr int es = 2;
  int nM, nN, nwg, G, c, skipctx;
  __device__ __forceinline__ void init(const void* A_, int lda_, const void* Bt_, int ldb_, int Mrows, int Ncols, int G_, int c_, int skipctx_ = 0) {
    A = (const char*)A_; Bt = (const char*)Bt_; lda = lda_; ldb = ldb_; skipctx = skipctx_; nM = skipctx_ ? 64 : Mrows / BM; nN = Ncols / BM; nwg = nM * nN; G = G_; c = c_; }
  __device__ __forceinline__ bool next(int i, Unit& u) const {
    const long Lq = (long)i * G + c; if (Lq >= nwg) return false;
    int wgid = (int)Lq; { const int q = nwg / NXCD, r = nwg % NXCD, xcd = wgid % NXCD, off = wgid / NXCD; wgid = (xcd < r ? xcd * (q + 1) : r * (q + 1) + (xcd - r) * q) + off; }
    const int nig = WGM * nN, gid = wgid / nig, fm = gid * WGM, gsz = (nM - fm) < WGM ? (nM - fm) : WGM;
    u.pm = fm + ((wgid % nig) % gsz); u.pn = (wgid % nig) / gsz; u.z = 0; u.ord = i; if (skipctx) u.pm += 1 + (u.pm >= 32 ? 1 : 0); return true;
  }
  __device__ __forceinline__ const char* a_base(const Unit& u) const { return A + (size_t)u.pm * BM * lda * 2; }
  __device__ __forceinline__ const char* b_base(const Unit& u) const { return Bt + (size_t)u.pn * BM * ldb * 2; }
  __device__ __forceinline__ void a_off(const Unit&, const int (&R)[2], const int (&C)[2], unsigned (&o)[2][2]) const {
#pragma unroll
    for (int h = 0; h < 2; ++h)
#pragma unroll
      for (int i = 0; i < 2; ++i) o[h][i] = (unsigned)((h * HALF + R[i]) * lda + C[i]) * 2u;
  }
};
struct QKVSched {
  static constexpr int es = 2;
  const char* A; const char* Bq; const char* Bkv; int lda, ldb, G, c;
  __device__ __forceinline__ void init(const void* P2, const void* Wq, const void* Wkv, int G_, int c_) { A = (const char*)P2; Bq = (const char*)Wq; Bkv = (const char*)Wkv; lda = 384; ldb = 256; G = G_; c = c_; }
  __device__ __forceinline__ bool next(int i, Unit& u) const {
    const int q = i * G + c; if (q >= 462) return false;
    if (q < 198) { u.z = 0; u.pm = q % 66; u.pn = q / 66; } else { const int r = q - 198; u.z = 1; u.pm = r % 66; u.pn = r / 66; }
    u.ord = i; return true;
  }
  __device__ __forceinline__ const char* a_base(const Unit& u) const { return A + (u.z ? 256 : 0) + (size_t)u.pm * BM * lda * 2; }
  __device__ __forceinline__ const char* b_base(const Unit& u) const { return (u.z ? Bkv : Bq) + (size_t)u.pn * BM * ldb * 2; }
  __device__ __forceinline__ void a_off(const Unit&, const int (&R)[2], const int (&C)[2], unsigned (&o)[2][2]) const {
#pragma unroll
    for (int h = 0; h < 2; ++h)
#pragma unroll
      for (int i = 0; i < 2; ++i) o[h][i] = (unsigned)((h * HALF + R[i]) * lda + C[i]) * 2u;
  }
};
template <bool GATHER, int ES> struct MoeSched {
  static constexpr int es = ES;
  const char* A; const char* Bt; int lda, ldb; size_t a_zstride, b_zstride;
  const int* idx;
  const LAS int* lidx;
  int TM, nN, per_x, vloc, xcd;
  __device__ __forceinline__ void init(const void* A_, int lda_, size_t azs, const void* Bt_, int ldb_, size_t bzs, const int* idx_, int TM_, int nN_, int G, int c) {
    A = (const char*)A_; Bt = (const char*)Bt_; lda = lda_; ldb = ldb_; a_zstride = azs; b_zstride = bzs; idx = idx_; TM = TM_; nN = nN_;
    xcd = c % 8; vloc = c / 8; per_x = 2 * TM * nN; (void)G; }
  __device__ __forceinline__ void stage_idx(LAS int* dst) {
    lidx = dst; Unit u;
    for (int i = 0; next(i, u); ++i) for (int r = threadIdx.x; r < BM; r += NTHR) dst[i * BM + r] = idx[u.z * PR + u.pm * BM + r];
    __syncthreads();
  }
  __device__ __forceinline__ bool next(int i, Unit& u) const {
    const int q = i * 32 + vloc; if (q >= per_x) return false;
    u.pm = q % TM; u.pn = (q / TM) % nN; u.z = xcd * 2 + q / (TM * nN); u.ord = i; return true;
  }
  __device__ __forceinline__ const char* a_base(const Unit& u) const { return GATHER ? A : A + (size_t)u.z * a_zstride + (size_t)u.pm * BM * lda * ES; }
  __device__ __forceinline__ const char* b_base(const Unit& u) const { return Bt + (size_t)u.z * b_zstride + (size_t)u.pn * BM * ldb * ES; }
  __device__ __forceinline__ void a_off(const Unit& u, const int (&R)[2], const int (&C)[2], unsigned (&o)[2][2]) const {
#pragma unroll
    for (int h = 0; h < 2; ++h)
#pragma unroll
      for (int i = 0; i < 2; ++i) {
        if (GATHER) { const int row = lidx[u.ord * BM + h * HALF + R[i]]; o[h][i] = (unsigned)(row * lda * ES + C[i] * 2); }
        else o[h][i] = (unsigned)((h * HALF + R[i]) * lda * ES + C[i] * 2);
      }
  }
};

template <class Epi, class Sched>
__device__ __forceinline__ void gemm_phase(LAS unsigned char* lds, const int K, const Sched& S, const Epi& E) {
  constexpr int ES = Sched::es; constexpr bool FP8 = ES == 1;
  const int tid = threadIdx.x, wid = __builtin_amdgcn_readfirstlane(tid >> 6), lane = tid & 63, wr = wid >> 2, wc = wid & 3, fr = lane & 15, fq = lane >> 4;
  const int nt = K * ES / (BK * 2);
  int RA[2], CA[2]; unsigned voffB[2];
#pragma unroll
  for (int i = 0; i < 2; ++i) { int R, C; stage_rc(tid * 16 + i * 8192, R, C); const int Rb = (R & ~31) + perm32(R & 31);
    RA[i] = R; CA[i] = C; voffB[i] = (unsigned)(Rb * S.ldb * ES + C * 2); }
  const size_t kstep = (size_t)(BK * 2);
  const size_t hstepB = (size_t)HALF * S.ldb * ES;
  const unsigned ldsw = (unsigned)wid * 1024u;
  const int aoff = lds_byte(wr * 64 + fr, fq * 8), boff = lds_byte(wc * 32 + fr, fq * 8);
#define PG8_SA(b, h) (((b) * 2 + (h)) * HTB)
#define PG8_SB(b, h) ((4 + (b) * 2 + (h)) * HTB)
#define PG8_STAGE2(bufoff, gbase, v0, v1) do { \
    __builtin_amdgcn_global_load_lds((const unsigned*)((const char*)(gbase) + (v0)), (LAS unsigned*)(lds + (bufoff) + ldsw), 16, 0, 0); \
    __builtin_amdgcn_global_load_lds((const unsigned*)((const char*)(gbase) + (v1)), (LAS unsigned*)(lds + (bufoff) + ldsw + 8192), 16, 0, 0); } while (0)
#define PG8_STAGEB(bufoff, gbase) PG8_STAGE2(bufoff, gbase, voffB[0], voffB[1])
#define PG8_LDA(dst, b, h) do { if constexpr (FP8) { _Pragma("unroll") for (int m = 0; m < 4; ++m) { const v4i_t lo_ = *(const LAS v4i_t*)(lds + PG8_SA(b, h) + aoff + m * 2048), hi_ = *(const LAS v4i_t*)(lds + PG8_SA(b, h) + aoff + m * 2048 + 1024); dst##8[m] = __builtin_shufflevector(lo_, hi_, 0, 1, 2, 3, 4, 5, 6, 7); } } \
    else { _Pragma("unroll") for (int m = 0; m < 4; ++m) _Pragma("unroll") for (int k = 0; k < 2; ++k) dst[m][k] = *(const LAS bf16x8*)(lds + PG8_SA(b, h) + aoff + m * 2048 + k * 1024); } } while (0)
#define PG8_LDB(dst, b, h) do { if constexpr (FP8) { _Pragma("unroll") for (int n = 0; n < 2; ++n) { const v4i_t lo_ = *(const LAS v4i_t*)(lds + PG8_SB(b, h) + boff + n * 2048), hi_ = *(const LAS v4i_t*)(lds + PG8_SB(b, h) + boff + n * 2048 + 1024); dst##8[n] = __builtin_shufflevector(lo_, hi_, 0, 1, 2, 3, 4, 5, 6, 7); } } \
    else { _Pragma("unroll") for (int n = 0; n < 2; ++n) _Pragma("unroll") for (int k = 0; k < 2; ++k) dst[n][k] = *(const LAS bf16x8*)(lds + PG8_SB(b, h) + boff + n * 2048 + k * 1024); } } while (0)
#define PG8_CAT(x, y) __builtin_shufflevector(__builtin_bit_cast(v4i_t, x), __builtin_bit_cast(v4i_t, y), 0, 1, 2, 3, 4, 5, 6, 7)
#define PG8_MMA(ai, bj, At, Bt) do { __builtin_amdgcn_s_setprio(1); \
    if constexpr (FP8) { _Pragma("unroll") for (int m = 0; m < 4; ++m) _Pragma("unroll") for (int n = 0; n < 2; ++n) \
        asm volatile("v_mfma_scale_f32_16x16x128_f8f6f4 %0, %1, %2, %0, %3, %3 op_sel_hi:[0,0,0]" : "+v"(acc[ai][bj][m][n]) : "v"(Bt##8[n]), "v"(At##8[m]), "v"(scl8)); } \
    else { _Pragma("unroll") for (int m = 0; m < 4; ++m) _Pragma("unroll") for (int n = 0; n < 2; ++n) _Pragma("unroll") for (int k = 0; k < 2; ++k) \
        acc[ai][bj][m][n] = __builtin_amdgcn_mfma_f32_16x16x32_bf16(Bt[n][k], At[m][k], acc[ai][bj][m][n], 0, 0, 0); } \
    __builtin_amdgcn_s_setprio(0); } while (0)
#define PG8_WAIT_V(n) asm volatile("s_waitcnt vmcnt(" #n ")" ::: "memory")
#define PG8_WAIT_L(n) asm volatile("s_waitcnt lgkmcnt(" #n ")" ::: "memory")
#define PG8_BAR __builtin_amdgcn_s_barrier()
#define PG8_SCHED __builtin_amdgcn_sched_barrier(0)
  Unit cur, nxt; int ui = 0;
  if (!S.next(0, cur)) return;
  f32x4 acc[2][2][4][2];
#pragma unroll
  for (int a = 0; a < 2; ++a)
#pragma unroll
    for (int b = 0; b < 2; ++b)
#pragma unroll
      for (int m = 0; m < 4; ++m)
#pragma unroll
        for (int n = 0; n < 2; ++n) acc[a][b][m][n] = (f32x4){0.f, 0.f, 0.f, 0.f};
  bf16x8 At[4][2], B0[2][2], B1[2][2]; v8i_t At8[4], B08[2], B18[2];
  int scl8 = 0x7f7f7f7f; asm volatile("" : "+v"(scl8));
  const char* cA = S.a_base(cur); const char* cB = S.b_base(cur);
  unsigned oC[2][2], oN[2][2];
  S.a_off(cur, RA, CA, oC);
  PG8_STAGEB(PG8_SB(0, 0), cB); PG8_STAGEB(PG8_SB(0, 1), cB + hstepB); PG8_STAGE2(PG8_SA(0, 0), cA, oC[0][0], oC[0][1]); PG8_STAGE2(PG8_SA(0, 1), cA, oC[1][0], oC[1][1]);
  if (wr == 1) PG8_BAR;
  PG8_WAIT_V(2); PG8_BAR;
  PG8_STAGEB(PG8_SB(1, 0), cB + kstep); PG8_STAGE2(PG8_SA(1, 0), cA + kstep, oC[0][0], oC[0][1]); PG8_STAGEB(PG8_SB(1, 1), cB + hstepB + kstep);
  PG8_WAIT_V(6); PG8_BAR;
  for (;;) {
    const bool has_next = S.next(ui + 1, nxt);
    const char* nA = has_next ? S.a_base(nxt) : cA; const char* nB = has_next ? S.b_base(nxt) : cB;
    if (has_next) S.a_off(nxt, RA, CA, oN);
    else {
#pragma unroll
      for (int h = 0; h < 2; ++h)
#pragma unroll
        for (int i = 0; i < 2; ++i) oN[h][i] = oC[h][i];
    }
#pragma unroll 1
    for (int t = 0; t < nt; t += 2) {
      const bool last = (t == nt - 2);
      const char* a1 = cA + (size_t)(t + 1) * kstep;
      const char* a2 = last ? nA : cA + (size_t)(t + 2) * kstep; const char* b2 = last ? nB : cB + (size_t)(t + 2) * kstep;
      const char* a3 = a2 + kstep; const char* b3 = b2 + kstep;
      const unsigned x00 = last ? oN[0][0] : oC[0][0], x01 = last ? oN[0][1] : oC[0][1], x10 = last ? oN[1][0] : oC[1][0], x11 = last ? oN[1][1] : oC[1][1];
      PG8_LDB(B0, 0, 0); PG8_LDB(B1, 0, 1); PG8_SCHED; PG8_LDA(At, 0, 0); PG8_STAGE2(PG8_SA(1, 1), a1, oC[1][0], oC[1][1]);
      PG8_WAIT_V(8); PG8_WAIT_L(0); PG8_BAR; PG8_MMA(0, 0, At, B0); PG8_MMA(0, 1, At, B1); PG8_BAR; PG8_SCHED;
      PG8_LDA(At, 0, 1); PG8_STAGEB(PG8_SB(0, 0), b2); PG8_STAGEB(PG8_SB(0, 1), b2 + hstepB); PG8_STAGE2(PG8_SA(0, 0), a2, x00, x01);
      PG8_WAIT_V(8); PG8_WAIT_L(0); PG8_BAR; PG8_MMA(1, 0, At, B0); PG8_MMA(1, 1, At, B1); PG8_BAR; PG8_SCHED;
      PG8_LDB(B0, 1, 0); PG8_LDB(B1, 1, 1); PG8_SCHED; PG8_LDA(At, 1, 0); PG8_STAGE2(PG8_SA(0, 1), a2, x10, x11);
      PG8_WAIT_V(8); PG8_WAIT_L(0); PG8_BAR; PG8_MMA(0, 0, At, B0); PG8_MMA(0, 1, At, B1); PG8_BAR; PG8_SCHED;
      PG8_LDA(At, 1, 1); PG8_STAGEB(PG8_SB(1, 0), b3); PG8_STAGEB(PG8_SB(1, 1), b3 + hstepB); PG8_STAGE2(PG8_SA(1, 0), a3, x00, x01);
      PG8_WAIT_V(8); PG8_WAIT_L(0); PG8_BAR; PG8_MMA(1, 0, At, B0); PG8_MMA(1, 1, At, B1); PG8_BAR; PG8_SCHED;
    }
    if constexpr (FP8) {
#pragma unroll
      for (int a = 0; a < 2; ++a)
#pragma unroll
        for (int b = 0; b < 2; ++b)
          asm volatile("s_nop 15\n\ts_nop 15" : "+v"(acc[a][b][0][0]), "+v"(acc[a][b][0][1]), "+v"(acc[a][b][1][0]), "+v"(acc[a][b][1][1]), "+v"(acc[a][b][2][0]), "+v"(acc[a][b][2][1]), "+v"(acc[a][b][3][0]), "+v"(acc[a][b][3][1]));
    }
    if (wr == 0) PG8_BAR;
    E(acc, cur, wr, wc, fr, fq);
#ifdef EXP_EPI2
    if constexpr (FP8) E(acc, cur, wr, wc, fr, fq);
#endif
    if (!has_next) break;
#pragma unroll
    for (int a = 0; a < 2; ++a)
#pragma unroll
      for (int b = 0; b < 2; ++b)
#pragma unroll
        for (int m = 0; m < 4; ++m)
#pragma unroll
          for (int n = 0; n < 2; ++n) acc[a][b][m][n] = (f32x4){0.f, 0.f, 0.f, 0.f};
    cur = nxt; cA = nA; cB = nB; ++ui;
#pragma unroll
    for (int h = 0; h < 2; ++h)
#pragma unroll
      for (int i = 0; i < 2; ++i) oC[h][i] = oN[h][i];
    if (wr == 1) PG8_BAR;
  }
  PG8_WAIT_V(0);
  PG8_BAR;
#undef PG8_SA
#undef PG8_SB
#undef PG8_STAGE2
#undef PG8_STAGEB
#undef PG8_LDA
#undef PG8_LDB
#undef PG8_MMA
#undef PG8_CAT
#undef PG8_WAIT_V
#undef PG8_WAIT_L
#undef PG8_BAR
#undef PG8_SCHED
}
}

typedef f32x4 AccT[2][2][4][2];
__device__ __forceinline__ u32x4 pack8(const f32x4 a, const f32x4 b) { u32x4 w; w.x = cvt_pk_bf16(a[0], a[1]); w.y = cvt_pk_bf16(a[2], a[3]); w.z = cvt_pk_bf16(b[0], b[1]); w.w = cvt_pk_bf16(b[2], b[3]); return w; }
__device__ __forceinline__ float clamp448(float x) { return __builtin_amdgcn_fmed3f(x, -448.f, 448.f); }
__device__ __forceinline__ unsigned pack4_fp8(float a, float b, float c, float d) {
  int w = 0; w = __builtin_amdgcn_cvt_pk_fp8_f32(clamp448(a), clamp448(b), w, false); w = __builtin_amdgcn_cvt_pk_fp8_f32(clamp448(c), clamp448(d), w, true); return (unsigned)w; }
__device__ __forceinline__ u32x2 pack8_fp8(const f32x4 a, const f32x4 b) { u32x2 w; w.x = pack4_fp8(a[0], a[1], a[2], a[3]); w.y = pack4_fp8(b[0], b[1], b[2], b[3]); return w; }
constexpr float W8_SCALE = 32.f, H8_SCALE = 4.f;
__device__ __forceinline__ void rope8(f32x4& v0, f32x4& v1, int fq, int prow, int pcol, const f32x2* tab) {
  const f32x2* tp = tab + (fq < 2 ? prow : pcol) * 8;
#pragma unroll
  for (int n = 0; n < 2; ++n)
#pragma unroll
    for (int j = 0; j < 4; ++j) {
      const float x = n == 0 ? v0[j] : v1[j];
      const float p = __shfl_xor(x, 16);
      const f32x2 cs = tp[4 * n + j];
      const float o = (fq & 1) ? (p * cs.y + x * cs.x) : (x * cs.x - p * cs.y);
      if (n == 0) v0[j] = o; else v1[j] = o;
    }
}
struct EpiInProj0 {
  bf16_t* FTL; bf16_t* FTC; bf16_t* P2; bf16_t* Kb; float* ssq; const f32x2* ropeA;
  __device__ __forceinline__ void operator()(const AccT& acc, const pg8::Unit& u, int wr, int wc, int fr, int fq) const {
    const int b = u.pm / 33; const bool isctx = (u.pm % 33) == 0;
#pragma unroll
    for (int ai = 0; ai < 2; ++ai)
#pragma unroll
      for (int m = 0; m < 4; ++m) {
        const int row = u.pm * 256 + ai * 128 + wr * 64 + m * 16 + fr, i = row - b * T;
        if (u.pn < 2) {
#pragma unroll
          for (int bj = 0; bj < 2; ++bj) {
            const int c0 = u.pn * 256 + bj * 128 + wc * 32 + 8 * fq, cb = c0 >> 2;
            const f32x4 v0 = acc[ai][bj][m][0], v1 = acc[ai][bj][m][1];
            u32x2 w0, w1; w0.x = cvt_pk_bf16(v0[0], v0[1]); w0.y = cvt_pk_bf16(v0[2], v0[3]); w1.x = cvt_pk_bf16(v1[0], v1[1]); w1.y = cvt_pk_bf16(v1[2], v1[3]);
            bf16_t* d = isctx ? FTC + ((size_t)(b * 128 + cb) * 256 + i) * 4 : FTL + ((size_t)(b * 128 + cb) * 8192 + (i - 256)) * 4;
            *(u32x2*)d = w0; *(u32x2*)(d + (isctx ? 256 * 4 : 8192 * 4)) = w1;
          }
        } else if (u.pn == 2) {
          float ss = 0.f;
#pragma unroll
          for (int bj = 0; bj < 2; ++bj) {
            const f32x4 v0 = acc[ai][bj][m][0], v1 = acc[ai][bj][m][1];
            ss += (v0[0] * v0[0] + v0[1] * v0[1]) + (v0[2] * v0[2] + v0[3] * v0[3]) + (v1[0] * v1[0] + v1[1] * v1[1]) + (v1[2] * v1[2] + v1[3] * v1[3]);
            *(u32x4*)(P2 + (size_t)row * 384 + bj * 128 + wc * 32 + 8 * fq) = pack8(v0, v1);
          }
          ss += __shfl_xor(ss, 16); ss += __shfl_xor(ss, 32);
          if (fq == 0) ssq[row * 8 + wc] = ss;
        } else {
          { const f32x4 v0 = acc[ai][0][m][0], v1 = acc[ai][0][m][1];
            float ss = (v0[0] * v0[0] + v0[1] * v0[1]) + (v0[2] * v0[2] + v0[3] * v0[3]) + (v1[0] * v1[0] + v1[1] * v1[1]) + (v1[2] * v1[2] + v1[3] * v1[3]);
            *(u32x4*)(P2 + (size_t)row * 384 + 256 + wc * 32 + 8 * fq) = pack8(v0, v1);
            ss += __shfl_xor(ss, 16); ss += __shfl_xor(ss, 32);
            if (fq == 0) ssq[row * 8 + 4 + wc] = ss; }
          if (wc == 0) {
            f32x4 v0 = acc[ai][1][m][0], v1 = acc[ai][1][m][1];
            if (!isctx) { const int s = i - 256; rope8(v0, v1, fq, s >> 6, s & 63, ropeA); }
            const u32x4 w = pack8(v0, v1);
#pragma unroll
            for (int h = 0; h < 8; ++h) *(u32x4*)(Kb + (size_t)row * 768 + h * 96 + 64 + 8 * fq) = w;
          }
        }
      }
  }
};
struct EpiQ {
  bf16_t* Q; const float* ssq; const f32x2* ropeA;
  __device__ __forceinline__ void operator()(const AccT& acc, const pg8::Unit& u, int wr, int wc, int fr, int fq) const {
    const int b = u.pm / 33; const bool isctx = (u.pm % 33) == 0;
#pragma unroll
    for (int ai = 0; ai < 2; ++ai)
#pragma unroll
      for (int m = 0; m < 4; ++m) {
        const int row = u.pm * 256 + ai * 128 + wr * 64 + m * 16 + fr, i = row - b * T, s = i - 256;
        const f32x4 s4 = *(const f32x4*)(ssq + row * 8); const float rstd = rsqrtf(((s4[0] + s4[1]) + (s4[2] + s4[3])) * (1.f / 256.f) + EPS);
#pragma unroll
        for (int bj = 0; bj < 2; ++bj) {
          const int g32 = u.pn * 8 + bj * 4 + wc;
          f32x4 v0 = acc[ai][bj][m][0] * rstd, v1 = acc[ai][bj][m][1] * rstd;
          if ((g32 % 3) == 2 && !isctx) rope8(v0, v1, fq, s >> 6, s & 63, ropeA);
          *(u32x4*)(Q + (size_t)row * 768 + g32 * 32 + 8 * fq) = pack8(v0, v1);
          asm volatile("" ::: "memory");
        }
      }
  }
};
struct EpiKV {
  bf16_t* Kb; bf16_t* Vb; const float* ssq;
  __device__ __forceinline__ void operator()(const AccT& acc, const pg8::Unit& u, int wr, int wc, int fr, int fq) const {
#pragma unroll
    for (int ai = 0; ai < 2; ++ai)
#pragma unroll
      for (int m = 0; m < 4; ++m) {
        const int row = u.pm * 256 + ai * 128 + wr * 64 + m * 16 + fr;
        const f32x4 s4 = *(const f32x4*)(ssq + row * 8 + 4); const float rstd = rsqrtf(((s4[0] + s4[1]) + (s4[2] + s4[3])) * (1.f / 128.f) + EPS);
#pragma unroll
        for (int bj = 0; bj < 2; ++bj) {
          const int head = u.pn * 2 + bj, d = wc * 32 + 8 * fq;
          const u32x4 w = pack8(acc[ai][bj][m][0] * rstd, acc[ai][bj][m][1] * rstd);
          if (wc < 2) *(u32x4*)(Kb + (size_t)row * 768 + head * 96 + d) = w; else *(u32x4*)(Vb + (size_t)row * 512 + head * 64 + (d - 64)) = w;
        }
        asm volatile("" ::: "memory");
      }
  }
};
struct EpiQKV { EpiQ q; EpiKV kv;
  __device__ __forceinline__ void operator()(const AccT& acc, const pg8::Unit& u, int wr, int wc, int fr, int fq) const { if (u.z == 0) q(acc, u, wr, wc, fr, fq); else kv(acc, u, wr, wc, fr, fq); } };
struct EpiBf16 {
  bf16_t* O; int ldo;
  __device__ __forceinline__ void operator()(const AccT& acc, const pg8::Unit& u, int wr, int wc, int fr, int fq) const {
#pragma unroll
    for (int ai = 0; ai < 2; ++ai)
#pragma unroll
      for (int m = 0; m < 4; ++m) {
        const size_t row = (size_t)u.pm * 256 + ai * 128 + wr * 64 + m * 16 + fr;
#pragma unroll
        for (int bj = 0; bj < 2; ++bj) *(u32x4*)(O + row * ldo + u.pn * 256 + bj * 128 + wc * 32 + 8 * fq) = pack8(acc[ai][bj][m][0], acc[ai][bj][m][1]);
      }
  }
};
template <bool FIRST> struct EpiResid {
  float* H; const float* modl; const float* x; const float* ctx;
  __device__ __forceinline__ void operator()(const AccT& acc, const pg8::Unit& u, int wr, int wc, int fr, int fq) const {
    const int b = u.pm / 33, pt = u.pm % 33; const bool isctx = pt == 0;
    const float* g1 = modl + (isctx ? 2 : b) * 6144 + 2048;
    const float* src = FIRST ? (isctx ? ctx + (size_t)b * L * D : x + ((size_t)b * S + (size_t)(pt - 1) * 256) * D) : H + (size_t)u.pm * 256 * D;
#pragma unroll
    for (int bj = 0; bj < 2; ++bj) {
      const int c0 = u.pn * 256 + bj * 128 + wc * 32 + 8 * fq;
      const f32x4 ga = *(const f32x4*)(g1 + c0), gb = *(const f32x4*)(g1 + c0 + 4);
#pragma unroll
      for (int ai = 0; ai < 2; ++ai)
#pragma unroll
        for (int m = 0; m < 4; ++m) {
          const size_t ro = (size_t)(ai * 128 + wr * 64 + m * 16 + fr) * D + c0;
          const float* sp = src + ro; float* hp = H + (size_t)u.pm * 256 * D + ro;
          const f32x4 h0 = *(const f32x4*)sp, h1 = *(const f32x4*)(sp + 4);
          *(f32x4*)hp = h0 + ga * acc[ai][bj][m][0]; *(f32x4*)(hp + 4) = h1 + gb * acc[ai][bj][m][1];
        }
    }
  }
};
template <bool F8> struct EpiGateUp {
  void* H1;
  __device__ __forceinline__ void operator()(const AccT& acc, const pg8::Unit& u, int wr, int wc, int fr, int fq) const {
    constexpr float ws = F8 ? 1.f / W8_SCALE : 1.f, hs = F8 ? H8_SCALE : 1.f;
#pragma unroll
    for (int ai = 0; ai < 2; ++ai)
#pragma unroll
      for (int m = 0; m < 4; ++m) {
        const size_t prow = (size_t)u.z * PR + u.pm * 256 + ai * 128 + wr * 64 + m * 16 + fr;
        f32x4 o0, o1;
#pragma unroll
        for (int j = 0; j < 4; ++j) { o0[j] = siluf(acc[ai][0][m][0][j] * ws) * (acc[ai][1][m][0][j] * (ws * hs)); o1[j] = siluf(acc[ai][0][m][1][j] * ws) * (acc[ai][1][m][1][j] * (ws * hs)); }
        const size_t off = prow * FF + u.pn * 128 + wc * 32 + 8 * fq;
        if constexpr (F8) *(u32x2*)((unsigned char*)H1 + off) = pack8_fp8(o0, o1); else *(u32x4*)((bf16_t*)H1 + off) = pack8(o0, o1);
      }
  }
};
template <bool F8> struct EpiDown {
  bf16_t* Y2;
  __device__ __forceinline__ void operator()(const AccT& acc, const pg8::Unit& u, int wr, int wc, int fr, int fq) const {
    constexpr float sc = F8 ? 1.f / (W8_SCALE * H8_SCALE) : 1.f;
#pragma unroll
    for (int ai = 0; ai < 2; ++ai)
#pragma unroll
      for (int m = 0; m < 4; ++m) {
        const size_t prow = (size_t)u.z * PR + u.pm * 256 + ai * 128 + wr * 64 + m * 16 + fr;
#pragma unroll
        for (int bj = 0; bj < 2; ++bj) *(u32x4*)(Y2 + prow * D + u.pn * 256 + bj * 128 + wc * 32 + 8 * fq) = pack8(acc[ai][bj][m][0] * sc, acc[ai][bj][m][1] * sc);
      }
  }
};
struct EpiInProj1 {
  bf16_t* QKR; bf16_t* Vb;
  __device__ __forceinline__ void operator()(const AccT& acc, const pg8::Unit& u, int wr, int wc, int fr, int fq) const {
#pragma unroll
    for (int ai = 0; ai < 2; ++ai)
#pragma unroll
      for (int m = 0; m < 4; ++m) {
        const size_t row = (size_t)u.pm * 256 + ai * 128 + wr * 64 + m * 16 + fr;
#pragma unroll
        for (int bj = 0; bj < 2; ++bj) {
          const int c0 = u.pn * 256 + bj * 128 + wc * 32 + 8 * fq;
          if (u.pn < 5) *(u32x4*)(QKR + row * 1280 + c0) = pack8(acc[ai][bj][m][0], acc[ai][bj][m][1]);
          else *(u32x4*)(Vb + row * 256 + (c0 - 1280)) = pack8(acc[ai][bj][m][0], acc[ai][bj][m][1]);
        }
      }
  }
};

__device__ __forceinline__ f32x2 cmul(f32x2 a, f32x2 b) { return (f32x2){a.x * b.x - a.y * b.y, a.x * b.y + a.y * b.x}; }
template <int N, int LOGN>
__device__ __forceinline__ void fft_item(LAS f32x2* d, const LAS f32x2* T1, const LAS f32x2* T2, const bf16_t* src, bf16_t* yc_row0, int kcol, float norm, int tid) {
  for (int c = tid; c < N / 2; c += NTHR) {
    const u32x4 w = *(const u32x4*)(src + (size_t)c * 8);
    *(LAS f32x4*)(d + 2 * c) = (f32x4){bflo(w.x), bfhi(w.x), bflo(w.z), bfhi(w.z)};
    *(LAS f32x4*)(d + N + 2 * c) = (f32x4){bflo(w.y), bfhi(w.y), bflo(w.w), bfhi(w.w)};
  }
  __syncthreads();
#pragma unroll 1
  for (int h = N / 2; h >= 2; h >>= 2) {
    const int hh = h >> 1, tmul = 4096 / h;
    for (int q = tid; q < N / 2; q += NTHR) {
      const int seq = q >= (N / 4) ? 1 : 0, qq = q & (N / 4 - 1);
      const int pos = qq & (hh - 1), i0 = seq * N + ((qq - pos) << 2) + pos;
      const f32x2 x0 = d[i0], x1 = d[i0 + hh], x2 = d[i0 + h], x3 = d[i0 + h + hh];
      const int tw = pos * tmul;
      const f32x2 w1 = cmul(T2[tw >> 6], T1[tw & 63]);
      const f32x2 w2 = (f32x2){w1.x * w1.x - w1.y * w1.y, 2.f * w1.x * w1.y};
      const f32x2 a0 = x0 + x2, a2 = cmul(x0 - x2, w1), a1 = x1 + x3, t3 = cmul(x1 - x3, w1), a3 = (f32x2){t3.y, -t3.x};
      d[i0] = a0 + a1; d[i0 + hh] = cmul(a0 - a1, w2); d[i0 + h] = a2 + a3; d[i0 + h + hh] = cmul(a2 - a3, w2);
    }
    __syncthreads();
  }
  if ((LOGN & 1) == 1) {
    for (int j = tid; j < N; j += NTHR) { const int seq = j >= (N / 2) ? 1 : 0, jj = j & (N / 2 - 1), i0 = seq * N + 2 * jj; const f32x2 a = d[i0], bb = d[i0 + 1]; d[i0] = a + bb; d[i0 + 1] = a - bb; }
    __syncthreads();
  }
  for (int m = tid; m < N; m += NTHR) {
    const int k = (int)(__brev((unsigned)m) >> (32 - LOGN)), km = (N - k) & (N - 1), mp = (int)(__brev((unsigned)km) >> (32 - LOGN));
    const f32x2 A0 = d[m], B0 = d[mp], A1 = d[N + m], B1 = d[N + mp];
    const float hn = 0.5f * norm;
    u32x4 w;
    w.x = cvt_pk_bf16((A0.x + B0.x) * hn, (A0.y - B0.y) * hn);
    w.y = cvt_pk_bf16((A0.y + B0.y) * hn, (B0.x - A0.x) * hn);
    w.z = cvt_pk_bf16((A1.x + B1.x) * hn, (A1.y - B1.y) * hn);
    w.w = cvt_pk_bf16((A1.y + B1.y) * hn, (B1.x - A1.x) * hn);
    *(u32x4*)(yc_row0 + (size_t)k * D + kcol) = w;
  }
  __syncthreads();
}
__device__ __forceinline__ void fft_phase(LAS unsigned char* lds, const bf16_t* FTL, const bf16_t* FTC, bf16_t* YC, int G) {
  const int tid = threadIdx.x;
  LAS f32x2* d = (LAS f32x2*)lds; LAS f32x2* T1 = (LAS f32x2*)(lds + LDS_TAB); LAS f32x2* T2 = T1 + 64;
  if (tid < 128) { const int j = tid & 63; float s, c; sincos_acc(6.283185307179586476925 * (double)(tid < 64 ? j : 64 * j) / 8192.0, s, c); (tid < 64 ? T1 : T2)[j] = (f32x2){c, -s}; }
  __syncthreads();
  for (int it = blockIdx.x; it < 256; it += G) {
    const int b = it >> 7, cb = it & 127, kcol = (cb >> 5) * 256 + (cb & 31) * 8;
    fft_item<8192, 13>(d, T1, T2, FTL + (size_t)(b * 128 + cb) * 8192 * 4, YC + ((size_t)b * T + 256) * D, kcol, 1.0f / 1024.0f, tid);
    fft_item<256, 8>(d, T1, T2, FTC + (size_t)(b * 128 + cb) * 256 * 4, YC + ((size_t)b * T) * D, kcol, 0.0055242717280199f  , tid);
  }
}

#ifndef ATT3_PLAIN
#define ATT3_PLAIN 4
#endif
namespace att {
constexpr int NW = 8, QBLK = 32, KVBLK = 64;
constexpr size_t SHM_V = KVBLK * 128 * 2, SHM_K = KVBLK * 128 * 2;
#define KSWZ(row, colB) ((row) * 256 + ((colB) ^ (((row) & 7) << 4)))
#define SBAR() __builtin_amdgcn_sched_barrier(0)
__device__ __forceinline__ int crow(int r, int hi) { return (r & 3) + 8 * (r >> 2) + 4 * hi; }
template <int CSCALE_NUM> struct Dummy {};
__device__ __forceinline__ void partialSM(f32x16& p0, f32x16& p1, float& m_reg, float& mn, float& alpha, const float C, const float THRS) {
  float pmax = p0[0];
#pragma unroll
  for (int r = 1; r < 16; ++r) pmax = fmaxf(pmax, p0[r]);
#pragma unroll
  for (int r = 0; r < 16; ++r) pmax = fmaxf(pmax, p1[r]);
  { auto rr = __builtin_amdgcn_permlane32_swap(__float_as_uint(pmax), __float_as_uint(pmax), false, false);
    pmax = fmaxf(__uint_as_float(rr[0]), __uint_as_float(rr[1])); }
  if (__builtin_expect(__all(pmax - m_reg <= THRS), 1)) { mn = m_reg; alpha = 1.f; }
  else { mn = fmaxf(m_reg, pmax); alpha = __builtin_amdgcn_exp2f((m_reg - mn) * C); m_reg = mn; }
  const float mnC = -mn * C;
#pragma unroll
  for (int r = 0; r < 16; ++r) p0[r] = fmaf(p0[r], C, mnC);
#pragma unroll
  for (int r = 0; r < 16; ++r) p1[r] = fmaf(p1[r], C, mnC);
#pragma unroll
  for (int r = 0; r < 16; ++r) p0[r] = __builtin_amdgcn_exp2f(p0[r]);
}
__device__ __forceinline__ void finishSM(f32x16& p0, f32x16& p1, float alpha, float& l_reg, bf16x8& pa0, bf16x8& pa1, bf16x8& pa2, bf16x8& pa3) {
#pragma unroll
  for (int r = 0; r < 16; ++r) p1[r] = __builtin_amdgcn_exp2f(p1[r]);
  float ps = 0;
#pragma unroll
  for (int r = 0; r < 16; ++r) ps += p0[r];
#pragma unroll
  for (int r = 0; r < 16; ++r) ps += p1[r];
  { auto rr = __builtin_amdgcn_permlane32_swap(__float_as_uint(ps), __float_as_uint(ps), false, false);
    ps = __uint_as_float(rr[0]) + __uint_as_float(rr[1]); }
  l_reg = l_reg * alpha + ps;
#define PK4(P, BASE, OUT) do { unsigned a0 = cvt_pk_bf16(P[BASE + 0], P[BASE + 1]), a1 = cvt_pk_bf16(P[BASE + 2], P[BASE + 3]);   \
    unsigned b0 = cvt_pk_bf16(P[BASE + 4], P[BASE + 5]), b1 = cvt_pk_bf16(P[BASE + 6], P[BASE + 7]);                              \
    auto r0 = __builtin_amdgcn_permlane32_swap(a0, b0, false, false); auto r1 = __builtin_amdgcn_permlane32_swap(a1, b1, false, false); \
    u32x4 w = {r0[0], r1[0], r0[1], r1[1]}; OUT = *reinterpret_cast<bf16x8*>(&w); } while (0)
  PK4(p0, 0, pa0); PK4(p0, 8, pa1); PK4(p1, 0, pa2); PK4(p1, 8, pa3);
#undef PK4
}
template <int DK>
__device__ __forceinline__ void qkt(f32x16& p0, f32x16& p1, const char* Ks, const bf16x8* qr, int r32, int hi) {
  p0 = f32x16{}; p1 = f32x16{};
#pragma unroll
  for (int d0 = 0; d0 < DK / 16; ++d0) { const int cb = (d0 * 16 + hi * 8) * 2;
    const bf16x8 b0 = *reinterpret_cast<const bf16x8*>(Ks + KSWZ(r32, cb));
    const bf16x8 b1 = *reinterpret_cast<const bf16x8*>(Ks + KSWZ(32 + r32, cb));
    p0 = __builtin_amdgcn_mfma_f32_32x32x16_bf16(b0, qr[d0], p0, 0, 0, 0);
    p1 = __builtin_amdgcn_mfma_f32_32x32x16_bf16(b1, qr[d0], p1, 0, 0, 0); }
}
__device__ __forceinline__ int v_st(int k, int c) { const int kk = (k & ~0xC) | ((k & 4) << 1) | ((k & 8) >> 1); return ((kk >> 3) * 4 + (c >> 5)) * 512 + ((kk & 7) * 32 + (c & 31)) * 2; }
__device__ __forceinline__ int v_rd_base(int lane) { return ((lane & 3) << 3) | (((lane >> 2) & 3) << 6) | (((lane >> 4) & 1) << 5) | (((lane >> 5) & 1) << 8); }
constexpr int v_rd_off(int d0, int ks, int half) { return d0 * 512 + ks * 4096 + half * 2048; }
template <int OFF> __device__ __forceinline__ s16x4 tr_read(int vb) {
  s16x4 r; asm volatile("ds_read_b64_tr_b16 %0, %1 offset:%2" : "=&v"(r) : "v"(vb), "i"(OFF) : "memory"); return r;
}
template <int D0> __device__ __forceinline__ void pv_one(f32x16& od, int vb, bf16x8 pa0, bf16x8 pa1, bf16x8 pa2, bf16x8 pa3) {
  const s16x4 l0 = tr_read<v_rd_off(D0, 0, 0)>(vb), h0 = tr_read<v_rd_off(D0, 0, 1)>(vb), l1 = tr_read<v_rd_off(D0, 1, 0)>(vb), h1 = tr_read<v_rd_off(D0, 1, 1)>(vb);
  const s16x4 l2 = tr_read<v_rd_off(D0, 2, 0)>(vb), h2 = tr_read<v_rd_off(D0, 2, 1)>(vb), l3 = tr_read<v_rd_off(D0, 3, 0)>(vb), h3 = tr_read<v_rd_off(D0, 3, 1)>(vb);
  asm volatile("s_waitcnt lgkmcnt(0)" ::: "memory"); SBAR();
#define PK(Lo, Hi) (bf16x8){Lo[0], Lo[1], Lo[2], Lo[3], Hi[0], Hi[1], Hi[2], Hi[3]}
  od = __builtin_amdgcn_mfma_f32_32x32x16_bf16(pa0, PK(l0, h0), od, 0, 0, 0);
  od = __builtin_amdgcn_mfma_f32_32x32x16_bf16(pa1, PK(l1, h1), od, 0, 0, 0);
  od = __builtin_amdgcn_mfma_f32_32x32x16_bf16(pa2, PK(l2, h2), od, 0, 0, 0);
  od = __builtin_amdgcn_mfma_f32_32x32x16_bf16(pa3, PK(l3, h3), od, 0, 0, 0);
#undef PK
}
template <int DV> __device__ __forceinline__ void pv_all(f32x16* o, int vb, bf16x8 pa0, bf16x8 pa1, bf16x8 pa2, bf16x8 pa3) {
  pv_one<0>(o[0], vb, pa0, pa1, pa2, pa3); pv_one<1>(o[1], vb, pa0, pa1, pa2, pa3);
  if constexpr (DV == 128) { pv_one<2>(o[2], vb, pa0, pa1, pa2, pa3); pv_one<3>(o[3], vb, pa0, pa1, pa2, pa3); }
}
__device__ __forceinline__ __amdgpu_buffer_rsrc_t make_rsrc(const void* p) {
  const unsigned lo = __builtin_amdgcn_readfirstlane((unsigned)(uintptr_t)p), hi = __builtin_amdgcn_readfirstlane((unsigned)((uintptr_t)p >> 32));
  return __builtin_amdgcn_make_buffer_rsrc((void*)(((uintptr_t)hi << 32) | lo), 0, 0x7fffffff, 0x00020000);
}
struct NoHook { static constexpr int VM_EXTRA = 0; __device__ __forceinline__ void step() {} };
template <int DK, int DV, int ldq, int ldk, int ldv, int ldo, int SDEPTH, class Hook>
__device__ __forceinline__ void attn_unit(const bf16_t* __restrict__ Qb, const bf16_t* __restrict__ Kh, const bf16_t* __restrict__ Vh,
                                          bf16_t* __restrict__ Ob, int seq, char* lds, Hook& hk) {
  constexpr float C = (DK == 96 ? 0.10206207261596577f : 0.08838834764831845f) * 1.4426950408889634f;
  constexpr int NKC = 16, NVC = DV / 8;
  constexpr int NKL = (64 * NKC + 511) / 512, NVL = (64 * NVC + 511) / 512;
  constexpr float THRS = 8.0f * 1.4426950408889634f / C;
  const int tid = threadIdx.x, wid = tid >> 6, lane = tid & 63, r32 = lane & 31, hi = lane >> 5;
  char* V_lds = lds; char* K_lds = lds + 2 * SHM_V;
  float* ws = (float*)(lds + 2 * SHM_V + 2 * SHM_K) + wid * 64; float* li_l = ws; float* al_l = ws + 32;
  float m_reg = -1e30f, l_reg = 0; f32x16 o[DV / 32]; bf16x8 qr[DK / 16];
#pragma unroll
  for (int d = 0; d < DV / 32; ++d) o[d] = f32x16{};
  { const unsigned qoff = (unsigned)((wid * QBLK + r32) * ldq + hi * 8) * 2u;
#pragma unroll
    for (int d0 = 0; d0 < DK / 16; ++d0) qr[d0] = *reinterpret_cast<const bf16x8*>((const char*)Qb + (qoff + d0 * 32)); }
  static_assert(64 * NKC == 512 * NKL && 64 * NVC == 512 * NVL, "every staging chunk is valid");
  int krow[NKL], kch[NKL], vrow[NVL], vch[NVL];
#pragma unroll
  for (int i = 0; i < NKL; ++i) { const int ci = tid + 512 * i; krow[i] = ci / NKC; kch[i] = ci % NKC; }
#pragma unroll
  for (int i = 0; i < NVL; ++i) { const int ci = tid + 512 * i; vrow[i] = ci / NVC; vch[i] = ci % NVC; }
  unsigned koff[NKL], voff[NVL];
#pragma unroll
  for (int i = 0; i < NKL; ++i) koff[i] = (unsigned)(krow[i] * ldk + kch[i] * 8) * 2u;
#pragma unroll
  for (int i = 0; i < NVL; ++i) voff[i] = (unsigned)(vrow[i] * ldv + vch[i] * 8) * 2u;
  const int vb0 = (int)(uintptr_t)V_lds + v_rd_base(lane);
  struct { bf16x8 v[NVL], k[NKL]; } sr_[SDEPTH];
  const __amdgpu_buffer_rsrc_t rsK = make_rsrc(Kh), rsV = make_rsrc(Vh);
#define SLOAD(i, k0) do { const int vso_ = (k0) * (ldv * 2), kso_ = (k0) * (ldk * 2); \
    _Pragma("unroll") for (int q = 0; q < NVL; ++q) sr_[i].v[q] = __builtin_bit_cast(bf16x8, __builtin_amdgcn_raw_buffer_load_b128(rsV, (int)voff[q], vso_, 0)); \
    _Pragma("unroll") for (int q = 0; q < NKL; ++q) sr_[i].k[q] = __builtin_bit_cast(bf16x8, __builtin_amdgcn_raw_buffer_load_b128(rsK, (int)koff[q], kso_, 0)); } while (0)
#define SWRITE(b, i) do { _Pragma("unroll") for (int q = 0; q < NVL; ++q) *(bf16x8*)(V_lds + (b) * SHM_V + v_st(vrow[q], vch[q] * 8)) = sr_[i].v[q]; \
    _Pragma("unroll") for (int q = 0; q < NKL; ++q) *(bf16x8*)(K_lds + (b) * SHM_K + KSWZ(krow[q], kch[q] * 16)) = sr_[i].k[q]; } while (0)
#define SWAIT() asm volatile("s_waitcnt vmcnt(%0)" :: "n"(SDEPTH == 2 ? NVL + NKL : 0) : "memory")
#define SWAIT2() asm volatile("s_waitcnt vmcnt(%0)" :: "n"((SDEPTH == 2 ? NVL + NKL : 0) + Hook::VM_EXTRA) : "memory")
#define RESC(a) do { if (__any((a) < 1.f)) { if (hi == 0) al_l[r32] = (a); asm volatile("s_waitcnt lgkmcnt(0)" ::: "memory"); \
    _Pragma("unroll") for (int d = 0; d < DV / 32; ++d) _Pragma("unroll") for (int r = 0; r < 16; ++r) o[d][r] *= al_l[crow(r, hi)]; } } while (0)
  f32x16 pA0, pA1, pB0, pB1; float mnA, mnB, alA, alB; bf16x8 pa0, pa1, pa2, pa3; const int NT = seq / KVBLK;
#ifdef ATT_PRIO
  if (wid >= 4) __builtin_amdgcn_s_setprio(1);
#endif
  constexpr int SE = 0, SO = SDEPTH - 1;
  SLOAD(SE, 0); asm volatile("s_waitcnt vmcnt(0)" ::: "memory"); SWRITE(0, SE); __syncthreads();
  qkt<DK>(pA0, pA1, K_lds, qr, r32, hi); partialSM(pA0, pA1, m_reg, mnA, alA, C, THRS);
  SLOAD(SO, KVBLK); if constexpr (SDEPTH == 2) SLOAD(SE, 2 * KVBLK);
  SWAIT(); SWRITE(1, SO); __syncthreads();
  for (int j = 1; j + 1 < NT; j += 2) {
    SBAR(); qkt<DK>(pB0, pB1, K_lds + SHM_K, qr, r32, hi);
    finishSM(pA0, pA1, alA, l_reg, pa0, pa1, pa2, pa3);
    hk.step();
    SBAR();
    SLOAD(SO, (j + SDEPTH) * KVBLK); SBAR();
    pv_all<DV>(o, vb0, pa0, pa1, pa2, pa3); partialSM(pB0, pB1, m_reg, mnB, alB, C, THRS);
    __syncthreads(); SWAIT2(); SWRITE(0, SE);
    RESC(alB); __syncthreads();
    SBAR(); qkt<DK>(pA0, pA1, K_lds, qr, r32, hi);
    finishSM(pB0, pB1, alB, l_reg, pa0, pa1, pa2, pa3); SBAR();
    { const int tn = (j + 1 + SDEPTH) < NT ? (j + 1 + SDEPTH) : NT - 1; SLOAD(SE, tn * KVBLK); } SBAR();
    pv_all<DV>(o, vb0 + (int)SHM_V, pa0, pa1, pa2, pa3); partialSM(pA0, pA1, m_reg, mnA, alA, C, THRS);
    __syncthreads(); SWAIT(); SWRITE(1, SO);
    RESC(alA); __syncthreads();
  }
  SBAR(); qkt<DK>(pB0, pB1, K_lds + SHM_K, qr, r32, hi);
  finishSM(pA0, pA1, alA, l_reg, pa0, pa1, pa2, pa3); SBAR();
  pv_all<DV>(o, vb0, pa0, pa1, pa2, pa3); partialSM(pB0, pB1, m_reg, mnB, alB, C, THRS);
  __syncthreads(); RESC(alB);
  finishSM(pB0, pB1, alB, l_reg, pa0, pa1, pa2, pa3); SBAR();
  pv_all<DV>(o, vb0 + (int)SHM_V, pa0, pa1, pa2, pa3);
  if (hi == 0) li_l[r32] = l_reg; asm volatile("s_waitcnt lgkmcnt(0)" ::: "memory");
  unsigned ooff = (unsigned)((wid * QBLK + 4 * hi) * ldo + r32) * 2u;
  asm volatile("" : "+v"(ooff));
#pragma unroll
  for (int r = 0; r < 16; ++r) { const float rl = __builtin_amdgcn_rcpf(li_l[crow(r, hi)]);
    char* orow = (char*)Ob + (size_t)(((r & 3) + 8 * (r >> 2)) * ldo) * 2;
#pragma unroll
    for (int d0 = 0; d0 < DV / 32; ++d0) *(bf16_t*)(orow + (ooff + d0 * 64)) = (bf16_t)(cvt_pk_bf16(o[d0][r] * rl, 0.f) & 0xffffu);
    asm volatile("" ::: "memory"); }
#ifdef ATT_PRIO
  __builtin_amdgcn_s_setprio(0);
#endif
  __syncthreads();
#undef SLOAD
#undef SWRITE
#undef SWAIT
#undef SWAIT2
#undef RESC
}


typedef short v4i16_t __attribute__((ext_vector_type(4)));
typedef __attribute__((address_space(3))) const char* lds_cptr;
__device__ __forceinline__ s16x4 vtr(lds_cptr p) { return __builtin_bit_cast(s16x4, __builtin_amdgcn_ds_read_tr16_b64_v4i16((__attribute__((address_space(3))) v4i16_t*)p)); }
template <int DK, int DV, bool DOQK>
__device__ __forceinline__ void mseg_compute(f32x16& p0, f32x16& p1, f32x16* o, lds_cptr Ks, lds_cptr Vs, const bf16x8* qr, int r32, int hi, int lane, bf16x8 pa0, bf16x8 pa1, bf16x8 pa2, bf16x8 pa3) {
  const lds_cptr vp = Vs + v_rd_base(lane);
#define VFRAG(d0, ks, L, H) const s16x4 L = vtr(vp + v_rd_off(d0, ks, 0)), H = vtr(vp + v_rd_off(d0, ks, 1))
#define PKV(L, H) (bf16x8){L[0], L[1], L[2], L[3], H[0], H[1], H[2], H[3]}
#define LFENCE() asm volatile("" ::: "memory")
#define PVBLK(d, A0, B0, A1, B1, A2, B2, A3, B3) do { o[d] = __builtin_amdgcn_mfma_f32_32x32x16_bf16(pa0, PKV(A0, B0), o[d], 0, 0, 0); o[d] = __builtin_amdgcn_mfma_f32_32x32x16_bf16(pa1, PKV(A1, B1), o[d], 0, 0, 0); \
    o[d] = __builtin_amdgcn_mfma_f32_32x32x16_bf16(pa2, PKV(A2, B2), o[d], 0, 0, 0); o[d] = __builtin_amdgcn_mfma_f32_32x32x16_bf16(pa3, PKV(A3, B3), o[d], 0, 0, 0); } while (0)
  VFRAG(0, 0, l00, h00); VFRAG(0, 1, l01, h01); VFRAG(0, 2, l02, h02); VFRAG(0, 3, l03, h03);
  if constexpr (DOQK) {
    p0 = f32x16{}; p1 = f32x16{};
    bf16x8 ka = *(const __attribute__((address_space(3))) bf16x8*)(Ks + KSWZ(r32, hi * 16)), kb = *(const __attribute__((address_space(3))) bf16x8*)(Ks + KSWZ(32 + r32, hi * 16));
    LFENCE();
#pragma unroll
    for (int d0 = 0; d0 < DK / 16; ++d0) {
      bf16x8 na = ka, nb = kb;
      if (d0 + 1 < DK / 16) { const int cb = ((d0 + 1) * 16 + hi * 8) * 2; na = *(const __attribute__((address_space(3))) bf16x8*)(Ks + KSWZ(r32, cb)); nb = *(const __attribute__((address_space(3))) bf16x8*)(Ks + KSWZ(32 + r32, cb)); }
      LFENCE();
      p0 = __builtin_amdgcn_mfma_f32_32x32x16_bf16(ka, qr[d0], p0, 0, 0, 0);
      p1 = __builtin_amdgcn_mfma_f32_32x32x16_bf16(kb, qr[d0], p1, 0, 0, 0);
      ka = na; kb = nb;
    }
  }
  LFENCE();
  if constexpr (DV == 128) {
    PVBLK(0, l00, h00, l01, h01, l02, h02, l03, h03);
    { VFRAG(1, 0, l10, h10); VFRAG(1, 1, l11, h11); VFRAG(1, 2, l12, h12); VFRAG(1, 3, l13, h13); LFENCE(); PVBLK(1, l10, h10, l11, h11, l12, h12, l13, h13); }
    { VFRAG(2, 0, l20, h20); VFRAG(2, 1, l21, h21); VFRAG(2, 2, l22, h22); VFRAG(2, 3, l23, h23); LFENCE(); PVBLK(2, l20, h20, l21, h21, l22, h22, l23, h23); }
    { VFRAG(3, 0, l30, h30); VFRAG(3, 1, l31, h31); VFRAG(3, 2, l32, h32); VFRAG(3, 3, l33, h33); LFENCE(); PVBLK(3, l30, h30, l31, h31, l32, h32, l33, h33); }
  } else {
    VFRAG(1, 0, l10, h10); VFRAG(1, 1, l11, h11); VFRAG(1, 2, l12, h12); VFRAG(1, 3, l13, h13);
    LFENCE();
    PVBLK(0, l00, h00, l01, h01, l02, h02, l03, h03);
    PVBLK(1, l10, h10, l11, h11, l12, h12, l13, h13);
  }
#undef VFRAG
#undef PKV
#undef LFENCE
#undef PVBLK
}
template <int DK, int DV, int ldq, int ldk, int ldv, int ldo>
__device__ __forceinline__ void attn_unit2(const bf16_t* __restrict__ Qb, const bf16_t* __restrict__ Kh, const bf16_t* __restrict__ Vh,
                                           bf16_t* __restrict__ Ob, int seq, char* lds) {
  constexpr float C = (DK == 96 ? 0.10206207261596577f : 0.08838834764831845f) * 1.4426950408889634f;
  constexpr float THRS = 8.0f * 1.4426950408889634f / C;
  constexpr int NKC = 16, NVC = DV / 8, NKL = 2, NVL = (64 * NVC) / 512;
  const int tid = threadIdx.x, wid = tid >> 6, lane = tid & 63, r32 = lane & 31, hi = lane >> 5;
  const int half = __builtin_amdgcn_readfirstlane(wid >> 2);
  char* V_lds = lds; char* K_lds = lds + 2 * SHM_V;
  float* ws = (float*)(lds + 2 * SHM_V + 2 * SHM_K) + wid * 64; float* li_l = ws; float* al_l = ws + 32;
  float m_reg = -1e30f, l_reg = 0; f32x16 o[DV / 32]; bf16x8 qr[DK / 16];
#pragma unroll
  for (int d = 0; d < DV / 32; ++d) o[d] = f32x16{};
  { const unsigned qoff = (unsigned)((wid * QBLK + r32) * ldq + hi * 8) * 2u;
#pragma unroll
    for (int d0 = 0; d0 < DK / 16; ++d0) qr[d0] = *reinterpret_cast<const bf16x8*>((const char*)Qb + (qoff + d0 * 32)); }
  int krow[NKL], kch[NKL], vrow[NVL], vch[NVL]; unsigned koff[NKL], voff[NVL];
#pragma unroll
  for (int i = 0; i < NKL; ++i) { const int ci = tid + 512 * i; krow[i] = ci / NKC; kch[i] = ci % NKC; koff[i] = (unsigned)(krow[i] * ldk + kch[i] * 8) * 2u; }
#pragma unroll
  for (int i = 0; i < NVL; ++i) { const int ci = tid + 512 * i; vrow[i] = ci / NVC; vch[i] = ci % NVC; voff[i] = (unsigned)(vrow[i] * ldv + vch[i] * 8) * 2u; }
  const int vb0 = (int)(uintptr_t)V_lds + v_rd_base(lane);
  const __amdgpu_buffer_rsrc_t rsK = make_rsrc(Kh), rsV = make_rsrc(Vh);
  const int NT = seq / KVBLK;
  bf16x8 ks[2][NKL], vs[2][NVL];
#define LOADK(set, t) do { const int tn_ = (t) < NT ? (t) : NT - 1; _Pragma("unroll") for (int q = 0; q < NKL; ++q) ks[set][q] = __builtin_bit_cast(bf16x8, __builtin_amdgcn_raw_buffer_load_b128(rsK, (int)koff[q], tn_ * (KVBLK * ldk * 2), 0)); } while (0)
#define LOADV(set, t) do { const int tn_ = (t) < NT ? (t) : NT - 1; _Pragma("unroll") for (int q = 0; q < NVL; ++q) vs[set][q] = __builtin_bit_cast(bf16x8, __builtin_amdgcn_raw_buffer_load_b128(rsV, (int)voff[q], tn_ * (KVBLK * ldv * 2), 0)); } while (0)
#define WRITEK(set, t) do { _Pragma("unroll") for (int q = 0; q < NKL; ++q) *(bf16x8*)(K_lds + ((t) & 1) * SHM_K + KSWZ(krow[q], kch[q] * 16)) = ks[set][q]; } while (0)
#define WRITEV(set, t) do { _Pragma("unroll") for (int q = 0; q < NVL; ++q) *(bf16x8*)(V_lds + ((t) & 1) * SHM_V + v_st(vrow[q], vch[q] * 8)) = vs[set][q]; } while (0)
  f32x16 p0, p1; bf16x8 pa0, pa1, pa2, pa3;
#define SOFTMAX() do { float mn_, al_; partialSM(p0, p1, m_reg, mn_, al_, C, THRS); \
    if (__any(al_ < 1.f)) { if (hi == 0) al_l[r32] = al_; asm volatile("s_waitcnt lgkmcnt(0)" ::: "memory"); \
      _Pragma("unroll") for (int d = 0; d < DV / 32; ++d) _Pragma("unroll") for (int r = 0; r < 16; ++r) o[d][r] *= al_l[crow(r, hi)]; } \
    finishSM(p0, p1, al_, l_reg, pa0, pa1, pa2, pa3); } while (0)
  LOADK(0, 0); LOADV(0, 0); LOADK(1, 1);
  asm volatile("s_waitcnt vmcnt(0)" ::: "memory");
  WRITEK(0, 0); WRITEV(0, 0); WRITEK(1, 1);
  LOADV(1, 1); LOADK(0, 2);
  __syncthreads();
  qkt<DK>(p0, p1, K_lds, qr, r32, hi);
  SOFTMAX();
  if (half == 1) { WRITEV(1, 1); LOADV(0, 2); __syncthreads(); }
#define MSEG(j, JP) do { \
    if (half == 0) { WRITEV((JP) ^ 1, (j) + 1); LOADV(JP, (j) + 2); } else { WRITEK(JP, (j) + 2); LOADK((JP) ^ 1, (j) + 3); } \
    SBAR(); if constexpr (DV == 64) { if ((j) + 1 < NT) mseg_compute<DK, DV, true>(p0, p1, o, (lds_cptr)(K_lds + ((JP) ^ 1) * SHM_K), (lds_cptr)(V_lds + (JP) * SHM_V), qr, r32, hi, lane, pa0, pa1, pa2, pa3); \
      else mseg_compute<DK, DV, false>(p0, p1, o, (lds_cptr)K_lds, (lds_cptr)(V_lds + (JP) * SHM_V), qr, r32, hi, lane, pa0, pa1, pa2, pa3); } \
    else { if ((j) + 1 < NT) qkt<DK>(p0, p1, K_lds + ((JP) ^ 1) * SHM_K, qr, r32, hi); pv_all<DV>(o, vb0 + (JP) * (int)SHM_V, pa0, pa1, pa2, pa3); } SBAR(); } while (0)
#define VSEG(j, JP) do { \
    if (half == 0) { WRITEK(JP, (j) + 2); LOADK((JP) ^ 1, (j) + 3); } else { WRITEV(JP, (j) + 2); LOADV((JP) ^ 1, (j) + 3); } \
    if ((j) + 1 < NT) SOFTMAX(); } while (0)
  for (int j = 0; j < NT; j += 2) {
    MSEG(j, 0); __syncthreads();
    VSEG(j, 0); __syncthreads();
    MSEG(j + 1, 1); __syncthreads();
    VSEG(j + 1, 1); __syncthreads();
  }
  if (half == 0) __syncthreads();
  if (hi == 0) li_l[r32] = l_reg; asm volatile("s_waitcnt lgkmcnt(0)" ::: "memory");
  unsigned ooff = (unsigned)((wid * QBLK + 4 * hi) * ldo + r32) * 2u;
  asm volatile("" : "+v"(ooff));
#pragma unroll
  for (int r = 0; r < 16; ++r) { const float rl = __builtin_amdgcn_rcpf(li_l[crow(r, hi)]);
    char* orow = (char*)Ob + (size_t)(((r & 3) + 8 * (r >> 2)) * ldo) * 2;
#pragma unroll
    for (int d0 = 0; d0 < DV / 32; ++d0) *(bf16_t*)(orow + (ooff + d0 * 64)) = (bf16_t)(cvt_pk_bf16(o[d0][r] * rl, 0.f) & 0xffffu);
    asm volatile("" ::: "memory"); }
  __syncthreads();
#undef LOADK
#undef LOADV
#undef WRITEK
#undef WRITEV
#undef SOFTMAX
#undef MSEG
#undef VSEG
}

template <int DK, int DV, bool DOQK>
__device__ __forceinline__ void mseg_asm(f32x16& p0, f32x16& p1, f32x16* o, lds_cptr Ks, int vb, const bf16x8* qr, int r32, int hi, bf16x8 pa0, bf16x8 pa1, bf16x8 pa2, bf16x8 pa3) {
#define TRR(dst, OFF) asm volatile("ds_read_b64_tr_b16 %0, %1 offset:%2" : "=&v"(dst) : "v"(vb), "i"(OFF) : "memory")
#define RDBLK(d, P) do { TRR(P##l0, v_rd_off(d, 0, 0)); TRR(P##h0, v_rd_off(d, 0, 1)); TRR(P##l1, v_rd_off(d, 1, 0)); TRR(P##h1, v_rd_off(d, 1, 1)); \
    TRR(P##l2, v_rd_off(d, 2, 0)); TRR(P##h2, v_rd_off(d, 2, 1)); TRR(P##l3, v_rd_off(d, 3, 0)); TRR(P##h3, v_rd_off(d, 3, 1)); } while (0)
#define WAITBLK(N, P) asm volatile("s_waitcnt lgkmcnt(" #N ")" : "+v"(P##l0), "+v"(P##h0), "+v"(P##l1), "+v"(P##h1), "+v"(P##l2), "+v"(P##h2), "+v"(P##l3), "+v"(P##h3) :: "memory")
#define PKV(L, H) (bf16x8){L[0], L[1], L[2], L[3], H[0], H[1], H[2], H[3]}
#define PVBLK(d, P) do { o[d] = __builtin_amdgcn_mfma_f32_32x32x16_bf16(pa0, PKV(P##l0, P##h0), o[d], 0, 0, 0); o[d] = __builtin_amdgcn_mfma_f32_32x32x16_bf16(pa1, PKV(P##l1, P##h1), o[d], 0, 0, 0); \
    o[d] = __builtin_amdgcn_mfma_f32_32x32x16_bf16(pa2, PKV(P##l2, P##h2), o[d], 0, 0, 0); o[d] = __builtin_amdgcn_mfma_f32_32x32x16_bf16(pa3, PKV(P##l3, P##h3), o[d], 0, 0, 0); } while (0)
  s16x4 al0, ah0, al1, ah1, al2, ah2, al3, ah3, bl0, bh0, bl1, bh1, bl2, bh2, bl3, bh3;
  RDBLK(0, a); RDBLK(1, b);
  WAITBLK(8, a); SBAR(); PVBLK(0, a);
  if constexpr (DV == 128) {
    RDBLK(2, a);
    WAITBLK(8, b); SBAR(); PVBLK(1, b);
    RDBLK(3, b);
    WAITBLK(8, a); SBAR(); PVBLK(2, a);
    WAITBLK(0, b); SBAR(); PVBLK(3, b);
  } else {
    WAITBLK(0, b); SBAR(); PVBLK(1, b);
  }
  if constexpr (DOQK) qkt<DK>(p0, p1, (const char*)Ks, qr, r32, hi);
#undef TRR
#undef RDBLK
#undef WAITBLK
#undef PKV
#undef PVBLK
}
template <int DK, int DV, int ldq, int ldk, int ldv, int ldo>
__device__ __forceinline__ void attn_unit3(const bf16_t* __restrict__ Qb, const bf16_t* __restrict__ Kh, const bf16_t* __restrict__ Vh,
                                           bf16_t* __restrict__ Ob, int seq, char* lds) {
  constexpr float C = (DK == 96 ? 0.10206207261596577f : 0.08838834764831845f) * 1.4426950408889634f;
  constexpr float THRS = 8.0f * 1.4426950408889634f / C;
  constexpr int NVOP = DV / 64;
  const int tid = threadIdx.x, wid = __builtin_amdgcn_readfirstlane(tid >> 6), lane = tid & 63, r32 = lane & 31, hi = lane >> 5;
  const int half = wid >> 2;
  char* V_lds = lds; char* K_lds = lds + 2 * SHM_V;
  float* ws = (float*)(lds + 2 * SHM_V + 2 * SHM_K) + wid * 64; float* li_l = ws; float* al_l = ws + 32;
  float m_reg = -1e30f, l_reg = 0; f32x16 o[DV / 32]; bf16x8 qr[DK / 16];
#pragma unroll
  for (int d = 0; d < DV / 32; ++d) o[d] = f32x16{};
  { const unsigned qoff = (unsigned)((wid * QBLK + r32) * ldq + hi * 8) * 2u;
#pragma unroll
    for (int d0 = 0; d0 < DK / 16; ++d0) qr[d0] = *reinterpret_cast<const bf16x8*>((const char*)Qb + (qoff + d0 * 32)); }
  unsigned ksrc[2], vsrc[NVOP]; unsigned kdst[2], vdst[NVOP];
#pragma unroll
  for (int i = 0; i < 2; ++i) { const int ch = wid + 8 * i, row = 4 * ch + (lane >> 4), pos = lane & 15; ksrc[i] = (unsigned)(row * ldk * 2 + ((pos ^ (row & 7)) << 4)); kdst[i] = (unsigned)(ch * 1024); }
#pragma unroll
  for (int i = 0; i < NVOP; ++i) { const int ch = (DV == 64) ? 2 * wid : wid + 8 * i;
    const int ob = ch * 1024 + 16 * lane, st = ob >> 9, rem = ob & 511, kk = (st >> 2) * 8 + (rem >> 6), c = (st & 3) * 32 + ((rem & 63) >> 1);
    const int k = (kk & ~0xC) | ((kk & 4) << 1) | ((kk & 8) >> 1);
    vsrc[i] = (unsigned)(k * ldv * 2 + c * 2); vdst[i] = (unsigned)(ch * 1024); }
  const int vb0 = (int)(uintptr_t)V_lds + v_rd_base(lane);
  const int NT = seq / KVBLK;
#define DMAK(t) do { const int tn_ = (t) < NT ? (t) : NT - 1; const char* kt_ = (const char*)Kh + (size_t)tn_ * (KVBLK * ldk * 2); \
    _Pragma("unroll") for (int q = 0; q < 2; ++q) __builtin_amdgcn_global_load_lds((const unsigned*)(kt_ + q * (32 * ldk * 2) + ksrc[0]), (LAS unsigned*)(K_lds + ((t) & 1) * SHM_K + kdst[q]), 16, 0, 0); } while (0)
#define DMAV(t) do { const int tn_ = (t) < NT ? (t) : NT - 1; const char* vt_ = (const char*)Vh + (size_t)tn_ * (KVBLK * ldv * 2); \
    _Pragma("unroll") for (int q = 0; q < NVOP; ++q) __builtin_amdgcn_global_load_lds((const unsigned*)(vt_ + q * (32 * ldv * 2) + vsrc[0]), (LAS unsigned*)(V_lds + ((t) & 1) * SHM_V + vdst[q]), 16, 0, 0); } while (0)
#define BAR_PLAIN() asm volatile("s_waitcnt lgkmcnt(0)\n\ts_barrier" ::: "memory")
#define BAR_DMA() asm volatile("s_waitcnt vmcnt(0) lgkmcnt(0)\n\ts_barrier" ::: "memory")
  f32x16 p0, p1; bf16x8 pa0, pa1, pa2, pa3;
#define SOFTMAX() do { float mn_, al_; partialSM(p0, p1, m_reg, mn_, al_, C, THRS); \
    if (__any(al_ < 1.f)) { if (hi == 0) al_l[r32] = al_; asm volatile("s_waitcnt lgkmcnt(0)" ::: "memory"); \
      _Pragma("unroll") for (int d = 0; d < DV / 32; ++d) _Pragma("unroll") for (int r = 0; r < 16; ++r) o[d][r] *= al_l[crow(r, hi)]; } \
    finishSM(p0, p1, al_, l_reg, pa0, pa1, pa2, pa3); } while (0)
  DMAK(0); DMAV(0); DMAK(1);
  BAR_DMA();
  qkt<DK>(p0, p1, K_lds, qr, r32, hi);
  BAR_PLAIN();
  SOFTMAX();
  if (half == 1) { DMAK(2); DMAV(1); BAR_PLAIN(); }
#define MSEG(j, JP) do { if (half == 0) { DMAK((j) + 2); DMAV((j) + 1); } \
    SBAR(); if (false) {} \
    else if (ATT3_PLAIN == 2 && DV == 128) { if ((j) + 1 < NT) mseg_asm<DK, DV, true>(p0, p1, o, (lds_cptr)(K_lds + ((JP) ^ 1) * SHM_K), vb0 + (JP) * (int)SHM_V, qr, r32, hi, pa0, pa1, pa2, pa3); else mseg_asm<DK, DV, false>(p0, p1, o, (lds_cptr)K_lds, vb0 + (JP) * (int)SHM_V, qr, r32, hi, pa0, pa1, pa2, pa3); } \
    else if ((ATT3_PLAIN && DV == 128) || ATT3_PLAIN == 4) { if ((j) + 1 < NT) qkt<DK>(p0, p1, K_lds + ((JP) ^ 1) * SHM_K, qr, r32, hi); pv_all<DV>(o, vb0 + (JP) * (int)SHM_V, pa0, pa1, pa2, pa3); } \
    else if ((j) + 1 < NT) mseg_compute<DK, DV, true>(p0, p1, o, (lds_cptr)(K_lds + ((JP) ^ 1) * SHM_K), (lds_cptr)(V_lds + (JP) * SHM_V), qr, r32, hi, lane, pa0, pa1, pa2, pa3); \
    else mseg_compute<DK, DV, false>(p0, p1, o, (lds_cptr)K_lds, (lds_cptr)(V_lds + (JP) * SHM_V), qr, r32, hi, lane, pa0, pa1, pa2, pa3); SBAR(); \
    if (half == 0) BAR_PLAIN(); else BAR_DMA(); } while (0)
#define VSEG(j, JP) do { if (half == 1) { DMAK((j) + 3); DMAV((j) + 2); } \
    if ((j) + 1 < NT) SOFTMAX(); \
    if (half == 0) BAR_DMA(); else BAR_PLAIN(); } while (0)
  for (int j = 0; j < NT; j += 2) { MSEG(j, 0); VSEG(j, 0); MSEG(j + 1, 1); VSEG(j + 1, 1); }
  if (half == 0) BAR_PLAIN();
  asm volatile("s_waitcnt vmcnt(0)" ::: "memory");
  if (hi == 0) li_l[r32] = l_reg; asm volatile("s_waitcnt lgkmcnt(0)" ::: "memory");
  unsigned ooff = (unsigned)((wid * QBLK + 4 * hi) * ldo + r32) * 2u;
  asm volatile("" : "+v"(ooff));
#pragma unroll
  for (int r = 0; r < 16; ++r) { const float rl = __builtin_amdgcn_rcpf(li_l[crow(r, hi)]);
    char* orow = (char*)Ob + (size_t)(((r & 3) + 8 * (r >> 2)) * ldo) * 2;
#pragma unroll
    for (int d0 = 0; d0 < DV / 32; ++d0) *(bf16_t*)(orow + (ooff + d0 * 64)) = (bf16_t)(cvt_pk_bf16(o[d0][r] * rl, 0.f) & 0xffffu);
    asm volatile("" ::: "memory"); }
  asm volatile("s_waitcnt vmcnt(0) lgkmcnt(0)\n\ts_barrier" ::: "memory");
#undef DMAK
#undef DMAV
#undef BAR_PLAIN
#undef BAR_DMA
#undef SOFTMAX
#undef MSEG
#undef VSEG
}
#undef KSWZ
#undef SBAR
}

struct Params { const float* in[23]; float* out; unsigned char* ws; int ph_lo, ph_hi, bar_region, use_cg; };
enum { IN_X = 0, IN_C, IN_CTX, IN_CCTX, IN_ADAW, IN_ADAB, IN_NORM1, IN_NORM2, IN_ABWIN, IN_ABQN, IN_ABWUQ, IN_ABKVN, IN_ABWUKV, IN_ABWO, IN_CWIN, IN_CQG, IN_CKG, IN_CWO, IN_ROUTER, IN_WG, IN_WU, IN_WD, IN_FNORM };
constexpr int NPH = 20;
#define LDS_WAIT() asm volatile("s_waitcnt lgkmcnt(0)" ::: "memory")

__device__ __forceinline__ void transpose_item(const float* W, int ldw, bf16_t* WT, int ldt, const float* kscale, LAS float* scr, int lane) {
#pragma unroll 8
  for (int i = 0; i < 32; ++i) { const int kk = 2 * i + (lane >> 5); float v = W[(size_t)kk * ldw + (lane & 31)]; if (kscale) v *= kscale[kk]; scr[kk * 33 + (lane & 31)] = v; }
  LDS_WAIT(); asm volatile("" ::: "memory");
  const int c = lane & 7;
#pragma unroll
  for (int j = 0; j < 4; ++j) { const int n = (lane >> 3) + 8 * j; const LAS float* s = scr + (8 * c) * 33 + n;
    u32x4 o; o.x = cvt_pk_bf16(s[0 * 33], s[1 * 33]); o.y = cvt_pk_bf16(s[2 * 33], s[3 * 33]); o.z = cvt_pk_bf16(s[4 * 33], s[5 * 33]); o.w = cvt_pk_bf16(s[6 * 33], s[7 * 33]);
    *(u32x4*)(WT + (size_t)n * ldt + 8 * c) = o; }
  LDS_WAIT(); asm volatile("" ::: "memory");
}
__device__ __forceinline__ void transpose_item8(const float* W, int ldw, unsigned char* WT, int ldt, LAS float* scr, int lane) {
#pragma unroll 8
  for (int i = 0; i < 32; ++i) { const int kk = 2 * i + (lane >> 5); scr[kk * 33 + (lane & 31)] = W[(size_t)kk * ldw + (lane & 31)] * W8_SCALE; }
  LDS_WAIT(); asm volatile("" ::: "memory");
#pragma unroll
  for (int u = 0; u < 2; ++u) { const int p = lane + 64 * u, n = p >> 2, c = p & 3; const LAS float* s = scr + (16 * c) * 33 + n;
    u32x4 o; o.x = pack4_fp8(s[0 * 33], s[1 * 33], s[2 * 33], s[3 * 33]); o.y = pack4_fp8(s[4 * 33], s[5 * 33], s[6 * 33], s[7 * 33]);
    o.z = pack4_fp8(s[8 * 33], s[9 * 33], s[10 * 33], s[11 * 33]); o.w = pack4_fp8(s[12 * 33], s[13 * 33], s[14 * 33], s[15 * 33]);
    *(u32x4*)(WT + (size_t)n * ldt + 16 * c) = o; }
  LDS_WAIT(); asm volatile("" ::: "memory");
}
#ifndef MOE_FP8
#define MOE_FP8 1
#endif
__device__ __forceinline__ void moe_item(const Params& P, int r, LAS float* scr, int lane) {
  unsigned char* ws = P.ws;
  const int le = r / 3072, q = r % 3072, which = q >> 10, t = q & 1023;
  if (which < 2) { const int kb = t >> 6, nb = t & 63, n0 = nb * 32;
    const float* src = P.in[which == 0 ? IN_WG : IN_WU] + (size_t)le * 1024 * 2048 + (size_t)kb * 64 * 2048 + n0;
    const size_t doff = (size_t)le * 4096 * 1024 + (size_t)((n0 >> 7) * 256 + which * 128 + (n0 & 127)) * 1024 + kb * 64;
    if (MOE_FP8) transpose_item8(src, 2048, ws + WS_WGU + doff, 1024, scr, lane); else transpose_item(src, 2048, (bf16_t*)(ws + WS_WGU) + doff, 1024, nullptr, scr, lane);
  } else { const int kb = t >> 5, nb = t & 31;
    const float* src = P.in[IN_WD] + (size_t)le * 2048 * 1024 + (size_t)kb * 64 * 1024 + nb * 32;
    const size_t doff = (size_t)le * 1024 * 2048 + (size_t)nb * 32 * 2048 + kb * 64;
    if (MOE_FP8) transpose_item8(src, 1024, ws + WS_WD + doff, 2048, scr, lane); else transpose_item(src, 1024, (bf16_t*)(ws + WS_WD) + doff, 2048, nullptr, scr, lane);
  }
}
#ifndef FQ_GEMM
#define FQ_GEMM 64
#endif
#ifndef FQ_TOPK
#define FQ_TOPK 44
#endif
constexpr int FS_NWG[7] = {248, 248, 192, 192, 116, 224, 124};
constexpr int FS_QUOTA[7] = {FQ_GEMM, FQ_GEMM, FQ_TOPK, FQ_GEMM, FQ_GEMM, FQ_TOPK, FQ_GEMM};
constexpr int FS_L0 = FS_NWG[0] * FS_QUOTA[0] + FS_NWG[1] * FS_QUOTA[1] + FS_NWG[2] * FS_QUOTA[2];
constexpr int FS_L1 = FS_NWG[3] * FS_QUOTA[3] + FS_NWG[4] * FS_QUOTA[4] + FS_NWG[5] * FS_QUOTA[5] + FS_NWG[6] * FS_QUOTA[6];
static_assert(FS_L0 <= 49152 && FS_L1 <= 49152, "filler quotas");
__device__ __forceinline__ int fs_base(int s) {
  int b = s < 3 ? 0 : 49152;
  for (int q = (s < 3 ? 0 : 3); q < s; ++q) b += FS_NWG[q] * FS_QUOTA[q];
  return b;
}
__device__ __forceinline__ void filler(const Params& P, LAS unsigned char* lds, int s, int f, int lane, int wave) {
  LAS float* scr = (LAS float*)(lds + wave * 16384);
  const int base = fs_base(s), nwg = FS_NWG[s], quota = FS_QUOTA[s];
  for (int k = wave; k < quota; k += NWAVES) moe_item(P, base + f + k * nwg, scr, lane);
}
constexpr int GEMV_ITEMS = 2 * 16 * 24;
constexpr int MOE_ITEMS = 2 * 16 * 3072;
constexpr int SM_WIN0 = 16 * 29, SM_WUQ = 4 * 24, SM_WUKV = 2 * 32, SM_WO = 16 * 32, SM_WIN1 = 16 * 48;
constexpr int SMALL_ITEMS = SM_WIN0 + SM_WUQ + SM_WUKV + SM_WO + SM_WIN1 + SM_WO;
__device__ __forceinline__ void p0_prologue(const Params& P, LAS unsigned char* lds, int gw, int NGW, int lane, int wave, bool skip_gemv = false) {
  unsigned char* ws = P.ws;
  float* MOD = (float*)(ws + WS_CTL) + CW_MOD;
  LAS float* scr = (LAS float*)(lds + wave * 16384);
  for (int it = gw; it < GEMV_ITEMS + SM_WIN0 + SM_WUQ + SM_WUKV; it += NGW) {
    if (it < GEMV_ITEMS) {
      if (skip_gemv) continue;
      const int l = it / 384, r0 = it % 384, kc = r0 / 24, nc = r0 % 24, k0 = kc * 64, n = nc * 256 + 4 * lane;
      const float s0 = siluf(P.in[IN_C][k0 + lane]), s1 = siluf(P.in[IN_C][1024 + k0 + lane]), s2 = siluf(P.in[IN_CCTX][k0 + lane]);
      const float* w = P.in[IN_ADAW] + ((size_t)l * 1024 + k0) * 6144 + n;
      f32x4 a0 = {0.f, 0.f, 0.f, 0.f}, a1 = a0, a2 = a0;
#pragma unroll 8
      for (int kk = 0; kk < 64; ++kk) { const f32x4 wv = *(const f32x4*)(w + (size_t)kk * 6144);
        a0 += wv * __shfl(s0, kk); a1 += wv * __shfl(s1, kk); a2 += wv * __shfl(s2, kk); }
      float* part = (float*)(ws + WS_MODP) + ((size_t)(l * 24 + nc) * 16) * 768 + 4 * lane;
      { float* pp = part + (size_t)kc * 768; *(f32x4*)pp = a0; *(f32x4*)(pp + 256) = a1; *(f32x4*)(pp + 512) = a2; }
      __threadfence();
      unsigned old = 0u; if (lane == 0) old = atomicAdd((unsigned*)(ws + WS_CTL) + CW_CNT + 64 * (l * 24 + nc), 1u);
      old = __builtin_amdgcn_readfirstlane(old);
      if (old == 15u) {
        __threadfence();
        const f32x4 bv = *(const f32x4*)(P.in[IN_ADAB] + l * 6144 + n); f32x4 t0 = bv, t1 = bv, t2 = bv;
#pragma unroll 4
        for (int q = 0; q < 16; ++q) { const float* pp = part + (size_t)q * 768; t0 += *(const f32x4*)pp; t1 += *(const f32x4*)(pp + 256); t2 += *(const f32x4*)(pp + 512); }
        float* m0 = MOD + (size_t)(l * 3) * 6144 + n;
        *(f32x4*)m0 = t0; *(f32x4*)(m0 + 6144) = t1; *(f32x4*)(m0 + 2 * 6144) = t2;
      }
      continue;
    }
    int r = it - GEMV_ITEMS;
    if (r < SM_WIN0) { const int kb = r / 29, nb = r % 29; transpose_item(P.in[IN_ABWIN] + (size_t)kb * 64 * 928 + nb * 32, 928, (bf16_t*)(ws + WS_WIN0) + (size_t)nb * 32 * 1024 + kb * 64, 1024, nullptr, scr, lane); continue; } r -= SM_WIN0;
    if (r < SM_WUQ) { const int kb = r / 24, nb = r % 24; transpose_item(P.in[IN_ABWUQ] + (size_t)kb * 64 * 768 + nb * 32, 768, (bf16_t*)(ws + WS_WUQ) + (size_t)nb * 32 * 256 + kb * 64, 256, P.in[IN_ABQN] + kb * 64, scr, lane); continue; } r -= SM_WUQ;
    { const int kb = r / 32, nb = r % 32; transpose_item(P.in[IN_ABWUKV] + (size_t)kb * 64 * 1024 + nb * 32, 1024, (bf16_t*)(ws + WS_WUKV) + (size_t)nb * 32 * 256 + 128 + kb * 64, 256, P.in[IN_ABKVN] + kb * 64, scr, lane); }
  }
  const bool fill = NGW == 2048;
  const int nrest = fill ? (49152 - FS_L0) + (49152 - FS_L1) : MOE_ITEMS;
  for (int it = gw; it < SM_WO + SM_WIN1 + SM_WO + nrest; it += NGW) {
    int r = it;
    if (r < SM_WO) { const int kb = r / 32, nb = r % 32; transpose_item(P.in[IN_ABWO] + (size_t)kb * 64 * 1024 + nb * 32, 1024, (bf16_t*)(ws + WS_WO0) + (size_t)nb * 32 * 1024 + kb * 64, 1024, nullptr, scr, lane); continue; } r -= SM_WO;
    if (r < SM_WIN1) { const int kb = r / 48, nb = r % 48; transpose_item(P.in[IN_CWIN] + (size_t)kb * 64 * 1536 + nb * 32, 1536, (bf16_t*)(ws + WS_WIN1) + (size_t)nb * 32 * 1024 + kb * 64, 1024, nullptr, scr, lane); continue; } r -= SM_WIN1;
    if (r < SM_WO) { const int kb = r / 32, nb = r % 32; transpose_item(P.in[IN_CWO] + (size_t)kb * 64 * 1024 + nb * 32, 1024, (bf16_t*)(ws + WS_WO1) + (size_t)nb * 32 * 1024 + kb * 64, 1024, nullptr, scr, lane); continue; } r -= SM_WO;
    moe_item(P, !fill ? r : r < 49152 - FS_L0 ? FS_L0 + r : 49152 + FS_L1 + (r - (49152 - FS_L0)), scr, lane);
  }
  const int NT_ = NGW * 64;
  for (int g = gw * 64 + lane; g < 1024 + 4096 + 65536 + 12288 + 16384; g += NT_) {
    int q = g;
    if (q < 1024) { const int pos = q >> 3, i = q & 7; const float inv = powf(10000.f, -(float)i / 8.f); float s, c; sincos_acc((double)((float)pos * inv), s, c); ((f32x2*)(ws + WS_ROPEA))[q] = (f32x2){c, s}; continue; } q -= 1024;
    if (q < 4096) { const int pos = q >> 5, i = q & 31; const float inv = powf(10000.f, -(float)i / 32.f); float s, c; sincos_acc((double)((float)pos * inv), s, c); ((f32x2*)(ws + WS_ROPEC))[q] = (f32x2){c, s}; continue; } q -= 4096;
    if (q < 65536) {
      const int n = q >> 7, k0 = (q & 127) * 8; u32x4 o = {0u, 0u, 0u, 0u};
      if ((k0 >> 8) == (n >> 7)) { const int cp = n & 127, c0 = (k0 & 255) >> 1; float sv[4], cv[4];
#pragma unroll
        for (int j = 0; j < 4; ++j) sincos_acc(6.283185307179586476925 * (double)(((c0 + j) * cp) & 127) / 128.0, sv[j], cv[j]);
        o.x = cvt_pk_bf16(cv[0], sv[0]); o.y = cvt_pk_bf16(cv[1], sv[1]); o.z = cvt_pk_bf16(cv[2], sv[2]); o.w = cvt_pk_bf16(cv[3], sv[3]); }
      *(u32x4*)((bf16_t*)(ws + WS_WDFT) + (size_t)n * 1024 + k0) = o; continue; } q -= 65536;
    if (q < 12288) { *(u32x4*)((bf16_t*)(ws + WS_WIN0) + (size_t)928 * 1024 + (size_t)q * 8) = (u32x4){0u, 0u, 0u, 0u}; continue; } q -= 12288;
    { const int n = q >> 4, k0 = (q & 15) * 8; *(u32x4*)((bf16_t*)(ws + WS_WUKV) + (size_t)n * 256 + k0) = (u32x4){0u, 0u, 0u, 0u}; }
  }
}

__device__ __forceinline__ int mod_row(int row) { return (row % T) < L ? 2 : row / T; }
__device__ __forceinline__ void modulate4(f32x4 (&y)[4], const f32x4 (&v)[4], float rstd, const float* g, const float* sh, const float* sc, int lane) {
#pragma unroll
  for (int j = 0; j < 4; ++j) { const int o = 256 * j + 4 * lane; const f32x4 gv = *(const f32x4*)(g + o), sv = *(const f32x4*)(sh + o), cv = *(const f32x4*)(sc + o);
    y[j] = v[j] * rstd * gv * (1.f + cv) + sv; }
}
__device__ __forceinline__ void store_bf16_row(bf16_t* orow, const f32x4 (&y)[4], int lane) {
#pragma unroll
  for (int j = 0; j < 4; ++j) { u32x2 w; w.x = cvt_pk_bf16(y[j][0], y[j][1]); w.y = cvt_pk_bf16(y[j][2], y[j][3]); *(u32x2*)(orow + 256 * j + 4 * lane) = w; }
}
__device__ __forceinline__ float sumsq4(const f32x4 (&v)[4]) {
  float s = 0.f;
#pragma unroll
  for (int j = 0; j < 4; ++j) s += (v[j][0] * v[j][0] + v[j][1] * v[j][1]) + (v[j][2] * v[j][2] + v[j][3] * v[j][3]);
  return wave_sum(s);
}
__device__ __forceinline__ void phase_r0(const Params& P, int gw, int NGW, int lane) {
  float* H = (float*)(P.ws + WS_H); bf16_t* XN = (bf16_t*)(P.ws + WS_XN); const float* MOD = (const float*)(P.ws + WS_CTL) + CW_MOD;
  auto srcp = [&](int row) { const int b = row / T, i = row % T; return i < L ? P.in[IN_CTX] + ((size_t)b * L + i) * D : P.in[IN_X] + ((size_t)b * S + (i - L)) * D; };
  f32x4 v[4], vn[4];
  if (gw < M) { const float* s = srcp(gw);
#pragma unroll
    for (int j = 0; j < 4; ++j) v[j] = *(const f32x4*)(s + 256 * j + 4 * lane); }
#pragma unroll 1
  for (int row = gw; row < M; row += NGW) {
    const int nrow = row + NGW < M ? row + NGW : row;
    { const float* s = srcp(nrow);
#pragma unroll
      for (int j = 0; j < 4; ++j) vn[j] = *(const f32x4*)(s + 256 * j + 4 * lane); }
    f32x4 y[4];
    const float rstd = rsqrtf(sumsq4(v) * (1.f / D) + EPS);
    const float* mr = MOD + (size_t)mod_row(row) * 6144;
    modulate4(y, v, rstd, P.in[IN_NORM1], mr, mr + 1024, lane);
    store_bf16_row(XN + (size_t)row * D, y, lane);
#pragma unroll
    for (int j = 0; j < 4; ++j) v[j] = vn[j];
  }
}
__device__ __forceinline__ int lane_expert(int lane) { return ((lane >> 5) & 1) * 8 + ((lane >> 4) & 1) * 4 + ((lane >> 3) & 1) * 2 + ((lane >> 2) & 1); }
__device__ __forceinline__ float router_reduce(float (&p)[16], int lane) {
  float q[8], r[4], s[2], t;
  { const bool up = lane & 32;
#pragma unroll
    for (int i = 0; i < 8; ++i) { const float snd = up ? p[i] : p[i + 8], kp = up ? p[i + 8] : p[i]; q[i] = kp + __shfl_xor(snd, 32); } }
  { const bool up = lane & 16;
#pragma unroll
    for (int i = 0; i < 4; ++i) { const float snd = up ? q[i] : q[i + 4], kp = up ? q[i + 4] : q[i]; r[i] = kp + __shfl_xor(snd, 16); } }
  { const bool up = lane & 8;
#pragma unroll
    for (int i = 0; i < 2; ++i) { const float snd = up ? r[i] : r[i + 2], kp = up ? r[i + 2] : r[i]; s[i] = kp + __shfl_xor(snd, 8); } }
  { const bool up = lane & 4; const float snd = up ? s[0] : s[1], kp = up ? s[1] : s[0]; t = kp + __shfl_xor(snd, 4); }
  t += __shfl_xor(t, 2); t += __shfl_xor(t, 1);
  float mx = t;
#pragma unroll
  for (int o = 4; o < 64; o <<= 1) mx = fmaxf(mx, __shfl_xor(mx, o));
  const float ex = expf(t - mx); float sm = ex;
#pragma unroll
  for (int o = 4; o < 64; o <<= 1) sm += __shfl_xor(sm, o);
  return ex / sm;
}
__device__ __forceinline__ void router_aff2(const f32x4 (&ya)[4], const f32x4 (&yb)[4], const LAS float* WrT, int lane, float& aa, float& ab) {
  asm volatile("" : "+v"(lane));
  float pa[16], pb[16];
#pragma unroll
  for (int e = 0; e < 16; ++e) { float a = 0.f, b = 0.f;
#pragma unroll
    for (int j = 0; j < 4; ++j) { const f32x4 w = *(const LAS f32x4*)(WrT + e * 1024 + 256 * j + 4 * lane);
      a += (ya[j][0] * w[0] + ya[j][1] * w[1]) + (ya[j][2] * w[2] + ya[j][3] * w[3]); b += (yb[j][0] * w[0] + yb[j][1] * w[1]) + (yb[j][2] * w[2] + yb[j][3] * w[3]); }
    pa[e] = a; pb[e] = b; }
  aa = router_reduce(pa, lane); ab = router_reduce(pb, lane);
}
__device__ __forceinline__ void phase_router(const Params& P, LAS unsigned char* lds, int layer, int gw, int NGW, int lane) {
  const float* H = (const float*)(P.ws + WS_H); bf16_t* XN = (bf16_t*)(P.ws + WS_XN); const float* MOD = (const float*)(P.ws + WS_CTL) + CW_MOD + layer * 3 * 6144;
  float* AFFL = (float*)(P.ws + WS_AFFL); float* AFFC = (float*)(P.ws + WS_AFFC); int* INV = (int*)(P.ws + WS_INV);
  LAS float* WrT = (LAS float*)lds;
  { const float* Wr = P.in[IN_ROUTER] + (size_t)layer * D * 16;
    for (int q = threadIdx.x; q < D * 4; q += NTHR) { const int d = q >> 2, e4 = (q & 3) * 4; const f32x4 w = *(const f32x4*)(Wr + d * 16 + e4);
#pragma unroll
      for (int t = 0; t < 4; ++t) WrT[(e4 + t) * 1024 + d] = w[t]; }
    __syncthreads(); }
  const float* g = P.in[IN_NORM2] + layer * D;
  const int NR = layer == 1 ? NB * S : M;
  auto rowof = [&](int r) { return layer == 1 ? (r / S) * T + L + (r % S) : r; };
  f32x4 vA[4], vB[4], nA[4], nB[4];
  auto ldrow = [&](int r, f32x4 (&v)[4]) { const int row = rowof(r < NR ? r : NR - 1);
#pragma unroll
    for (int j = 0; j < 4; ++j) v[j] = *(const f32x4*)(H + (size_t)row * D + 256 * j + 4 * lane); };
  auto modrow = [&](int r, const f32x4 (&v)[4], f32x4 (&y)[4]) {
    const int row = rowof(r), b = row / T, i = row % T;
    const float rstd = rsqrtf(sumsq4(v) * (1.f / D) + EPS);
    const float* mr = MOD + (size_t)(i < L ? 2 : b) * 6144;
    modulate4(y, v, rstd, g, mr + 3 * 1024, mr + 4 * 1024, lane);
    if (!MOE_FP8) store_bf16_row(XN + (size_t)row * D, y, lane);
    if (MOE_FP8) {
#pragma unroll
      for (int j = 0; j < 4; ++j) *(unsigned*)(P.ws + WS_XN8 + (size_t)row * D + 256 * j + 4 * lane) = pack4_fp8(y[j][0], y[j][1], y[j][2], y[j][3]);
    } };
  auto putaff = [&](int r, float a) { const int row = rowof(r), b = row / T, i = row % T;
    if ((lane & 3) == 0) { const int e = lane_expert(lane); if (i < L) AFFC[((size_t)b * 16 + e) * L + i] = a; else AFFL[((size_t)b * 16 + e) * S + (i - L)] = a; }
    if (lane < 16) INV[(size_t)row * 16 + lane] = -1; };
  if (gw < NR) { ldrow(gw, vA); ldrow(gw + NGW, vB); }
#pragma unroll 1
  for (int r = gw; r < NR; r += 2 * NGW) {
    const bool hasB = r + NGW < NR;
    ldrow(r + 2 * NGW, nA); ldrow(r + 3 * NGW, nB);
    f32x4 yA[4], yB[4]; float aA, aB;
    modrow(r, vA, yA);
    if (hasB) modrow(r + NGW, vB, yB); else {
#pragma unroll
      for (int j = 0; j < 4; ++j) yB[j] = yA[j]; }
    router_aff2(yA, yB, WrT, lane, aA, aB);
    putaff(r, aA); if (hasB) putaff(r + NGW, aB);
#pragma unroll
    for (int j = 0; j < 4; ++j) { vA[j] = nA[j]; vB[j] = nB[j]; }
  }
}
__device__ __forceinline__ void phase_combine(const Params& P, int layer, int gw, int NGW, int lane) {
  float* H = (float*)(P.ws + WS_H); bf16_t* XN = (bf16_t*)(P.ws + WS_XN); const float* MODL = (const float*)(P.ws + WS_CTL) + CW_MOD + layer * 3 * 6144;
  const int* INV = (const int*)(P.ws + WS_INV); const float* GATE = (const float*)(P.ws + WS_GATE); const bf16_t* Y2 = (const bf16_t*)(P.ws + WS_Y2);
  const int NR = layer == 1 ? NB * S : M;
  auto rowof = [&](int r) { return layer == 1 ? (r / S) * T + L + (r % S) : r; };
  f32x4 hA[4], hB[4], nA[4], nB[4]; int peA = -1, peB = -1, pnA, pnB;
  auto ldrow = [&](int r, f32x4 (&h)[4], int& pe) { const int row = rowof(r < NR ? r : NR - 1); pe = INV[(size_t)row * 16 + (lane & 15)];
#pragma unroll
    for (int j = 0; j < 4; ++j) h[j] = *(const f32x4*)(H + (size_t)row * D + 256 * j + 4 * lane); };
  auto finish = [&](int r, f32x4 (&hv)[4], const f32x4 (&acc)[4]) {
    const int row = rowof(r), b = row / T, i = row % T;
    const float* mr = MODL + (size_t)(i < L ? 2 : b) * 6144 + 5 * 1024;
#pragma unroll
    for (int j = 0; j < 4; ++j) hv[j] += *(const f32x4*)(mr + 256 * j + 4 * lane) * acc[j];
    const float rstd = rsqrtf(sumsq4(hv) * (1.f / D) + EPS);
    if (layer == 0) {
#pragma unroll
      for (int j = 0; j < 4; ++j) *(f32x4*)(H + (size_t)row * D + 256 * j + 4 * lane) = hv[j];
      f32x4 y[4]; const float* m1 = MODL + 3 * 6144 + (size_t)(i < L ? 2 : b) * 6144;
      modulate4(y, hv, rstd, P.in[IN_NORM1] + D, m1, m1 + 1024, lane);
      store_bf16_row(XN + (size_t)row * D, y, lane);
    } else {
      float* o = P.out + ((size_t)b * S + (i - L)) * D;
#pragma unroll
      for (int j = 0; j < 4; ++j) *(f32x4*)(o + 256 * j + 4 * lane) = hv[j] * rstd * *(const f32x4*)(P.in[IN_FNORM] + 256 * j + 4 * lane);
    }
  };
  if (gw < NR) { ldrow(gw, hA, peA); ldrow(gw + NGW, hB, peB); }
#pragma unroll 1
  for (int r = gw; r < NR; r += 2 * NGW) {
    const bool hasB = r + NGW < NR;
    ldrow(r + 2 * NGW, nA, pnA); ldrow(r + 3 * NGW, nB, pnB);
    f32x4 aA[4], aB[4];
#pragma unroll
    for (int j = 0; j < 4; ++j) { aA[j] = (f32x4){0.f, 0.f, 0.f, 0.f}; aB[j] = (f32x4){0.f, 0.f, 0.f, 0.f}; }
#pragma unroll
    for (int e = 0; e < 16; ++e) {
      const int pa = __builtin_amdgcn_readlane(peA, e), pb = hasB ? __builtin_amdgcn_readlane(peB, e) : -1;
      u32x2 wa[4], wb[4]; float ga = 0.f, gb = 0.f;
      if (pa >= 0) { ga = GATE[pa];
#pragma unroll
        for (int j = 0; j < 4; ++j) wa[j] = *(const u32x2*)(Y2 + (size_t)pa * D + 256 * j + 4 * lane); }
      if (pb >= 0) { gb = GATE[pb];
#pragma unroll
        for (int j = 0; j < 4; ++j) wb[j] = *(const u32x2*)(Y2 + (size_t)pb * D + 256 * j + 4 * lane); }
      if (pa >= 0) {
#pragma unroll
        for (int j = 0; j < 4; ++j) { aA[j][0] += ga * bflo(wa[j].x); aA[j][1] += ga * bfhi(wa[j].x); aA[j][2] += ga * bflo(wa[j].y); aA[j][3] += ga * bfhi(wa[j].y); } }
      if (pb >= 0) {
#pragma unroll
        for (int j = 0; j < 4; ++j) { aB[j][0] += gb * bflo(wb[j].x); aB[j][1] += gb * bfhi(wb[j].x); aB[j][2] += gb * bflo(wb[j].y); aB[j][3] += gb * bfhi(wb[j].y); } }
    }
    finish(r, hA, aA);
    if (hasB) finish(r + NGW, hB, aB);
    peA = pnA; peB = pnB;
#pragma unroll
    for (int j = 0; j < 4; ++j) { hA[j] = nA[j]; hB[j] = nB[j]; }
  }
}
__device__ __forceinline__ void phase_qkpost(const Params& P, int gw, int NGW, int lane) {
  const bf16_t* QKR = (const bf16_t*)(P.ws + WS_QKR); bf16_t* Q = (bf16_t*)(P.ws + WS_Q); bf16_t* Kb = (bf16_t*)(P.ws + WS_K); const f32x2* ropeC = (const f32x2*)(P.ws + WS_ROPEC);
  const float gq1 = P.in[IN_CQG][lane], gq2 = P.in[IN_CQG][64 + lane], gk1 = P.in[IN_CKG][lane], gk2 = P.in[IN_CKG][64 + lane];
  float v1[10], v2[10], n1_[10], n2_[10];
  if (gw < M) {
#pragma unroll
    for (int s = 0; s < 10; ++s) { v1[s] = bf2f(QKR[(size_t)gw * 1280 + s * 128 + lane]); v2[s] = bf2f(QKR[(size_t)gw * 1280 + s * 128 + 64 + lane]); } }
#pragma unroll 1
  for (int row = gw; row < M; row += NGW) {
    const int nrow = row + NGW < M ? row + NGW : row;
#pragma unroll
    for (int s = 0; s < 10; ++s) { n1_[s] = bf2f(QKR[(size_t)nrow * 1280 + s * 128 + lane]); n2_[s] = bf2f(QKR[(size_t)nrow * 1280 + s * 128 + 64 + lane]); }
    const int i = row % T; const bool lat = i >= L; const int sp = i - L;
    f32x2 cs1 = {1.f, 0.f}, cs2 = {1.f, 0.f};
    if (lat) { cs1 = ropeC[(sp >> 6) * 32 + (lane & 31)]; cs2 = ropeC[(sp & 63) * 32 + (lane & 31)]; }
#pragma unroll
    for (int slot = 0; slot < 10; ++slot) {
      if (slot < 8 && !lat) continue;
      const float a1 = v1[slot], a2 = v2[slot];
      const float rstd = rsqrtf(wave_sum(a1 * a1 + a2 * a2) * (1.f / 128.f) + EPS);
      const float m1 = a1 * rstd * (slot < 8 ? gq1 : gk1), m2 = a2 * rstd * (slot < 8 ? gq2 : gk2);
      const float p1 = __shfl_xor(m1, 32), p2 = __shfl_xor(m2, 32);
      const float o1 = lat ? ((lane < 32) ? m1 * cs1.x - p1 * cs1.y : p1 * cs1.y + m1 * cs1.x) : m1;
      const float o2 = lat ? ((lane < 32) ? m2 * cs2.x - p2 * cs2.y : p2 * cs2.y + m2 * cs2.x) : m2;
      bf16_t* dst = slot < 8 ? Q + (size_t)row * 1024 + slot * 128 : Kb + (size_t)row * 256 + (slot - 8) * 128;
      dst[lane] = (bf16_t)(cvt_pk_bf16(o1, 0.f) & 0xffffu); dst[64 + lane] = (bf16_t)(cvt_pk_bf16(o2, 0.f) & 0xffffu);
    }
#pragma unroll
    for (int s = 0; s < 10; ++s) { v1[s] = n1_[s]; v2[s] = n2_[s]; }
  }
}

__device__ __forceinline__ void topk_problem(const float* vals, int N, int cap, int row_base, int pbase, int e, int* IDX, float* GATE, int* INV, LAS unsigned* hist, LAS unsigned* misc) {
  const int tid = threadIdx.x, lane = tid & 63, wave = tid >> 6; const bool act = 16 * tid < N;
  unsigned v[16];
#pragma unroll
  for (int q = 0; q < 4; ++q) { u32x4 w = {0u, 0u, 0u, 0u}; if (act) w = *(const u32x4*)(vals + 16 * tid + 4 * q); v[4 * q] = w.x; v[4 * q + 1] = w.y; v[4 * q + 2] = w.z; v[4 * q + 3] = w.w; }
  unsigned prefix = 0u, pmask = 0u; int krem = cap;
#pragma unroll 1
  for (int pass = 0; pass < 4; ++pass) {
    const int shift = 24 - 8 * pass;
    if (tid < 256) hist[tid] = 0u;
    __syncthreads();
    if (act) {
#pragma unroll
      for (int i = 0; i < 16; ++i) if ((v[i] & pmask) == prefix) atomicAdd((unsigned*)(hist + ((v[i] >> shift) & 255u)), 1u);
    }
    __syncthreads();
    if (wave == 0) {
      const unsigned a0 = hist[255 - 4 * lane], a1 = hist[254 - 4 * lane], a2 = hist[253 - 4 * lane], a3 = hist[252 - 4 * lane];
      const int c0 = (int)a0, c1 = c0 + (int)a1, c2 = c1 + (int)a2, c3 = c2 + (int)a3;
      int incl = c3;
#pragma unroll
      for (int o = 1; o < 64; o <<= 1) { const int t = __shfl_up(incl, o); if (lane >= o) incl += t; }
      const int excl = incl - c3;
      if (excl < krem && krem <= incl) {
        const int j = (excl + c0 >= krem) ? 0 : (excl + c1 >= krem) ? 1 : (excl + c2 >= krem) ? 2 : 3;
        const int above = excl + (j == 0 ? 0 : j == 1 ? c0 : j == 2 ? c1 : c2);
        misc[0] = (unsigned)(255 - 4 * lane - j); misc[1] = (unsigned)(krem - above);
      }
    }
    __syncthreads();
    prefix |= misc[0] << shift; pmask |= 255u << shift; krem = (int)misc[1];
    __syncthreads();
  }
  int ngt = 0, neq = 0;
  if (act) {
#pragma unroll
    for (int i = 0; i < 16; ++i) { ngt += v[i] > prefix ? 1 : 0; neq += v[i] == prefix ? 1 : 0; }
  }
  int packed = ngt | (neq << 16), incl = packed;
#pragma unroll
  for (int o = 1; o < 64; o <<= 1) { const int t = __shfl_up(incl, o); if (lane >= o) incl += t; }
  if (lane == 63) misc[2 + wave] = (unsigned)incl;
  __syncthreads();
  int wpre = 0;
#pragma unroll
  for (int w = 0; w < 8; ++w) if (w < wave) wpre += (int)misc[2 + w];
  const int excl = wpre + incl - packed, gt_before = excl & 0xffff, eq_before = excl >> 16;
  if (act) {
    int slot = gt_before + (eq_before < krem ? eq_before : krem), eqi = eq_before;
#pragma unroll
    for (int i = 0; i < 16; ++i) {
      bool sel = v[i] > prefix;
      if (v[i] == prefix) { sel = eqi < krem; ++eqi; }
      if (sel) { const int row = row_base + 16 * tid + i; IDX[pbase + slot] = row; GATE[pbase + slot] = __uint_as_float(v[i]); INV[(size_t)row * 16 + e] = pbase + slot; ++slot; }
    }
  }
  __syncthreads();
}
__device__ __forceinline__ void phase_topk(const Params& P, LAS unsigned char* lds, int layer, int G) {
  const float* AFFL = (const float*)(P.ws + WS_AFFL); const float* AFFC = (const float*)(P.ws + WS_AFFC);
  int* IDX = (int*)(P.ws + WS_IDX); float* GATE = (float*)(P.ws + WS_GATE); int* INV = (int*)(P.ws + WS_INV);
  LAS unsigned* hist = (LAS unsigned*)(lds + LDS_TAB); LAS unsigned* misc = hist + 256;
  const int nprob = layer == 0 ? 64 : 32;
  for (int id = blockIdx.x; id < nprob; id += G) {
    const int ty = id >> 5, b = (id >> 4) & 1, e = id & 15;
    if (ty == 0) topk_problem(AFFL + ((size_t)b * 16 + e) * S, S, CAPL, b * T + L, e * PR + b * CAPL, e, IDX, GATE, INV, hist, misc);
    else {
      topk_problem(AFFC + ((size_t)b * 16 + e) * L, L, CAPC, b * T, e * PR + 2 * CAPL + b * CAPC, e, IDX, GATE, INV, hist, misc);
      if (b == 1) for (int q = threadIdx.x; q < PR - 2 * CAPL - 2 * CAPC; q += NTHR) { IDX[e * PR + 2 * CAPL + 2 * CAPC + q] = 0; GATE[e * PR + 2 * CAPL + 2 * CAPC + q] = 0.f; }
    }
  }
}


struct CvtStream {
  static constexpr int VM_EXTRA = 6;
  const float* const* in; unsigned char* ws; LAS float* scr; int lane;
  int s, le, which;
  int sgu, dgu, sd, dd;
  bf16_t* pdst; int pldt;
  f32x4 st[4];
  __device__ __forceinline__ void init(const Params& P, LAS unsigned char* lds, int t, int lane_, int wave) {
    in = P.in; ws = P.ws; scr = (LAS float*)(lds + 67584 + wave * 4224); lane = lane_; s = 0; le = 0; which = 0;
    { const int kb = t >> 6, n0 = (t & 63) * 32; sgu = kb * 32 * 2048 + n0; dgu = ((n0 >> 7) * 256 + (n0 & 127)) * 1024 + kb * 32; }
    { const int kb = t >> 5, n0 = (t & 31) * 32; sd = kb * 32 * 1024 + n0; dd = n0 * 2048 + kb * 32; }
    issue_point();
  }
  __device__ __forceinline__ void issue_point() {
    const bool dn = which == 2;
    const float* src = in[IN_WG + which] + (size_t)le * (1024 * 2048) + (dn ? sd : sgu);
    const int ldw = dn ? 1024 : 2048;
    pdst = dn ? (bf16_t*)(ws + WS_WD) + (size_t)le * (1024 * 2048) + dd : (bf16_t*)(ws + WS_WGU) + (size_t)le * (4096 * 1024) + which * (128 * 1024) + dgu;
    pldt = dn ? 2048 : 1024;
#if defined(EXP_FAKELD)
    const __amdgpu_buffer_rsrc_t rs = att::make_rsrc(in[IN_ABWO]);
#else
    const __amdgpu_buffer_rsrc_t rs = att::make_rsrc(src);
#endif
    const int voff = ((lane >> 3) * ldw + 4 * (lane & 7)) * 4, so = 8 * ldw * 4;
#pragma unroll
    for (int q = 0; q < 4; ++q) st[q] = __builtin_bit_cast(f32x4, __builtin_amdgcn_raw_buffer_load_b128(rs, voff, q * so, 2  ));
    if (s < 95) { ++s; if (++which == 3) { which = 0; ++le; } }
    else s = 96;
  }
  __device__ __forceinline__ void flush_point() {
    const int r = lane >> 3, c4 = (lane & 7) * 4;
#pragma unroll
    for (int q = 0; q < 4; ++q)
#pragma unroll
      for (int t = 0; t < 4; ++t) scr[(8 * q + r) * 33 + c4 + t] = st[q][t];
    LDS_WAIT(); asm volatile("" ::: "memory");
#if defined(EXP_FAKEST)
    const __amdgpu_buffer_rsrc_t rd = att::make_rsrc(ws + WS_H1 + (size_t)(blockIdx.x * 8 + (scr - (LAS float*)0) / 1056 % 8) * 2048); pldt = 32;
#else
    const __amdgpu_buffer_rsrc_t rd = att::make_rsrc(pdst);
#endif
#pragma unroll
    for (int u = 0; u < 2; ++u) { const int ii = lane + 64 * u, n = ii >> 2, c = ii & 3; const LAS float* sp = scr + (8 * c) * 33 + n;
      u32x4 o; o.x = cvt_pk_bf16(sp[0 * 33], sp[1 * 33]); o.y = cvt_pk_bf16(sp[2 * 33], sp[3 * 33]); o.z = cvt_pk_bf16(sp[4 * 33], sp[5 * 33]); o.w = cvt_pk_bf16(sp[6 * 33], sp[7 * 33]);
      __builtin_amdgcn_raw_buffer_store_b128(o, rd, (n * pldt + 8 * c) * 2, 0, 0); }
    LDS_WAIT(); asm volatile("" ::: "memory");
  }
  __device__ __forceinline__ void step() { flush_point(); issue_point(); }
  __device__ __forceinline__ void drain() { flush_point(); while (s < 96) { issue_point(); flush_point(); } }
};

template <class Hook> __device__ __forceinline__ void phase_attn(const Params& P, LAS unsigned char* lds, int layer, int G, Hook& hk) {
  const bf16_t* Q = (const bf16_t*)(P.ws + WS_Q); const bf16_t* Kb = (const bf16_t*)(P.ws + WS_K); const bf16_t* Vb = (const bf16_t*)(P.ws + WS_V); bf16_t* AC = (bf16_t*)(P.ws + WS_AC);
  const int bx = blockIdx.x; const int nunits = layer == 0 ? 528 : 512;
  for (int i = 0;; ++i) {
    int p, qb; bool isctx = false;
    if (G == 256) { const int xcd = bx & 7, loc = bx >> 3;
      if (i < 2) { p = xcd * 2 + i; qb = loc; } else if (i == 2 && layer == 0 && loc < 2) { p = xcd * 2 + loc; qb = 0; isctx = true; } else break;
    } else { const int uid = i * G + bx; if (uid >= nunits) break; if (uid < 512) { p = uid >> 5; qb = uid & 31; } else { p = uid - 512; qb = 0; isctx = true; } }
    const int b = p >> 3, h = p & 7;
    const size_t krow0 = (size_t)b * T, qrow0 = krow0 + (isctx ? 0 : L + qb * 256);
    const int seq = isctx ? L : T;
#ifndef ATT2
#define ATT2 1
#endif
#ifndef ATT3M
#define ATT3M 1
#endif
    if (ATT3M && layer == 0) att::attn_unit3<96, 64, 768, 768, 512, 1024>(Q + qrow0 * 768 + h * 96, Kb + krow0 * 768 + h * 96, Vb + krow0 * 512 + h * 64, AC + qrow0 * 1024 + 512 + h * 64, seq, (char*)lds);
    else if (ATT2 && layer == 0) att::attn_unit2<96, 64, 768, 768, 512, 1024>(Q + qrow0 * 768 + h * 96, Kb + krow0 * 768 + h * 96, Vb + krow0 * 512 + h * 64, AC + qrow0 * 1024 + 512 + h * 64, seq, (char*)lds);
#ifndef ATT3
#define ATT3 1
#endif
    else if (ATT3) att::attn_unit3<128, 128, 1024, 256, 256, 1024>(Q + qrow0 * 1024 + h * 128, Kb + krow0 * 256 + (h >> 2) * 128, Vb + krow0 * 256 + (h >> 2) * 128, AC + qrow0 * 1024 + h * 128, seq, (char*)lds);
    else if (ATT2) att::attn_unit2<128, 128, 1024, 256, 256, 1024>(Q + qrow0 * 1024 + h * 128, Kb + krow0 * 256 + (h >> 2) * 128, Vb + krow0 * 256 + (h >> 2) * 128, AC + qrow0 * 1024 + h * 128, seq, (char*)lds);
    else if (layer == 0)
      att::attn_unit<96, 64, 768, 768, 512, 1024, 2>(Q + qrow0 * 768 + h * 96, Kb + krow0 * 768 + h * 96, Vb + krow0 * 512 + h * 64, AC + qrow0 * 1024 + 512 + h * 64, seq, (char*)lds, hk);
    else
      att::attn_unit<128, 128, 1024, 256, 256, 1024, 2>(Q + qrow0 * 1024 + h * 128, Kb + krow0 * 256 + (h >> 2) * 128, Vb + krow0 * 256 + (h >> 2) * 128, AC + qrow0 * 1024 + h * 128, seq, (char*)lds, hk);
  }
}

__global__ void __launch_bounds__(NTHR, 2) mega_fwd(Params P_) {
  const Params& P = *(const Params*)__builtin_amdgcn_kernarg_segment_ptr(); (void)P_;
  extern __shared__ __attribute__((aligned(16))) unsigned char lds_raw[];
  LAS unsigned char* lds = (LAS unsigned char*)lds_raw;
  const int tid = threadIdx.x, lane = tid & 63, wave = __builtin_amdgcn_readfirstlane(tid >> 6);
  const int G = gridDim.x, bx = blockIdx.x;
  const int vcu = (G % 8 == 0) ? (bx % 8) * (G / 8) + bx / 8 : bx;
  const int gw = vcu * NWAVES + wave, NGW = G * NWAVES;
  volatile LAS unsigned* MISC = (volatile LAS unsigned*)(lds + LDS_MISC);
  if (tid < 64) MISC[tid] = 0u;
  __syncthreads();
  unsigned char* ws = P.ws;
  unsigned* ctl = (unsigned*)(ws + WS_CTL);
  XcdBarrier bar = xcd_barrier_post(ctl + CW_BAR + P.bar_region * XCD_BAR_WORDS, MISC + 8);
  const int lo = P.ph_lo, hi = P.ph_hi;
#ifndef ONLY_PH
#define ONLY_PH -1
#endif
#define IN(k) ((ONLY_PH < 0 || ONLY_PH == (k)) && lo <= (k) && (k) < hi)
#ifndef USE_CG
#define USE_CG 1
#endif
#if USE_CG
#define SEAM(k) do { if (IN(k) && IN((k) + 1)) { if ((k) == 0 && P.use_cg) cg::this_grid().sync(); else xcd_barrier(bar); if (DUP(25)) { xcd_barrier(bar); xcd_barrier(bar); } } } while (0)
#else
#define SEAM(k) do { if (IN(k) && IN((k) + 1)) xcd_barrier(bar); } while (0)
#endif
  float* SSQ = (float*)ctl + CW_SSQ; const float* MOD = (const float*)ctl + CW_MOD;
  const f32x2* ropeA = (const f32x2*)(ws + WS_ROPEA);

#ifndef DUP_MASK
#define DUP_MASK 0
#endif
#define DUP(k) ((DUP_MASK >> (k)) & 1)
  if (IN(0)) { p0_prologue(P, lds, gw, NGW, lane, wave); if (DUP(0)) { __syncthreads(); p0_prologue(P, lds, gw, NGW, lane, wave, true); } }
  SEAM(0);
  if (IN(1)) phase_r0(P, gw, NGW, lane);
  SEAM(1);
  if (IN(2)) {
    pg8::PlainSched Sd; Sd.init(ws + WS_XN, 1024, ws + WS_WIN0, 1024, M, 1024, G, bx);
    EpiInProj0 E{(bf16_t*)(ws + WS_FTL), (bf16_t*)(ws + WS_FTC), (bf16_t*)(ws + WS_P2), (bf16_t*)(ws + WS_K), SSQ, ropeA};
    pg8::gemm_phase(lds, 1024, Sd, E);
    if (G == 256 && bx >= 8) filler(P, lds, 0, bx - 8, lane, wave);
  }
  SEAM(2);
  if (IN(3)) {
    { pg8::QKVSched Sd; Sd.init(ws + WS_P2, ws + WS_WUQ, ws + WS_WUKV, G, bx); EpiQKV E{EpiQ{(bf16_t*)(ws + WS_Q), SSQ, ropeA}, EpiKV{(bf16_t*)(ws + WS_K), (bf16_t*)(ws + WS_V), SSQ}}; pg8::gemm_phase(lds, 256, Sd, E); }
#ifndef NO_FFT
    fft_phase(lds, (const bf16_t*)(ws + WS_FTL), (const bf16_t*)(ws + WS_FTC), (bf16_t*)(ws + WS_YC), G);
    if (DUP(21)) { for (int q_ = 0; q_ < 4; ++q_) fft_phase(lds, (const bf16_t*)(ws + WS_FTL), (const bf16_t*)(ws + WS_FTC), (bf16_t*)(ws + WS_YC), G); }
#endif
  }
  SEAM(3);
  if (IN(4)) {
    { att::NoHook nh; phase_attn(P, lds, 0, G, nh); if (DUP(4)) phase_attn(P, lds, 0, G, nh); }
    { pg8::PlainSched Sd; Sd.init(ws + WS_YC, 1024, ws + WS_WDFT, 1024, M, 512, G, bx); EpiBf16 E{(bf16_t*)(ws + WS_AC), 1024}; pg8::gemm_phase(lds, 1024, Sd, E); }
    if (G == 256 && bx >= 132) filler(P, lds, 6, bx - 132, lane, wave);
  }
  SEAM(4);
  if (IN(5)) { pg8::PlainSched Sd; Sd.init(ws + WS_AC, 1024, ws + WS_WO0, 1024, M, 1024, G, bx); EpiResid<true> E{(float*)(ws + WS_H), MOD, P.in[IN_X], P.in[IN_CTX]}; pg8::gemm_phase(lds, 1024, Sd, E); if (G == 256 && bx >= 8) filler(P, lds, 1, bx - 8, lane, wave); }
  SEAM(5);
  if (IN(6)) { phase_router(P, lds, 0, gw, NGW, lane); if (DUP(23)) { for (int q_ = 0; q_ < 4; ++q_) { __syncthreads(); phase_router(P, lds, 0, gw, NGW, lane); } } }
  SEAM(6);
  if (IN(7)) { phase_topk(P, lds, 0, G); if (DUP(22)) { for (int q_ = 0; q_ < 4; ++q_) phase_topk(P, lds, 0, G); } if (G == 256 && bx >= 64) filler(P, lds, 2, bx - 64, lane, wave); }
  SEAM(7);
  constexpr int MES = MOE_FP8 ? 1 : 2;
  if (IN(8)) { pg8::MoeSched<true, MES> Sd; Sd.init(ws + (MOE_FP8 ? WS_XN8 : WS_XN), 1024, 0, ws + WS_WGU, 1024, (size_t)4096 * 1024 * MES, (const int*)(ws + WS_IDX), 9, 16, G, bx); Sd.stage_idx((LAS int*)(lds + LDS_TAB)); EpiGateUp<MOE_FP8> E{ws + WS_H1}; pg8::gemm_phase(lds, 1024, Sd, E); if (DUP(8)) pg8::gemm_phase(lds, 1024, Sd, E);
    if (DUP(20)) { pg8::MoeSched<false, MES> S2; S2.init(ws + WS_XN8, 1024, (size_t)256 * 1024 * MES, ws + WS_WGU, 1024, (size_t)4096 * 1024 * MES, nullptr, 9, 16, G, bx); EpiGateUp<MOE_FP8> E2{ws + WS_Y2}; pg8::gemm_phase(lds, 1024, S2, E2); } }
  SEAM(8);
  if (IN(9)) { pg8::MoeSched<false, MES> Sd; Sd.init(ws + WS_H1, 2048, (size_t)PR * 2048 * MES, ws + WS_WD, 2048, (size_t)1024 * 2048 * MES, nullptr, 9, 4, G, bx); EpiDown<MOE_FP8> E{(bf16_t*)(ws + WS_Y2)}; pg8::gemm_phase(lds, 2048, Sd, E); if (DUP(9)) pg8::gemm_phase(lds, 2048, Sd, E);
    if (G == 256 && (bx >> 3) >= 8) filler(P, lds, 3, (bx & 7) * 24 + ((bx >> 3) - 8), lane, wave); }
  SEAM(9);
  if (IN(10)) phase_combine(P, 0, gw, NGW, lane);
  SEAM(10);
  if (IN(11)) { pg8::PlainSched Sd; Sd.init(ws + WS_XN, 1024, ws + WS_WIN1, 1024, M, 1536, G, bx); EpiInProj1 E{(bf16_t*)(ws + WS_QKR), (bf16_t*)(ws + WS_V)}; pg8::gemm_phase(lds, 1024, Sd, E); if (G == 256 && bx >= 140) filler(P, lds, 4, bx - 140, lane, wave); }
  SEAM(11);
  if (IN(12)) { phase_qkpost(P, gw, NGW, lane); if (DUP(24)) { for (int q_ = 0; q_ < 4; ++q_) phase_qkpost(P, gw, NGW, lane); } }
  SEAM(12);
  if (IN(13)) { att::NoHook nh; phase_attn(P, lds, 1, G, nh); if (DUP(13)) phase_attn(P, lds, 1, G, nh); }
  SEAM(13);
  if (IN(14)) { pg8::PlainSched Sd; Sd.init(ws + WS_AC, 1024, ws + WS_WO1, 1024, M, 1024, G, bx, 1); EpiResid<false> E{(float*)(ws + WS_H), MOD + 3 * 6144, nullptr, nullptr}; pg8::gemm_phase(lds, 1024, Sd, E); }
  SEAM(14);
  if (IN(15)) phase_router(P, lds, 1, gw, NGW, lane);
  SEAM(15);
  if (IN(16)) { phase_topk(P, lds, 1, G); if (G == 256 && bx >= 32) filler(P, lds, 5, bx - 32, lane, wave); }
  SEAM(16);
  if (IN(17)) { pg8::MoeSched<true, MES> Sd; Sd.init(ws + (MOE_FP8 ? WS_XN8 : WS_XN), 1024, 0, ws + WS_WGU + (size_t)16 * 4096 * 1024 * MES, 1024, (size_t)4096 * 1024 * MES, (const int*)(ws + WS_IDX), 8, 16, G, bx); Sd.stage_idx((LAS int*)(lds + LDS_TAB)); EpiGateUp<MOE_FP8> E{ws + WS_H1}; pg8::gemm_phase(lds, 1024, Sd, E); }
  SEAM(17);
  if (IN(18)) { pg8::MoeSched<false, MES> Sd; Sd.init(ws + WS_H1, 2048, (size_t)PR * 2048 * MES, ws + WS_WD + (size_t)16 * 1024 * 2048 * MES, 2048, (size_t)1024 * 2048 * MES, nullptr, 8, 4, G, bx); EpiDown<MOE_FP8> E{(bf16_t*)(ws + WS_Y2)}; pg8::gemm_phase(lds, 2048, Sd, E); }
  SEAM(18);
  if (IN(19)) phase_combine(P, 1, gw, NGW, lane);
#undef IN
#undef SEAM
}

struct Host { int grid; bool ok; };
inline Host& host_state() { static Host h{0, false}; return h; }
inline bool host_init(size_t ws_size) {
  Host& h = host_state();
  if (h.grid != 0) return h.ok;
  h.grid = -1; h.ok = false;
  if (ws_size < WS_END) { fprintf(stderr, "fk: workspace too small: %zu < %zu\n", ws_size, (size_t)WS_END); return false; }
  int dev = 0, cus = 0, per_cu = 0;
  if (hipGetDevice(&dev) != hipSuccess || hipDeviceGetAttribute(&cus, hipDeviceAttributeMultiprocessorCount, dev) != hipSuccess) return false;
  if (hipFuncSetAttribute((const void*)mega_fwd, hipFuncAttributeMaxDynamicSharedMemorySize, LDS_BYTES) != hipSuccess) { fprintf(stderr, "fk: hipFuncSetAttribute failed\n"); return false; }
  if (hipOccupancyMaxActiveBlocksPerMultiprocessor(&per_cu, (const void*)mega_fwd, NTHR, LDS_BYTES) != hipSuccess || per_cu < 1) { fprintf(stderr, "fk: occupancy query failed (%d)\n", per_cu); (void)hipGetLastError(); return false; }
  h.grid = cus * (per_cu > 1 ? 1 : per_cu);
  h.ok = true; return true;
}
inline void launch(hipStream_t st, void* const* d_in, float* out, void* ws, int lo, int hi, int region) {
  Params p; memset(&p, 0, sizeof(p));
  for (int i = 0; i < 23; ++i) p.in[i] = (const float*)d_in[i];
  p.out = out; p.ws = (unsigned char*)ws; p.ph_lo = lo; p.ph_hi = hi; p.bar_region = region; p.use_cg = 1;
  void* args[] = {&p};
  const hipError_t e = hipLaunchCooperativeKernel((const void*)mega_fwd, dim3(host_state().grid), dim3(NTHR), args, LDS_BYTES, st);
  if (e != hipSuccess) fprintf(stderr, "fk: cooperative launch failed: %s (grid %d)\n", hipGetErrorString(e), host_state().grid);
}
}


extern "C" void kernel_launch(void* const* d_in, const int* in_sizes, int n_in, void* d_out, int out_size, void* d_ws, size_t ws_size, hipStream_t stream) {
  if (n_in != 23 || out_size != fk::NB * fk::S * fk::D) { fprintf(stderr, "kernel_launch: unexpected shapes\n"); return; }
  if (!fk::host_init(ws_size)) return;
  hipMemsetAsync((char*)d_ws + fk::WS_CTL, 0, fk::CTL_BYTES, stream);
  fk::launch(stream, d_in, (float*)d_out, d_ws, 0, fk::NPH, 0);
}
```

```cpp
#include <hip/hip_runtime.h>
#include <cstdio>
#include <cstring>
#include <cstdint>

namespace nv {
__device__ __forceinline__ void sincos_acc(double x, float& s, float& c) {
  const double k = rint(x * 0.63661977236758134308);
  double r = fma(-k, 1.57079632679489655800e+00, x);
  r = fma(-k, 6.12323399573676603587e-17, r);
  const double r2 = r * r;
  double sp = 1.0 / 6227020800.0;
  sp = fma(sp, r2, -1.0 / 39916800.0);
  sp = fma(sp, r2, 1.0 / 362880.0);
  sp = fma(sp, r2, -1.0 / 5040.0);
  sp = fma(sp, r2, 1.0 / 120.0);
  sp = fma(sp, r2, -1.0 / 6.0);
  sp = fma(sp * r2, r, r);
  double cp = -1.0 / 87178291200.0;
  cp = fma(cp, r2, 1.0 / 479001600.0);
  cp = fma(cp, r2, -1.0 / 3628800.0);
  cp = fma(cp, r2, 1.0 / 40320.0);
  cp = fma(cp, r2, -1.0 / 720.0);
  cp = fma(cp, r2, 1.0 / 24.0);
  cp = fma(cp, r2, -0.5);
  cp = fma(cp, r2, 1.0);
  const int q = ((int)k) & 3;
  const double ss = (q == 0) ? sp : (q == 1) ? cp : (q == 2) ? -sp : -cp;
  const double cc = (q == 0) ? cp : (q == 1) ? -sp : (q == 2) ? -cp : sp;
  s = (float)ss; c = (float)cc;
}

}

#ifndef ATT4
#define ATT4 3
#endif
#ifndef ATT4_STRIP
#define ATT4_STRIP 0
#endif
#include <hip/hip_cooperative_groups.h>
namespace fk {
namespace cg = cooperative_groups;
#define LAS __attribute__((address_space(3)))
#define GAS __attribute__((address_space(1)))
typedef unsigned short bf16_t;
typedef short bf16x8 __attribute__((ext_vector_type(8)));
typedef short s16x4 __attribute__((ext_vector_type(4)));
typedef float f32x4 __attribute__((ext_vector_type(4)));
typedef float f32x2 __attribute__((ext_vector_type(2)));
typedef float f32x16 __attribute__((ext_vector_type(16)));
typedef unsigned u32x4 __attribute__((ext_vector_type(4)));
typedef unsigned u32x2 __attribute__((ext_vector_type(2)));

constexpr int D = 1024, NB = 2, S = 8192, L = 256, T = S + L, M = NB * T, MT = M / 256;
constexpr int NE = 16, FF = 2048, CAPL = 1024, CAPC = 32, PR = 2304;
constexpr float EPS = 1e-6f;
constexpr int NWAVES = 8, NTHR = 512;

constexpr size_t al256(size_t x) { return (x + 255) / 256 * 256; }
constexpr size_t WS_CTL = 0, CTL_BYTES = 1u << 20;
constexpr int CW_BAR = 1024;
constexpr int CW_MOD = 8192;
constexpr int CW_SSQ = CW_MOD + 36864;
constexpr int CW_CNT = CW_SSQ + 8 * M;
static_assert((CW_CNT + 48 * 64) * 4 <= (int)CTL_BYTES, "ctl");
constexpr size_t WS_WIN0 = CTL_BYTES;
constexpr size_t WS_WUQ = WS_WIN0 + (size_t)1024 * 1024 * 2;
constexpr size_t WS_WUKV = WS_WUQ + (size_t)768 * 256 * 2;
constexpr size_t WS_WDFT = WS_WUKV + (size_t)1024 * 256 * 2;
constexpr size_t WS_WO0 = WS_WDFT + (size_t)512 * 1024 * 2;
constexpr size_t WS_WIN1 = WS_WO0 + (size_t)1024 * 1024 * 2;
constexpr size_t WS_WO1 = WS_WIN1 + (size_t)1536 * 1024 * 2;
constexpr size_t WS_WGU = WS_WO1 + (size_t)1024 * 1024 * 2;
constexpr size_t WS_WD = WS_WGU + (size_t)2 * 16 * 4096 * 1024 * 2;
constexpr size_t WS_MODP = WS_WD + (size_t)2 * 16 * 1024 * 2048 * 2;
constexpr size_t WS_ROPEA = WS_MODP + (size_t)48 * 16 * 768 * 4;
constexpr size_t WS_ROPEC = WS_ROPEA + 128 * 8 * 8;
constexpr size_t WS_H = al256(WS_ROPEC + 128 * 32 * 8);
constexpr size_t WS_XN = WS_H + (size_t)M * D * 4;
constexpr size_t WS_XN8 = WS_XN + (size_t)M * D * 2;
constexpr size_t WS_P2 = WS_XN8 + (size_t)M * D;
constexpr size_t WS_FTL = WS_P2 + (size_t)M * 384 * 2;
constexpr size_t WS_FTC = WS_FTL + (size_t)2 * 128 * 8192 * 4 * 2;
constexpr size_t WS_YC = WS_FTC + (size_t)2 * 128 * 256 * 4 * 2;
constexpr size_t WS_AC = WS_YC + (size_t)M * D * 2;
constexpr size_t WS_Q = WS_AC + (size_t)M * D * 2;
constexpr size_t WS_K = WS_Q + (size_t)M * D * 2;
constexpr size_t WS_V = WS_K + (size_t)M * 768 * 2;
constexpr size_t WS_AFFL = WS_V + (size_t)M * 512 * 2;
constexpr size_t WS_AFFC = WS_AFFL + (size_t)2 * 16 * 8192 * 4;
constexpr size_t WS_IDX = WS_AFFC + (size_t)2 * 16 * 256 * 4;
constexpr size_t WS_GATE = WS_IDX + (size_t)16 * PR * 4;
constexpr size_t WS_INV = WS_GATE + (size_t)16 * PR * 4;
constexpr size_t WS_H1 = al256(WS_INV + (size_t)M * 16 * 4);
constexpr size_t WS_END = WS_H1 + (size_t)16 * PR * 2048 * 2;
constexpr size_t WS_QKR = WS_H1;
constexpr size_t WS_Y2 = WS_YC;
static_assert(WS_Y2 + (size_t)16 * PR * 1024 * 2 <= WS_K && (size_t)M * 1280 * 4 <= (size_t)16 * PR * 2048 * 2, "aliases");

constexpr int RING_BYTES = 131072;
constexpr int LDS_MISC = RING_BYTES;
constexpr int LDS_TAB = RING_BYTES + 1024;
constexpr int LDS_BYTES = 147456;

__device__ __forceinline__ unsigned cvt_pk_bf16(float lo, float hi) { unsigned r; asm volatile("v_cvt_pk_bf16_f32 %0, %1, %2" : "=v"(r) : "v"(lo), "v"(hi)); return r; }
__device__ __forceinline__ float bf2f(unsigned short b) { return __uint_as_float((unsigned)b << 16); }
__device__ __forceinline__ float bflo(unsigned w) { return __uint_as_float(w << 16); }
__device__ __forceinline__ float bfhi(unsigned w) { return __uint_as_float(w & 0xffff0000u); }
__device__ __forceinline__ float wave_sum(float v) {
#pragma unroll
  for (int o = 1; o < 64; o <<= 1) v += __shfl_xor(v, o);
  return v;
}
__device__ __forceinline__ float siluf(float x) { return x * __builtin_amdgcn_rcpf(1.f + __expf(-x)); }
using nv::sincos_acc;

#define XB_TMO      128
#define XB_XCNT(j)  (256  + 64 * (j))
#define XB_XSUB(j)  (1280 + 64 * (j))
#define XB_XGEN(j)  (2304 + 64 * (j))
#define XB_TOP      3328
#define XB_TOPGEN   3392
#define XCD_BAR_WORDS 3456
#define XB_SPIN_CAP (1u << 20)
__device__ __forceinline__ unsigned xb_ld(unsigned* p)              { return __hip_atomic_load(p, __ATOMIC_RELAXED, __HIP_MEMORY_SCOPE_AGENT); }
__device__ __forceinline__ unsigned xb_add(unsigned* p, unsigned v) { return __hip_atomic_fetch_add(p, v, __ATOMIC_RELAXED, __HIP_MEMORY_SCOPE_AGENT); }
__device__ __forceinline__ unsigned xb_xcc_id() { return (unsigned)__builtin_amdgcn_s_getreg((3 << 11) | 20) & 0xFu; }
#define XB_SPIN(cond, bar) do { unsigned _sp = 0; while (cond) { __builtin_amdgcn_s_sleep(1); \
    if ((++_sp & 255u) == 0u) { if (xb_ld(&(bar)[XB_TMO])) break; if (_sp > XB_SPIN_CAP) { atomicAdd(&(bar)[XB_TMO], 1u); break; } } } } while (0)
struct XcdBarrier { unsigned* bar; unsigned x; volatile LAS unsigned* st; };
__device__ __forceinline__ XcdBarrier xcd_barrier_post(unsigned* bar, volatile LAS unsigned* st) {
  XcdBarrier b; b.bar = bar; b.x = xb_xcc_id(); b.st = st;
  if (threadIdx.x == 0) (void)xb_add(&bar[XB_XCNT(b.x)], 1u);
  return b;
}
__device__ __forceinline__ void xcd_barrier_complete(unsigned* bar, unsigned x, unsigned& nloc, unsigned& nx) {
  const unsigned G = gridDim.x * gridDim.y * gridDim.z;
  unsigned sum, cnt, mine, sp = 0u;
  for (;;) {
    sum = 0u; cnt = 0u; mine = 0u;
#pragma unroll
    for (unsigned j = 0; j < 16; ++j) { const unsigned c = xb_ld(&bar[XB_XCNT(j)]); sum += c; cnt += (c > 0u) ? 1u : 0u; mine = (j == x) ? c : mine; }
    if (sum == G) break;
    __builtin_amdgcn_s_sleep(1);
    if ((++sp & 255u) == 0u) { if (xb_ld(&bar[XB_TMO])) break; if (sp > XB_SPIN_CAP) { atomicAdd(&bar[XB_TMO], 1u); break; } }
  }
  nloc = mine > 0u ? mine : 1u; nx = cnt > 0u ? cnt : 1u;
}
__device__ __forceinline__ void xcd_barrier(const XcdBarrier& b) {
  asm volatile("s_waitcnt vmcnt(0)" ::: "memory");
  __syncthreads();
  if (threadIdx.x == 0) {
    unsigned* bar = b.bar;
    __builtin_amdgcn_s_waitcnt(0);
    unsigned nloc = b.st[0], nx = b.st[1];
    if (nloc == 0u) { xcd_barrier_complete(bar, b.x, nloc, nx); b.st[0] = nloc; b.st[1] = nx; }
    const unsigned old = xb_add(&bar[XB_XSUB(b.x)], 1u);
    const unsigned gen = old / nloc;
    if (old + 1u == (gen + 1u) * nloc) {
      __builtin_amdgcn_fence(__ATOMIC_RELEASE, "agent");
      asm volatile("s_waitcnt vmcnt(0)" ::: "memory");
      const unsigned og = xb_add(&bar[XB_TOP], 1u);
      const unsigned tg = og / nx;
      if (og + 1u == (tg + 1u) * nx) xb_add(&bar[XB_TOPGEN], 1u);
      else XB_SPIN(xb_ld(&bar[XB_TOPGEN]) == tg, bar);
      __builtin_amdgcn_fence(__ATOMIC_ACQUIRE, "agent");
      xb_add(&bar[XB_XGEN(b.x)], 1u);
      asm volatile("s_waitcnt vmcnt(0)" ::: "memory");
    } else {
      XB_SPIN(xb_ld(&bar[XB_XGEN(b.x)]) == gen, bar);
      __builtin_amdgcn_fence(__ATOMIC_ACQUIRE, "agent");
      asm volatile("s_waitcnt vmcnt(0)" ::: "memory");
    }
  }
  __syncthreads();
}

namespace pg8 {
typedef int v4i_t __attribute__((ext_vector_type(4)));
typedef int v8i_t __attribute__((ext_vector_type(8)));
constexpr int BM = 256, BK = 64, HALF = 128, HTB = HALF * BK * 2, STAGE_BYTES = 8 * HTB, NXCD = 8, WGM = 8;
__host__ __device__ __forceinline__ int lds_byte(int r, int c) { const int st = (r >> 4) * 2 + (c >> 5), rr = r & 15, cc = c & 31, ob = rr * 64 + cc * 2; return st * 1024 + (ob ^ (((ob >> 9) & 1) << 5)); }
__host__ __device__ __forceinline__ void stage_rc(int b, int& R, int& C) { const int st = b / 1024, sb = b % 1024, swz = sb ^ (((sb >> 9) & 1) << 5); R = (st >> 1) * 16 + swz / 64; C = (st & 1) * 32 + (swz % 64) / 2; }
__host__ __device__ __forceinline__ int perm32(int rho) { const int n = rho >> 4, i = rho & 15; return 8 * (i >> 2) + 4 * n + (i & 3); }

struct Unit { int pm, pn, z, ord; };

struct PlainSched {
  const char* A; const char* Bt; int lda, ldb;
  static constexpr int es = 2;
  int nM, nN, nwg, G, c, skipctx;
  __device__ __forceinline__ void init(const void* A_, int lda_, const void* Bt_, int ldb_, int Mrows, int Ncols, int G_, int c_, int skipctx_ = 0) {
    A = (const char*)A_; Bt = (const char*)Bt_; lda = lda_; ldb = ldb_; skipctx = skipctx_; nM = skipctx_ ? 64 : Mrows / BM; nN = Ncols / BM; nwg = nM * nN; G = G_; c = c_; }
  __device__ __forceinline__ bool next(int i, Unit& u) const {
    const long Lq = (long)i * G + c; if (Lq >= nwg) return false;
    int wgid = (int)Lq; { const int q = nwg / NXCD, r = nwg % NXCD, xcd = wgid % NXCD, off = wgid / NXCD; wgid = (xcd < r ? xcd * (q + 1) : r * (q + 1) + (xcd - r) * q) + off; }
    const int nig = WGM * nN, gid = wgid / nig, fm = gid * WGM, gsz = (nM - fm) < WGM ? (nM - fm) : WGM;
    u.pm = fm + ((wgid % nig) % gsz); u.pn = (wgid % nig) / gsz; u.z = 0; u.ord = i; if (skipctx) u.pm += 1 + (u.pm >= 32 ? 1 : 0); return true;
  }
  __device__ __forceinline__ const char* a_base(const Unit& u) const { return A + (size_t)u.pm * BM * lda * 2; }
  __device__ __forceinline__ const char* b_base(const Unit& u) const { return Bt + (size_t)u.pn * BM * ldb * 2; }
  __device__ __forceinline__ void a_off(const Unit&, const int (&R)[2], const int (&C)[2], unsigned (&o)[2][2]) const {
#pragma unroll
    for (int h = 0; h < 2; ++h)
#pragma unroll
      for (int i = 0; i < 2; ++i) o[h][i] = (unsigned)((h * HALF + R[i]) * lda + C[i]) * 2u;
  }
};
struct QKVSched {
  static constexpr int es = 2;
  const char* A; const char* Bq; const char* Bkv; int lda, ldb, G, c;
  __device__ __forceinline__ void init(const void* P2, const void* Wq, const void* Wkv, int G_, int c_) { A = (const char*)P2; Bq = (const char*)Wq; Bkv = (const char*)Wkv; lda = 384; ldb = 256; G = G_; c = c_; }
  __device__ __forceinline__ bool next(int i, Unit& u) const {
    const int q = i * G + c; if (q >= 462) return false;
    if (q < 198) { u.z = 0; u.pm = q % 66; u.pn = q / 66; } else { const int r = q - 198; u.z = 1; u.pm = r % 66; u.pn = r / 66; }
    u.ord = i; return true;
  }
  __device__ __forceinline__ const char* a_base(const Unit& u) const { return A + (u.z ? 256 : 0) + (size_t)u.pm * BM * lda * 2; }
  __device__ __forceinline__ const char* b_base(const Unit& u) const { return (u.z ? Bkv : Bq) + (size_t)u.pn * BM * ldb * 2; }
  __device__ __forceinline__ void a_off(const Unit&, const int (&R)[2], const int (&C)[2], unsigned (&o)[2][2]) const {
#pragma unroll
    for (int h = 0; h < 2; ++h)
#pragma unroll
      for (int i = 0; i < 2; ++i) o[h][i] = (unsigned)((h * HALF + R[i]) * lda + C[i]) * 2u;
  }
};
template <bool GATHER, int ES> struct MoeSched {
  static constexpr int es = ES;
  const char* A; const char* Bt; int lda, ldb; size_t a_zstride, b_zstride;
  const int* idx;
  const LAS int* lidx;
  int TM, nN, per_x, vloc, xcd;
  __device__ __forceinline__ void init(const void* A_, int lda_, size_t azs, const void* Bt_, int ldb_, size_t bzs, const int* idx_, int TM_, int nN_, int G, int c) {
    A = (const char*)A_; Bt = (const char*)Bt_; lda = lda_; ldb = ldb_; a_zstride = azs; b_zstride = bzs; idx = idx_; TM = TM_; nN = nN_;
    xcd = c % 8; vloc = c / 8; per_x = 2 * TM * nN; (void)G; }
  __device__ __forceinline__ void stage_idx(LAS int* dst) {
    lidx = dst; Unit u;
    for (int i = 0; next(i, u); ++i) for (int r = threadIdx.x; r < BM; r += NTHR) dst[i * BM + r] = idx[u.z * PR + u.pm * BM + r];
    __syncthreads();
  }
  __device__ __forceinline__ bool next(int i, Unit& u) const {
    const int q = i * 32 + vloc; if (q >= per_x) return false;
    u.pm = q % TM; u.pn = (q / TM) % nN; u.z = xcd * 2 + q / (TM * nN); u.ord = i; return true;
  }
  __device__ __forceinline__ const char* a_base(const Unit& u) const { return GATHER ? A : A + (size_t)u.z * a_zstride + (size_t)u.pm * BM * lda * ES; }
  __device__ __forceinline__ const char* b_base(const Unit& u) const { return Bt + (size_t)u.z * b_zstride + (size_t)u.pn * BM * ldb * ES; }
  __device__ __forceinline__ void a_off(const Unit& u, const int (&R)[2], const int (&C)[2], unsigned (&o)[2][2]) const {
#pragma unroll
    for (int h = 0; h < 2; ++h)
#pragma unroll
      for (int i = 0; i < 2; ++i) {
        if (GATHER) { const int row = lidx[u.ord * BM + h * HALF + R[i]]; o[h][i] = (unsigned)(row * lda * ES + C[i] * 2); }
        else o[h][i] = (unsigned)((h * HALF + R[i]) * lda * ES + C[i] * 2);
      }
  }
};

template <class Epi, class Sched>
__device__ __forceinline__ void gemm_phase(LAS unsigned char* lds, const int K, const Sched& S, const Epi& E) {
  constexpr int ES = Sched::es; constexpr bool FP8 = ES == 1;
  const int tid = threadIdx.x, wid = __builtin_amdgcn_readfirstlane(tid >> 6), lane = tid & 63, wr = wid >> 2, wc = wid & 3, fr = lane & 15, fq = lane >> 4;
  const int nt = K * ES / (BK * 2);
  int RA[2], CA[2]; unsigned voffB[2];
#pragma unroll
  for (int i = 0; i < 2; ++i) { int R, C; stage_rc(tid * 16 + i * 8192, R, C); const int Rb = (R & ~31) + perm32(R & 31);
    RA[i] = R; CA[i] = C; voffB[i] = (unsigned)(Rb * S.ldb * ES + C * 2); }
  const size_t kstep = (size_t)(BK * 2);
  const size_t hstepB = (size_t)HALF * S.ldb * ES;
  const unsigned ldsw = (unsigned)wid * 1024u;
  const int aoff = lds_byte(wr * 64 + fr, fq * 8), boff = lds_byte(wc * 32 + fr, fq * 8);
#define PG8_SA(b, h) (((b) * 2 + (h)) * HTB)
#define PG8_SB(b, h) ((4 + (b) * 2 + (h)) * HTB)
#define PG8_STAGE2(bufoff, gbase, v0, v1) do { \
    __builtin_amdgcn_global_load_lds((const unsigned*)((const char*)(gbase) + (v0)), (LAS unsigned*)(lds + (bufoff) + ldsw), 16, 0, 0); \
    __builtin_amdgcn_global_load_lds((const unsigned*)((const char*)(gbase) + (v1)), (LAS unsigned*)(lds + (bufoff) + ldsw + 8192), 16, 0, 0); } while (0)
#define PG8_STAGEB(bufoff, gbase) PG8_STAGE2(bufoff, gbase, voffB[0], voffB[1])
#define PG8_LDA(dst, b, h) do { if constexpr (FP8) { _Pragma("unroll") for (int m = 0; m < 4; ++m) { const v4i_t lo_ = *(const LAS v4i_t*)(lds + PG8_SA(b, h) + aoff + m * 2048), hi_ = *(const LAS v4i_t*)(lds + PG8_SA(b, h) + aoff + m * 2048 + 1024); dst##8[m] = __builtin_shufflevector(lo_, hi_, 0, 1, 2, 3, 4, 5, 6, 7); } } \
    else { _Pragma("unroll") for (int m = 0; m < 4; ++m) _Pragma("unroll") for (int k = 0; k < 2; ++k) dst[m][k] = *(const LAS bf16x8*)(lds + PG8_SA(b, h) + aoff + m * 2048 + k * 1024); } } while (0)
#define PG8_LDB(dst, b, h) do { if constexpr (FP8) { _Pragma("unroll") for (int n = 0; n < 2; ++n) { const v4i_t lo_ = *(const LAS v4i_t*)(lds + PG8_SB(b, h) + boff + n * 2048), hi_ = *(const LAS v4i_t*)(lds + PG8_SB(b, h) + boff + n * 2048 + 1024); dst##8[n] = __builtin_shufflevector(lo_, hi_, 0, 1, 2, 3, 4, 5, 6, 7); } } \
    else { _Pragma("unroll") for (int n = 0; n < 2; ++n) _Pragma("unroll") for (int k = 0; k < 2; ++k) dst[n][k] = *(const LAS bf16x8*)(lds + PG8_SB(b, h) + boff + n * 2048 + k * 1024); } } while (0)
#define PG8_CAT(x, y) __builtin_shufflevector(__builtin_bit_cast(v4i_t, x), __builtin_bit_cast(v4i_t, y), 0, 1, 2, 3, 4, 5, 6, 7)
#define PG8_MMA(ai, bj, At, Bt) do { __builtin_amdgcn_s_setprio(1); \
    if constexpr (FP8) { _Pragma("unroll") for (int m = 0; m < 4; ++m) _Pragma("unroll") for (int n = 0; n < 2; ++n) \
        asm volatile("v_mfma_scale_f32_16x16x128_f8f6f4 %0, %1, %2, %0, %3, %3 op_sel_hi:[0,0,0]" : "+v"(acc[ai][bj][m][n]) : "v"(Bt##8[n]), "v"(At##8[m]), "v"(scl8)); } \
    else { _Pragma("unroll") for (int m = 0; m < 4; ++m) _Pragma("unroll") for (int n = 0; n < 2; ++n) _Pragma("unroll") for (int k = 0; k < 2; ++k) \
        acc[ai][bj][m][n] = __builtin_amdgcn_mfma_f32_16x16x32_bf16(Bt[n][k], At[m][k], acc[ai][bj][m][n], 0, 0, 0); } \
    __builtin_amdgcn_s_setprio(0); } while (0)
#define PG8_WAIT_V(n) asm volatile("s_waitcnt vmcnt(" #n ")" ::: "memory")
#define PG8_WAIT_L(n) asm volatile("s_waitcnt lgkmcnt(" #n ")" ::: "memory")
#define PG8_BAR __builtin_amdgcn_s_barrier()
#define PG8_SCHED __builtin_amdgcn_sched_barrier(0)
  Unit cur, nxt; int ui = 0;
  if (!S.next(0, cur)) return;
  f32x4 acc[2][2][4][2];
#pragma unroll
  for (int a = 0; a < 2; ++a)
#pragma unroll
    for (int b = 0; b < 2; ++b)
#pragma unroll
      for (int m = 0; m < 4; ++m)
#pragma unroll
        for (int n = 0; n < 2; ++n) acc[a][b][m][n] = (f32x4){0.f, 0.f, 0.f, 0.f};
  bf16x8 At[4][2], B0[2][2], B1[2][2]; v8i_t At8[4], B08[2], B18[2];
  int scl8 = 0x7f7f7f7f; asm volatile("" : "+v"(scl8));
  const char* cA = S.a_base(cur); const char* cB = S.b_base(cur);
  unsigned oC[2][2], oN[2][2];
  S.a_off(cur, RA, CA, oC);
  PG8_STAGEB(PG8_SB(0, 0), cB); PG8_STAGEB(PG8_SB(0, 1), cB + hstepB); PG8_STAGE2(PG8_SA(0, 0), cA, oC[0][0], oC[0][1]); PG8_STAGE2(PG8_SA(0, 1), cA, oC[1][0], oC[1][1]);
  if (wr == 1) PG8_BAR;
  PG8_WAIT_V(2); PG8_BAR;
  PG8_STAGEB(PG8_SB(1, 0), cB + kstep); PG8_STAGE2(PG8_SA(1, 0), cA + kstep, oC[0][0], oC[0][1]); PG8_STAGEB(PG8_SB(1, 1), cB + hstepB + kstep);
  PG8_WAIT_V(6); PG8_BAR;
  for (;;) {
    const bool has_next = S.next(ui + 1, nxt);
    const char* nA = has_next ? S.a_base(nxt) : cA; const char* nB = has_next ? S.b_base(nxt) : cB;
    if (has_next) S.a_off(nxt, RA, CA, oN);
    else {
#pragma unroll
      for (int h = 0; h < 2; ++h)
#pragma unroll
        for (int i = 0; i < 2; ++i) oN[h][i] = oC[h][i];
    }
#pragma unroll 1
    for (int t = 0; t < nt; t += 2) {
      const bool last = (t == nt - 2);
      const char* a1 = cA + (size_t)(t + 1) * kstep;
      const char* a2 = last ? nA : cA + (size_t)(t + 2) * kstep; const char* b2 = last ? nB : cB + (size_t)(t + 2) * kstep;
      const char* a3 = a2 + kstep; const char* b3 = b2 + kstep;
      const unsigned x00 = last ? oN[0][0] : oC[0][0], x01 = last ? oN[0][1] : oC[0][1], x10 = last ? oN[1][0] : oC[1][0], x11 = last ? oN[1][1] : oC[1][1];
      PG8_LDB(B0, 0, 0); PG8_LDB(B1, 0, 1); PG8_SCHED; PG8_LDA(At, 0, 0); PG8_STAGE2(PG8_SA(1, 1), a1, oC[1][0], oC[1][1]);
      PG8_WAIT_V(8); PG8_WAIT_L(0); PG8_BAR; PG8_MMA(0, 0, At, B0); PG8_MMA(0, 1, At, B1); PG8_BAR; PG8_SCHED;
      PG8_LDA(At, 0, 1); PG8_STAGEB(PG8_SB(0, 0), b2); PG8_STAGEB(PG8_SB(0, 1), b2 + hstepB); PG8_STAGE2(PG8_SA(0, 0), a2, x00, x01);
      PG8_WAIT_V(8); PG8_WAIT_L(0); PG8_BAR; PG8_MMA(1, 0, At, B0); PG8_MMA(1, 1, At, B1); PG8_BAR; PG8_SCHED;
      PG8_LDB(B0, 1, 0); PG8_LDB(B1, 1, 1); PG8_SCHED; PG8_LDA(At, 1, 0); PG8_STAGE2(PG8_SA(0, 1), a2, x10, x11);
      PG8_WAIT_V(8); PG8_WAIT_L(0); PG8_BAR; PG8_MMA(0, 0, At, B0); PG8_MMA(0, 1, At, B1); PG8_BAR; PG8_SCHED;
      PG8_LDA(At, 1, 1); PG8_STAGEB(PG8_SB(1, 0), b3); PG8_STAGEB(PG8_SB(1, 1), b3 + hstepB); PG8_STAGE2(PG8_SA(1, 0), a3, x00, x01);
      PG8_WAIT_V(8); PG8_WAIT_L(0); PG8_BAR; PG8_MMA(1, 0, At, B0); PG8_MMA(1, 1, At, B1); PG8_BAR; PG8_SCHED;
    }
    if constexpr (FP8) {
#pragma unroll
      for (int a = 0; a < 2; ++a)
#pragma unroll
        for (int b = 0; b < 2; ++b)
          asm volatile("s_nop 15\n\ts_nop 15" : "+v"(acc[a][b][0][0]), "+v"(acc[a][b][0][1]), "+v"(acc[a][b][1][0]), "+v"(acc[a][b][1][1]), "+v"(acc[a][b][2][0]), "+v"(acc[a][b][2][1]), "+v"(acc[a][b][3][0]), "+v"(acc[a][b][3][1]));
    }
    if (wr == 0) PG8_BAR;
    E(acc, cur, wr, wc, fr, fq);
#ifdef EXP_EPI2
    if constexpr (FP8) E(acc, cur, wr, wc, fr, fq);
#endif
    if (!has_next) break;
#pragma unroll
    for (int a = 0; a < 2; ++a)
#pragma unroll
      for (int b = 0; b < 2; ++b)
#pragma unroll
        for (int m = 0; m < 4; ++m)
#pragma unroll
          for (int n = 0; n < 2; ++n) acc[a][b][m][n] = (f32x4){0.f, 0.f, 0.f, 0.f};
    cur = nxt; cA = nA; cB = nB; ++ui;
#pragma unroll
    for (int h = 0; h < 2; ++h)
#pragma unroll
      for (int i = 0; i < 2; ++i) oC[h][i] = oN[h][i];
    if (wr == 1) PG8_BAR;
  }
  PG8_WAIT_V(0);
  PG8_BAR;
#undef PG8_SA
#undef PG8_SB
#undef PG8_STAGE2
#undef PG8_STAGEB
#undef PG8_LDA
#undef PG8_LDB
#undef PG8_MMA
#undef PG8_CAT
#undef PG8_WAIT_V
#undef PG8_WAIT_L
#undef PG8_BAR
#undef PG8_SCHED
}
}

typedef f32x4 AccT[2][2][4][2];
__device__ __forceinline__ u32x4 pack8(const f32x4 a, const f32x4 b) { u32x4 w; w.x = cvt_pk_bf16(a[0], a[1]); w.y = cvt_pk_bf16(a[2], a[3]); w.z = cvt_pk_bf16(b[0], b[1]); w.w = cvt_pk_bf16(b[2], b[3]); return w; }
__device__ __forceinline__ float clamp448(float x) { return __builtin_amdgcn_fmed3f(x, -448.f, 448.f); }
__device__ __forceinline__ unsigned pack4_fp8(float a, float b, float c, float d) {
  int w = 0; w = __builtin_amdgcn_cvt_pk_fp8_f32(clamp448(a), clamp448(b), w, false); w = __builtin_amdgcn_cvt_pk_fp8_f32(clamp448(c), clamp448(d), w, true); return (unsigned)w; }
__device__ __forceinline__ u32x2 pack8_fp8(const f32x4 a, const f32x4 b) { u32x2 w; w.x = pack4_fp8(a[0], a[1], a[2], a[3]); w.y = pack4_fp8(b[0], b[1], b[2], b[3]); return w; }
constexpr float W8_SCALE = 32.f, H8_SCALE = 4.f;
__device__ __forceinline__ void rope8(f32x4& v0, f32x4& v1, int fq, int prow, int pcol, const f32x2* tab) {
  const f32x2* tp = tab + (fq < 2 ? prow : pcol) * 8;
#pragma unroll
  for (int n = 0; n < 2; ++n)
#pragma unroll
    for (int j = 0; j < 4; ++j) {
      const float x = n == 0 ? v0[j] : v1[j];
      const float p = __shfl_xor(x, 16);
      const f32x2 cs = tp[4 * n + j];
      const float o = (fq & 1) ? (p * cs.y + x * cs.x) : (x * cs.x - p * cs.y);
      if (n == 0) v0[j] = o; else v1[j] = o;
    }
}
struct EpiInProj0 {
  bf16_t* FTL; bf16_t* FTC; bf16_t* P2; bf16_t* Kb; float* ssq; const f32x2* ropeA;
  __device__ __forceinline__ void operator()(const AccT& acc, const pg8::Unit& u, int wr, int wc, int fr, int fq) const {
    const int b = u.pm / 33; const bool isctx = (u.pm % 33) == 0;
#pragma unroll
    for (int ai = 0; ai < 2; ++ai)
#pragma unroll
      for (int m = 0; m < 4; ++m) {
        const int row = u.pm * 256 + ai * 128 + wr * 64 + m * 16 + fr, i = row - b * T;
        if (u.pn < 2) {
#pragma unroll
          for (int bj = 0; bj < 2; ++bj) {
            const int c0 = u.pn * 256 + bj * 128 + wc * 32 + 8 * fq, cb = c0 >> 2;
            const f32x4 v0 = acc[ai][bj][m][0], v1 = acc[ai][bj][m][1];
            u32x2 w0, w1; w0.x = cvt_pk_bf16(v0[0], v0[1]); w0.y = cvt_pk_bf16(v0[2], v0[3]); w1.x = cvt_pk_bf16(v1[0], v1[1]); w1.y = cvt_pk_bf16(v1[2], v1[3]);
            bf16_t* d = isctx ? FTC + ((size_t)(b * 128 + cb) * 256 + i) * 4 : FTL + ((size_t)(b * 128 + cb) * 8192 + (i - 256)) * 4;
            *(u32x2*)d = w0; *(u32x2*)(d + (isctx ? 256 * 4 : 8192 * 4)) = w1;
          }
        } else if (u.pn == 2) {
          float ss = 0.f;
#pragma unroll
          for (int bj = 0; bj < 2; ++bj) {
            const f32x4 v0 = acc[ai][bj][m][0], v1 = acc[ai][bj][m][1];
            ss += (v0[0] * v0[0] + v0[1] * v0[1]) + (v0[2] * v0[2] + v0[3] * v0[3]) + (v1[0] * v1[0] + v1[1] * v1[1]) + (v1[2] * v1[2] + v1[3] * v1[3]);
            *(u32x4*)(P2 + (size_t)row * 384 + bj * 128 + wc * 32 + 8 * fq) = pack8(v0, v1);
          }
          ss += __shfl_xor(ss, 16); ss += __shfl_xor(ss, 32);
          if (fq == 0) ssq[row * 8 + wc] = ss;
        } else {
          { const f32x4 v0 = acc[ai][0][m][0], v1 = acc[ai][0][m][1];
            float ss = (v0[0] * v0[0] + v0[1] * v0[1]) + (v0[2] * v0[2] + v0[3] * v0[3]) + (v1[0] * v1[0] + v1[1] * v1[1]) + (v1[2] * v1[2] + v1[3] * v1[3]);
            *(u32x4*)(P2 + (size_t)row * 384 + 256 + wc * 32 + 8 * fq) = pack8(v0, v1);
            ss += __shfl_xor(ss, 16); ss += __shfl_xor(ss, 32);
            if (fq == 0) ssq[row * 8 + 4 + wc] = ss; }
          if (wc == 0) {
            f32x4 v0 = acc[ai][1][m][0], v1 = acc[ai][1][m][1];
            if (!isctx) { const int s = i - 256; rope8(v0, v1, fq, s >> 6, s & 63, ropeA); }
            const u32x4 w = pack8(v0, v1);
#pragma unroll
            for (int h = 0; h < 8; ++h) *(u32x4*)(Kb + (size_t)row * 768 + h * 96 + 64 + 8 * fq) = w;
          }
        }
      }
  }
};
struct EpiQ {
  bf16_t* Q; const float* ssq; const f32x2* ropeA;
  __device__ __forceinline__ void operator()(const AccT& acc, const pg8::Unit& u, int wr, int wc, int fr, int fq) const {
    const int b = u.pm / 33; const bool isctx = (u.pm % 33) == 0;
#pragma unroll
    for (int ai = 0; ai < 2; ++ai)
#pragma unroll
      for (int m = 0; m < 4; ++m) {
        const int row = u.pm * 256 + ai * 128 + wr * 64 + m * 16 + fr, i = row - b * T, s = i - 256;
        const f32x4 s4 = *(const f32x4*)(ssq + row * 8); const float rstd = rsqrtf(((s4[0] + s4[1]) + (s4[2] + s4[3])) * (1.f / 256.f) + EPS);
#pragma unroll
        for (int bj = 0; bj < 2; ++bj) {
          const int g32 = u.pn * 8 + bj * 4 + wc;
          f32x4 v0 = acc[ai][bj][m][0] * rstd, v1 = acc[ai][bj][m][1] * rstd;
          if ((g32 % 3) == 2 && !isctx) rope8(v0, v1, fq, s >> 6, s & 63, ropeA);
          *(u32x4*)(Q + (size_t)row * 768 + g32 * 32 + 8 * fq) = pack8(v0, v1);
          asm volatile("" ::: "memory");
        }
      }
  }
};
struct EpiKV {
  bf16_t* Kb; bf16_t* Vb; const float* ssq;
  __device__ __forceinline__ void operator()(const AccT& acc, const pg8::Unit& u, int wr, int wc, int fr, int fq) const {
#pragma unroll
    for (int ai = 0; ai < 2; ++ai)
#pragma unroll
      for (int m = 0; m < 4; ++m) {
        const int row = u.pm * 256 + ai * 128 + wr * 64 + m * 16 + fr;
        const f32x4 s4 = *(const f32x4*)(ssq + row * 8 + 4); const float rstd = rsqrtf(((s4[0] + s4[1]) + (s4[2] + s4[3])) * (1.f / 128.f) + EPS);
#pragma unroll
        for (int bj = 0; bj < 2; ++bj) {
          const int head = u.pn * 2 + bj, d = wc * 32 + 8 * fq;
          const u32x4 w = pack8(acc[ai][bj][m][0] * rstd, acc[ai][bj][m][1] * rstd);
          if (wc < 2) *(u32x4*)(Kb + (size_t)row * 768 + head * 96 + d) = w; else *(u32x4*)(Vb + (size_t)row * 512 + head * 64 + (d - 64)) = w;
        }
        asm volatile("" ::: "memory");
      }
  }
};
struct EpiQKV { EpiQ q; EpiKV kv;
  __device__ __forceinline__ void operator()(const AccT& acc, const pg8::Unit& u, int wr, int wc, int fr, int fq) const { if (u.z == 0) q(acc, u, wr, wc, fr, fq); else kv(acc, u, wr, wc, fr, fq); } };
struct EpiBf16 {
  bf16_t* O; int ldo;
  __device__ __forceinline__ void operator()(const AccT& acc, const pg8::Unit& u, int wr, int wc, int fr, int fq) const {
#pragma unroll
    for (int ai = 0; ai < 2; ++ai)
#pragma unroll
      for (int m = 0; m < 4; ++m) {
        const size_t row = (size_t)u.pm * 256 + ai * 128 + wr * 64 + m * 16 + fr;
#pragma unroll
        for (int bj = 0; bj < 2; ++bj) *(u32x4*)(O + row * ldo + u.pn * 256 + bj * 128 + wc * 32 + 8 * fq) = pack8(acc[ai][bj][m][0], acc[ai][bj][m][1]);
      }
  }
};
template <bool FIRST> struct EpiResid {
  float* H; const float* modl; const float* x; const float* ctx;
  __device__ __forceinline__ void operator()(const AccT& acc, const pg8::Unit& u, int wr, int wc, int fr, int fq) const {
    const int b = u.pm / 33, pt = u.pm % 33; const bool isctx = pt == 0;
    const float* g1 = modl + (isctx ? 2 : b) * 6144 + 2048;
    const float* src = FIRST ? (isctx ? ctx + (size_t)b * L * D : x + ((size_t)b * S + (size_t)(pt - 1) * 256) * D) : H + (size_t)u.pm * 256 * D;
#pragma unroll
    for (int bj = 0; bj < 2; ++bj) {
      const int c0 = u.pn * 256 + bj * 128 + wc * 32 + 8 * fq;
      const f32x4 ga = *(const f32x4*)(g1 + c0), gb = *(const f32x4*)(g1 + c0 + 4);
#pragma unroll
      for (int ai = 0; ai < 2; ++ai)
#pragma unroll
        for (int m = 0; m < 4; ++m) {
          const size_t ro = (size_t)(ai * 128 + wr * 64 + m * 16 + fr) * D + c0;
          const float* sp = src + ro; float* hp = H + (size_t)u.pm * 256 * D + ro;
          const f32x4 h0 = *(const f32x4*)sp, h1 = *(const f32x4*)(sp + 4);
          *(f32x4*)hp = h0 + ga * acc[ai][bj][m][0]; *(f32x4*)(hp + 4) = h1 + gb * acc[ai][bj][m][1];
        }
    }
  }
};
template <bool F8> struct EpiGateUp {
  void* H1;
  __device__ __forceinline__ void operator()(const AccT& acc, const pg8::Unit& u, int wr, int wc, int fr, int fq) const {
    constexpr float ws = F8 ? 1.f / W8_SCALE : 1.f, hs = F8 ? H8_SCALE : 1.f;
#pragma unroll
    for (int ai = 0; ai < 2; ++ai)
#pragma unroll
      for (int m = 0; m < 4; ++m) {
        const size_t prow = (size_t)u.z * PR + u.pm * 256 + ai * 128 + wr * 64 + m * 16 + fr;
        f32x4 o0, o1;
#pragma unroll
        for (int j = 0; j < 4; ++j) { o0[j] = siluf(acc[ai][0][m][0][j] * ws) * (acc[ai][1][m][0][j] * (ws * hs)); o1[j] = siluf(acc[ai][0][m][1][j] * ws) * (acc[ai][1][m][1][j] * (ws * hs)); }
        const size_t off = prow * FF + u.pn * 128 + wc * 32 + 8 * fq;
        if constexpr (F8) *(u32x2*)((unsigned char*)H1 + off) = pack8_fp8(o0, o1); else *(u32x4*)((bf16_t*)H1 + off) = pack8(o0, o1);
      }
  }
};
template <bool F8> struct EpiDown {
  bf16_t* Y2;
  __device__ __forceinline__ void operator()(const AccT& acc, const pg8::Unit& u, int wr, int wc, int fr, int fq) const {
    constexpr float sc = F8 ? 1.f / (W8_SCALE * H8_SCALE) : 1.f;
#pragma unroll
    for (int ai = 0; ai < 2; ++ai)
#pragma unroll
      for (int m = 0; m < 4; ++m) {
        const size_t prow = (size_t)u.z * PR + u.pm * 256 + ai * 128 + wr * 64 + m * 16 + fr;
#pragma unroll
        for (int bj = 0; bj < 2; ++bj) *(u32x4*)(Y2 + prow * D + u.pn * 256 + bj * 128 + wc * 32 + 8 * fq) = pack8(acc[ai][bj][m][0] * sc, acc[ai][bj][m][1] * sc);
      }
  }
};
struct EpiInProj1 {
  bf16_t* QKR; bf16_t* Vb;
  __device__ __forceinline__ void operator()(const AccT& acc, const pg8::Unit& u, int wr, int wc, int fr, int fq) const {
#pragma unroll
    for (int ai = 0; ai < 2; ++ai)
#pragma unroll
      for (int m = 0; m < 4; ++m) {
        const size_t row = (size_t)u.pm * 256 + ai * 128 + wr * 64 + m * 16 + fr;
#pragma unroll
        for (int bj = 0; bj < 2; ++bj) {
          const int c0 = u.pn * 256 + bj * 128 + wc * 32 + 8 * fq;
          if (u.pn < 5) *(u32x4*)(QKR + row * 1280 + c0) = pack8(acc[ai][bj][m][0], acc[ai][bj][m][1]);
          else *(u32x4*)(Vb + row * 256 + (c0 - 1280)) = pack8(acc[ai][bj][m][0], acc[ai][bj][m][1]);
        }
      }
  }
};

__device__ __forceinline__ f32x2 cmul(f32x2 a, f32x2 b) { return (f32x2){a.x * b.x - a.y * b.y, a.x * b.y + a.y * b.x}; }
template <int N, int LOGN>
__device__ __forceinline__ void fft_item(LAS f32x2* d, const LAS f32x2* T1, const LAS f32x2* T2, const bf16_t* src, bf16_t* yc_row0, int kcol, float norm, int tid) {
  for (int c = tid; c < N / 2; c += NTHR) {
    const u32x4 w = *(const u32x4*)(src + (size_t)c * 8);
    *(LAS f32x4*)(d + 2 * c) = (f32x4){bflo(w.x), bfhi(w.x), bflo(w.z), bfhi(w.z)};
    *(LAS f32x4*)(d + N + 2 * c) = (f32x4){bflo(w.y), bfhi(w.y), bflo(w.w), bfhi(w.w)};
  }
  __syncthreads();
#pragma unroll 1
  for (int h = N / 2; h >= 2; h >>= 2) {
    const int hh = h >> 1, tmul = 4096 / h;
    for (int q = tid; q < N / 2; q += NTHR) {
      const int seq = q >= (N / 4) ? 1 : 0, qq = q & (N / 4 - 1);
      const int pos = qq & (hh - 1), i0 = seq * N + ((qq - pos) << 2) + pos;
      const f32x2 x0 = d[i0], x1 = d[i0 + hh], x2 = d[i0 + h], x3 = d[i0 + h + hh];
      const int tw = pos * tmul;
      const f32x2 w1 = cmul(T2[tw >> 6], T1[tw & 63]);
      const f32x2 w2 = (f32x2){w1.x * w1.x - w1.y * w1.y, 2.f * w1.x * w1.y};
      const f32x2 a0 = x0 + x2, a2 = cmul(x0 - x2, w1), a1 = x1 + x3, t3 = cmul(x1 - x3, w1), a3 = (f32x2){t3.y, -t3.x};
      d[i0] = a0 + a1; d[i0 + hh] = cmul(a0 - a1, w2); d[i0 + h] = a2 + a3; d[i0 + h + hh] = cmul(a2 - a3, w2);
    }
    __syncthreads();
  }
  if ((LOGN & 1) == 1) {
    for (int j = tid; j < N; j += NTHR) { const int seq = j >= (N / 2) ? 1 : 0, jj = j & (N / 2 - 1), i0 = seq * N + 2 * jj; const f32x2 a = d[i0], bb = d[i0 + 1]; d[i0] = a + bb; d[i0 + 1] = a - bb; }
    __syncthreads();
  }
  for (int m = tid; m < N; m += NTHR) {
    const int k = (int)(__brev((unsigned)m) >> (32 - LOGN)), km = (N - k) & (N - 1), mp = (int)(__brev((unsigned)km) >> (32 - LOGN));
    const f32x2 A0 = d[m], B0 = d[mp], A1 = d[N + m], B1 = d[N + mp];
    const float hn = 0.5f * norm;
    u32x4 w;
    w.x = cvt_pk_bf16((A0.x + B0.x) * hn, (A0.y - B0.y) * hn);
    w.y = cvt_pk_bf16((A0.y + B0.y) * hn, (B0.x - A0.x) * hn);
    w.z = cvt_pk_bf16((A1.x + B1.x) * hn, (A1.y - B1.y) * hn);
    w.w = cvt_pk_bf16((A1.y + B1.y) * hn, (B1.x - A1.x) * hn);
    *(u32x4*)(yc_row0 + (size_t)k * D + kcol) = w;
  }
  __syncthreads();
}
__device__ __forceinline__ void fft_phase(LAS unsigned char* lds, const bf16_t* FTL, const bf16_t* FTC, bf16_t* YC, int G) {
  const int tid = threadIdx.x;
  LAS f32x2* d = (LAS f32x2*)lds; LAS f32x2* T1 = (LAS f32x2*)(lds + LDS_TAB); LAS f32x2* T2 = T1 + 64;
  if (tid < 128) { const int j = tid & 63; float s, c; sincos_acc(6.283185307179586476925 * (double)(tid < 64 ? j : 64 * j) / 8192.0, s, c); (tid < 64 ? T1 : T2)[j] = (f32x2){c, -s}; }
  __syncthreads();
  for (int it = blockIdx.x; it < 256; it += G) {
    const int b = it >> 7, cb = it & 127, kcol = (cb >> 5) * 256 + (cb & 31) * 8;
    fft_item<8192, 13>(d, T1, T2, FTL + (size_t)(b * 128 + cb) * 8192 * 4, YC + ((size_t)b * T + 256) * D, kcol, 1.0f / 1024.0f, tid);
    fft_item<256, 8>(d, T1, T2, FTC + (size_t)(b * 128 + cb) * 256 * 4, YC + ((size_t)b * T) * D, kcol, 0.0055242717280199f  , tid);
  }
}

#ifndef ATT3_PLAIN
#define ATT3_PLAIN 4
#endif
#ifndef ATT_EXP
#define ATT_EXP 0
#endif
#ifndef ATT4_SPLIT
#define ATT4_SPLIT 0
#endif
#ifndef ATT4_NOFENCE
#define ATT4_NOFENCE 0
#endif
#ifndef ATT_PRIO
#define ATT_PRIO 0
#endif
namespace att {
constexpr int NW = 8, QBLK = 32, KVBLK = 64;
constexpr size_t SHM_V = KVBLK * 128 * 2, SHM_K = KVBLK * 128 * 2;
#define KSWZ(row, colB) ((row) * 256 + ((colB) ^ (((row) & 7) << 4)))
#define SBAR() __builtin_amdgcn_sched_barrier(0)
__device__ __forceinline__ int crow(int r, int hi) { return (r & 3) + 8 * (r >> 2) + 4 * hi; }
template <int CSCALE_NUM> struct Dummy {};
__device__ __forceinline__ void partialSM(f32x16& p0, f32x16& p1, float& m_reg, float& mn, float& alpha, const float C, const float THRS) {
  float pmax = p0[0];
#pragma unroll
  for (int r = 1; r < 16; ++r) pmax = fmaxf(pmax, p0[r]);
#pragma unroll
  for (int r = 0; r < 16; ++r) pmax = fmaxf(pmax, p1[r]);
  { auto rr = __builtin_amdgcn_permlane32_swap(__float_as_uint(pmax), __float_as_uint(pmax), false, false);
    pmax = fmaxf(__uint_as_float(rr[0]), __uint_as_float(rr[1])); }
  if (__builtin_expect(__all(pmax - m_reg <= THRS), 1)) { mn = m_reg; alpha = 1.f; }
  else { mn = fmaxf(m_reg, pmax); alpha = __builtin_amdgcn_exp2f((m_reg - mn) * C); m_reg = mn; }
  const float mnC = -mn * C;
#pragma unroll
  for (int r = 0; r < 16; ++r) p0[r] = fmaf(p0[r], C, mnC);
#pragma unroll
  for (int r = 0; r < 16; ++r) p1[r] = fmaf(p1[r], C, mnC);
#pragma unroll
  for (int r = 0; r < 16; ++r) p0[r] = __builtin_amdgcn_exp2f(p0[r]);
#if (ATT_EXP & 2)
#pragma unroll
  for (int r = 0; r < 16; ++r) { float dm_; asm volatile("v_exp_f32 %0, %1" : "=v"(dm_) : "v"(p0[r])); }
#endif
}
__device__ __forceinline__ void finishSM(f32x16& p0, f32x16& p1, float alpha, float& l_reg, bf16x8& pa0, bf16x8& pa1, bf16x8& pa2, bf16x8& pa3) {
#pragma unroll
  for (int r = 0; r < 16; ++r) p1[r] = __builtin_amdgcn_exp2f(p1[r]);
#if (ATT_EXP & 2)
#pragma unroll
  for (int r = 0; r < 16; ++r) { float dm_; asm volatile("v_exp_f32 %0, %1" : "=v"(dm_) : "v"(p1[r])); }
#endif
  float ps = 0;
#pragma unroll
  for (int r = 0; r < 16; ++r) ps += p0[r];
#pragma unroll
  for (int r = 0; r < 16; ++r) ps += p1[r];
  { auto rr = __builtin_amdgcn_permlane32_swap(__float_as_uint(ps), __float_as_uint(ps), false, false);
    ps = __uint_as_float(rr[0]) + __uint_as_float(rr[1]); }
  l_reg = l_reg * alpha + ps;
#define PK4(P, BASE, OUT) do { unsigned a0 = cvt_pk_bf16(P[BASE + 0], P[BASE + 1]), a1 = cvt_pk_bf16(P[BASE + 2], P[BASE + 3]);   \
    unsigned b0 = cvt_pk_bf16(P[BASE + 4], P[BASE + 5]), b1 = cvt_pk_bf16(P[BASE + 6], P[BASE + 7]);                              \
    auto r0 = __builtin_amdgcn_permlane32_swap(a0, b0, false, false); auto r1 = __builtin_amdgcn_permlane32_swap(a1, b1, false, false); \
    u32x4 w = {r0[0], r1[0], r0[1], r1[1]}; OUT = *reinterpret_cast<bf16x8*>(&w); } while (0)
  PK4(p0, 0, pa0); PK4(p0, 8, pa1); PK4(p1, 0, pa2); PK4(p1, 8, pa3);
#undef PK4
}
template <int DK>
__device__ __forceinline__ void qkt(f32x16& p0, f32x16& p1, const char* Ks, const bf16x8* qr, int r32, int hi) {
  p0 = f32x16{}; p1 = f32x16{};
#pragma unroll
  for (int d0 = 0; d0 < DK / 16; ++d0) { const int cb = (d0 * 16 + hi * 8) * 2;
    const bf16x8 b0 = *reinterpret_cast<const bf16x8*>(Ks + KSWZ(r32, cb));
    const bf16x8 b1 = *reinterpret_cast<const bf16x8*>(Ks + KSWZ(32 + r32, cb));
#if (ATT_EXP & 1)
    { u32x4 dm_; asm volatile("ds_read_b128 %0, %1\n\tds_read_b128 %0, %2" : "=&v"(dm_) : "v"((unsigned)(uintptr_t)(Ks + KSWZ(r32, cb))), "v"((unsigned)(uintptr_t)(Ks + KSWZ(32 + r32, cb))) : "memory"); }
#endif
    p0 = __builtin_amdgcn_mfma_f32_32x32x16_bf16(b0, qr[d0], p0, 0, 0, 0);
    p1 = __builtin_amdgcn_mfma_f32_32x32x16_bf16(b1, qr[d0], p1, 0, 0, 0);
#if (ATT_EXP & 4)
    { f32x4 dm_ = {0, 0, 0, 0}; asm volatile("v_mfma_f32_16x16x32_bf16 %0, %1, %1, %0\n\tv_mfma_f32_16x16x32_bf16 %0, %1, %1, %0\n\tv_mfma_f32_16x16x32_bf16 %0, %1, %1, %0\n\tv_mfma_f32_16x16x32_bf16 %0, %1, %1, %0\n\ts_nop 15" : "+v"(dm_) : "v"(qr[d0])); }
#endif
  }
}
__device__ __forceinline__ int v_st(int k, int c) { const int kk = (k & ~0xC) | ((k & 4) << 1) | ((k & 8) >> 1); return ((kk >> 3) * 4 + (c >> 5)) * 512 + ((kk & 7) * 32 + (c & 31)) * 2; }
__device__ __forceinline__ int v_rd_base(int lane) { return ((lane & 3) << 3) | (((lane >> 2) & 3) << 6) | (((lane >> 4) & 1) << 5) | (((lane >> 5) & 1) << 8); }
constexpr int v_rd_off(int d0, int ks, int half) { return d0 * 512 + ks * 4096 + half * 2048; }
template <int OFF> __device__ __forceinline__ s16x4 tr_read(int vb) {
  s16x4 r; asm volatile("ds_read_b64_tr_b16 %0, %1 offset:%2" : "=&v"(r) : "v"(vb), "i"(OFF) : "memory"); return r;
}
template <int D0> __device__ __forceinline__ void pv_one(f32x16& od, int vb, bf16x8 pa0, bf16x8 pa1, bf16x8 pa2, bf16x8 pa3) {
  const s16x4 l0 = tr_read<v_rd_off(D0, 0, 0)>(vb), h0 = tr_read<v_rd_off(D0, 0, 1)>(vb), l1 = tr_read<v_rd_off(D0, 1, 0)>(vb), h1 = tr_read<v_rd_off(D0, 1, 1)>(vb);
  const s16x4 l2 = tr_read<v_rd_off(D0, 2, 0)>(vb), h2 = tr_read<v_rd_off(D0, 2, 1)>(vb), l3 = tr_read<v_rd_off(D0, 3, 0)>(vb), h3 = tr_read<v_rd_off(D0, 3, 1)>(vb);
#if (ATT_EXP & 1)
  { s16x4 dm_; asm volatile("ds_read_b64_tr_b16 %0, %1 offset:%2\n\tds_read_b64_tr_b16 %0, %1 offset:%3\n\tds_read_b64_tr_b16 %0, %1 offset:%4\n\tds_read_b64_tr_b16 %0, %1 offset:%5\n\t"
      "ds_read_b64_tr_b16 %0, %1 offset:%6\n\tds_read_b64_tr_b16 %0, %1 offset:%7\n\tds_read_b64_tr_b16 %0, %1 offset:%8\n\tds_read_b64_tr_b16 %0, %1 offset:%9" : "=&v"(dm_) : "v"(vb),
      "i"(v_rd_off(D0, 0, 0)), "i"(v_rd_off(D0, 0, 1)), "i"(v_rd_off(D0, 1, 0)), "i"(v_rd_off(D0, 1, 1)), "i"(v_rd_off(D0, 2, 0)), "i"(v_rd_off(D0, 2, 1)), "i"(v_rd_off(D0, 3, 0)), "i"(v_rd_off(D0, 3, 1)) : "memory"); }
#endif
  asm volatile("s_waitcnt lgkmcnt(0)" ::: "memory"); SBAR();
#define PK(Lo, Hi) (bf16x8){Lo[0], Lo[1], Lo[2], Lo[3], Hi[0], Hi[1], Hi[2], Hi[3]}
  od = __builtin_amdgcn_mfma_f32_32x32x16_bf16(pa0, PK(l0, h0), od, 0, 0, 0);
  od = __builtin_amdgcn_mfma_f32_32x32x16_bf16(pa1, PK(l1, h1), od, 0, 0, 0);
  od = __builtin_amdgcn_mfma_f32_32x32x16_bf16(pa2, PK(l2, h2), od, 0, 0, 0);
  od = __builtin_amdgcn_mfma_f32_32x32x16_bf16(pa3, PK(l3, h3), od, 0, 0, 0);
#if (ATT_EXP & 4)
  { f32x4 dm_ = {0, 0, 0, 0}; asm volatile("v_mfma_f32_16x16x32_bf16 %0, %1, %1, %0\n\tv_mfma_f32_16x16x32_bf16 %0, %1, %1, %0\n\tv_mfma_f32_16x16x32_bf16 %0, %1, %1, %0\n\tv_mfma_f32_16x16x32_bf16 %0, %1, %1, %0\n\t"
      "v_mfma_f32_16x16x32_bf16 %0, %1, %1, %0\n\tv_mfma_f32_16x16x32_bf16 %0, %1, %1, %0\n\tv_mfma_f32_16x16x32_bf16 %0, %1, %1, %0\n\tv_mfma_f32_16x16x32_bf16 %0, %1, %1, %0\n\ts_nop 15" : "+v"(dm_) : "v"(pa0)); }
#endif
#undef PK
}
template <int DV> __device__ __forceinline__ void pv_all(f32x16* o, int vb, bf16x8 pa0, bf16x8 pa1, bf16x8 pa2, bf16x8 pa3) {
  pv_one<0>(o[0], vb, pa0, pa1, pa2, pa3); pv_one<1>(o[1], vb, pa0, pa1, pa2, pa3);
  if constexpr (DV == 128) { pv_one<2>(o[2], vb, pa0, pa1, pa2, pa3); pv_one<3>(o[3], vb, pa0, pa1, pa2, pa3); }
}
__device__ __forceinline__ __amdgpu_buffer_rsrc_t make_rsrc(const void* p) {
  const unsigned lo = __builtin_amdgcn_readfirstlane((unsigned)(uintptr_t)p), hi = __builtin_amdgcn_readfirstlane((unsigned)((uintptr_t)p >> 32));
  return __builtin_amdgcn_make_buffer_rsrc((void*)(((uintptr_t)hi << 32) | lo), 0, 0x7fffffff, 0x00020000);
}
struct NoHook { static constexpr int VM_EXTRA = 0; __device__ __forceinline__ void step() {} };
template <int DK, int DV, int ldq, int ldk, int ldv, int ldo, int SDEPTH, class Hook>
__device__ __forceinline__ void attn_unit(const bf16_t* __restrict__ Qb, const bf16_t* __restrict__ Kh, const bf16_t* __restrict__ Vh,
                                          bf16_t* __restrict__ Ob, int seq, char* lds, Hook& hk) {
  constexpr float C = (DK == 96 ? 0.10206207261596577f : 0.08838834764831845f) * 1.4426950408889634f;
  constexpr int NKC = 16, NVC = DV / 8;
  constexpr int NKL = (64 * NKC + 511) / 512, NVL = (64 * NVC + 511) / 512;
  constexpr float THRS = 8.0f * 1.4426950408889634f / C;
  const int tid = threadIdx.x, wid = tid >> 6, lane = tid & 63, r32 = lane & 31, hi = lane >> 5;
  char* V_lds = lds; char* K_lds = lds + 2 * SHM_V;
  float* ws = (float*)(lds + 2 * SHM_V + 2 * SHM_K) + wid * 64; float* li_l = ws; float* al_l = ws + 32;
  float m_reg = -1e30f, l_reg = 0; f32x16 o[DV / 32]; bf16x8 qr[DK / 16];
#pragma unroll
  for (int d = 0; d < DV / 32; ++d) o[d] = f32x16{};
  { const unsigned qoff = (unsigned)((wid * QBLK + r32) * ldq + hi * 8) * 2u;
#pragma unroll
    for (int d0 = 0; d0 < DK / 16; ++d0) qr[d0] = *reinterpret_cast<const bf16x8*>((const char*)Qb + (qoff + d0 * 32)); }
  static_assert(64 * NKC == 512 * NKL && 64 * NVC == 512 * NVL, "every staging chunk is valid");
  int krow[NKL], kch[NKL], vrow[NVL], vch[NVL];
#pragma unroll
  for (int i = 0; i < NKL; ++i) { const int ci = tid + 512 * i; krow[i] = ci / NKC; kch[i] = ci % NKC; }
#pragma unroll
  for (int i = 0; i < NVL; ++i) { const int ci = tid + 512 * i; vrow[i] = ci / NVC; vch[i] = ci % NVC; }
  unsigned koff[NKL], voff[NVL];
#pragma unroll
  for (int i = 0; i < NKL; ++i) koff[i] = (unsigned)(krow[i] * ldk + kch[i] * 8) * 2u;
#pragma unroll
  for (int i = 0; i < NVL; ++i) voff[i] = (unsigned)(vrow[i] * ldv + vch[i] * 8) * 2u;
  const int vb0 = (int)(uintptr_t)V_lds + v_rd_base(lane);
  struct { bf16x8 v[NVL], k[NKL]; } sr_[SDEPTH];
  const __amdgpu_buffer_rsrc_t rsK = make_rsrc(Kh), rsV = make_rsrc(Vh);
#define SLOAD(i, k0) do { const int vso_ = (k0) * (ldv * 2), kso_ = (k0) * (ldk * 2); \
    _Pragma("unroll") for (int q = 0; q < NVL; ++q) sr_[i].v[q] = __builtin_bit_cast(bf16x8, __builtin_amdgcn_raw_buffer_load_b128(rsV, (int)voff[q], vso_, 0)); \
    _Pragma("unroll") for (int q = 0; q < NKL; ++q) sr_[i].k[q] = __builtin_bit_cast(bf16x8, __builtin_amdgcn_raw_buffer_load_b128(rsK, (int)koff[q], kso_, 0)); } while (0)
#define SWRITE(b, i) do { _Pragma("unroll") for (int q = 0; q < NVL; ++q) *(bf16x8*)(V_lds + (b) * SHM_V + v_st(vrow[q], vch[q] * 8)) = sr_[i].v[q]; \
    _Pragma("unroll") for (int q = 0; q < NKL; ++q) *(bf16x8*)(K_lds + (b) * SHM_K + KSWZ(krow[q], kch[q] * 16)) = sr_[i].k[q]; } while (0)
#define SWAIT() asm volatile("s_waitcnt vmcnt(%0)" :: "n"(SDEPTH == 2 ? NVL + NKL : 0) : "memory")
#define SWAIT2() asm volatile("s_waitcnt vmcnt(%0)" :: "n"((SDEPTH == 2 ? NVL + NKL : 0) + Hook::VM_EXTRA) : "memory")
#define RESC(a) do { if (__any((a) < 1.f)) { if (hi == 0) al_l[r32] = (a); asm volatile("s_waitcnt lgkmcnt(0)" ::: "memory"); \
    _Pragma("unroll") for (int d = 0; d < DV / 32; ++d) _Pragma("unroll") for (int r = 0; r < 16; ++r) o[d][r] *= al_l[crow(r, hi)]; } } while (0)
  f32x16 pA0, pA1, pB0, pB1; float mnA, mnB, alA, alB; bf16x8 pa0, pa1, pa2, pa3; const int NT = seq / KVBLK;
#ifdef ATT_PRIO
  if (wid >= 4) __builtin_amdgcn_s_setprio(1);
#endif
  constexpr int SE = 0, SO = SDEPTH - 1;
  SLOAD(SE, 0); asm volatile("s_waitcnt vmcnt(0)" ::: "memory"); SWRITE(0, SE); __syncthreads();
  qkt<DK>(pA0, pA1, K_lds, qr, r32, hi); partialSM(pA0, pA1, m_reg, mnA, alA, C, THRS);
  SLOAD(SO, KVBLK); if constexpr (SDEPTH == 2) SLOAD(SE, 2 * KVBLK);
  SWAIT(); SWRITE(1, SO); __syncthreads();
  for (int j = 1; j + 1 < NT; j += 2) {
    SBAR(); qkt<DK>(pB0, pB1, K_lds + SHM_K, qr, r32, hi);
    finishSM(pA0, pA1, alA, l_reg, pa0, pa1, pa2, pa3);
    hk.step();
    SBAR();
    SLOAD(SO, (j + SDEPTH) * KVBLK); SBAR();
    pv_all<DV>(o, vb0, pa0, pa1, pa2, pa3); partialSM(pB0, pB1, m_reg, mnB, alB, C, THRS);
    __syncthreads(); SWAIT2(); SWRITE(0, SE);
    RESC(alB); __syncthreads();
    SBAR(); qkt<DK>(pA0, pA1, K_lds, qr, r32, hi);
    finishSM(pB0, pB1, alB, l_reg, pa0, pa1, pa2, pa3); SBAR();
    { const int tn = (j + 1 + SDEPTH) < NT ? (j + 1 + SDEPTH) : NT - 1; SLOAD(SE, tn * KVBLK); } SBAR();
    pv_all<DV>(o, vb0 + (int)SHM_V, pa0, pa1, pa2, pa3); partialSM(pA0, pA1, m_reg, mnA, alA, C, THRS);
    __syncthreads(); SWAIT(); SWRITE(1, SO);
    RESC(alA); __syncthreads();
  }
  SBAR(); qkt<DK>(pB0, pB1, K_lds + SHM_K, qr, r32, hi);
  finishSM(pA0, pA1, alA, l_reg, pa0, pa1, pa2, pa3); SBAR();
  pv_all<DV>(o, vb0, pa0, pa1, pa2, pa3); partialSM(pB0, pB1, m_reg, mnB, alB, C, THRS);
  __syncthreads(); RESC(alB);
  finishSM(pB0, pB1, alB, l_reg, pa0, pa1, pa2, pa3); SBAR();
  pv_all<DV>(o, vb0 + (int)SHM_V, pa0, pa1, pa2, pa3);
  if (hi == 0) li_l[r32] = l_reg; asm volatile("s_waitcnt lgkmcnt(0)" ::: "memory");
  unsigned ooff = (unsigned)((wid * QBLK + 4 * hi) * ldo + r32) * 2u;
  asm volatile("" : "+v"(ooff));
#pragma unroll
  for (int r = 0; r < 16; ++r) { const float rl = __builtin_amdgcn_rcpf(li_l[crow(r, hi)]);
    char* orow = (char*)Ob + (size_t)(((r & 3) + 8 * (r >> 2)) * ldo) * 2;
#pragma unroll
    for (int d0 = 0; d0 < DV / 32; ++d0) *(bf16_t*)(orow + (ooff + d0 * 64)) = (bf16_t)(cvt_pk_bf16(o[d0][r] * rl, 0.f) & 0xffffu);
    asm volatile("" ::: "memory"); }
#ifdef ATT_PRIO
  __builtin_amdgcn_s_setprio(0);
#endif
  __syncthreads();
#undef SLOAD
#undef SWRITE
#undef SWAIT
#undef SWAIT2
#undef RESC
}


typedef short v4i16_t __attribute__((ext_vector_type(4)));
typedef __attribute__((address_space(3))) const char* lds_cptr;
__device__ __forceinline__ s16x4 vtr(lds_cptr p) { return __builtin_bit_cast(s16x4, __builtin_amdgcn_ds_read_tr16_b64_v4i16((__attribute__((address_space(3))) v4i16_t*)p)); }
template <int DK, int DV, bool DOQK>
__device__ __forceinline__ void mseg_compute(f32x16& p0, f32x16& p1, f32x16* o, lds_cptr Ks, lds_cptr Vs, const bf16x8* qr, int r32, int hi, int lane, bf16x8 pa0, bf16x8 pa1, bf16x8 pa2, bf16x8 pa3) {
  const lds_cptr vp = Vs + v_rd_base(lane);
#define VFRAG(d0, ks, L, H) const s16x4 L = vtr(vp + v_rd_off(d0, ks, 0)), H = vtr(vp + v_rd_off(d0, ks, 1))
#define PKV(L, H) (bf16x8){L[0], L[1], L[2], L[3], H[0], H[1], H[2], H[3]}
#define LFENCE() asm volatile("" ::: "memory")
#define PVBLK(d, A0, B0, A1, B1, A2, B2, A3, B3) do { o[d] = __builtin_amdgcn_mfma_f32_32x32x16_bf16(pa0, PKV(A0, B0), o[d], 0, 0, 0); o[d] = __builtin_amdgcn_mfma_f32_32x32x16_bf16(pa1, PKV(A1, B1), o[d], 0, 0, 0); \
    o[d] = __builtin_amdgcn_mfma_f32_32x32x16_bf16(pa2, PKV(A2, B2), o[d], 0, 0, 0); o[d] = __builtin_amdgcn_mfma_f32_32x32x16_bf16(pa3, PKV(A3, B3), o[d], 0, 0, 0); } while (0)
  VFRAG(0, 0, l00, h00); VFRAG(0, 1, l01, h01); VFRAG(0, 2, l02, h02); VFRAG(0, 3, l03, h03);
  if constexpr (DOQK) {
    p0 = f32x16{}; p1 = f32x16{};
    bf16x8 ka = *(const __attribute__((address_space(3))) bf16x8*)(Ks + KSWZ(r32, hi * 16)), kb = *(const __attribute__((address_space(3))) bf16x8*)(Ks + KSWZ(32 + r32, hi * 16));
    LFENCE();
#pragma unroll
    for (int d0 = 0; d0 < DK / 16; ++d0) {
      bf16x8 na = ka, nb = kb;
      if (d0 + 1 < DK / 16) { const int cb = ((d0 + 1) * 16 + hi * 8) * 2; na = *(const __attribute__((address_space(3))) bf16x8*)(Ks + KSWZ(r32, cb)); nb = *(const __attribute__((address_space(3))) bf16x8*)(Ks + KSWZ(32 + r32, cb)); }
      LFENCE();
      p0 = __builtin_amdgcn_mfma_f32_32x32x16_bf16(ka, qr[d0], p0, 0, 0, 0);
      p1 = __builtin_amdgcn_mfma_f32_32x32x16_bf16(kb, qr[d0], p1, 0, 0, 0);
      ka = na; kb = nb;
    }
  }
  LFENCE();
  if constexpr (DV == 128) {
    PVBLK(0, l00, h00, l01, h01, l02, h02, l03, h03);
    { VFRAG(1, 0, l10, h10); VFRAG(1, 1, l11, h11); VFRAG(1, 2, l12, h12); VFRAG(1, 3, l13, h13); LFENCE(); PVBLK(1, l10, h10, l11, h11, l12, h12, l13, h13); }
    { VFRAG(2, 0, l20, h20); VFRAG(2, 1, l21, h21); VFRAG(2, 2, l22, h22); VFRAG(2, 3, l23, h23); LFENCE(); PVBLK(2, l20, h20, l21, h21, l22, h22, l23, h23); }
    { VFRAG(3, 0, l30, h30); VFRAG(3, 1, l31, h31); VFRAG(3, 2, l32, h32); VFRAG(3, 3, l33, h33); LFENCE(); PVBLK(3, l30, h30, l31, h31, l32, h32, l33, h33); }
  } else {
    VFRAG(1, 0, l10, h10); VFRAG(1, 1, l11, h11); VFRAG(1, 2, l12, h12); VFRAG(1, 3, l13, h13);
    LFENCE();
    PVBLK(0, l00, h00, l01, h01, l02, h02, l03, h03);
    PVBLK(1, l10, h10, l11, h11, l12, h12, l13, h13);
  }
#undef VFRAG
#undef PKV
#undef LFENCE
#undef PVBLK
}
template <int DK, int DV, int ldq, int ldk, int ldv, int ldo>
__device__ __forceinline__ void attn_unit2(const bf16_t* __restrict__ Qb, const bf16_t* __restrict__ Kh, const bf16_t* __restrict__ Vh,
                                           bf16_t* __restrict__ Ob, int seq, char* lds) {
  constexpr float C = (DK == 96 ? 0.10206207261596577f : 0.08838834764831845f) * 1.4426950408889634f;
  constexpr float THRS = 8.0f * 1.4426950408889634f / C;
  constexpr int NKC = 16, NVC = DV / 8, NKL = 2, NVL = (64 * NVC) / 512;
  const int tid = threadIdx.x, wid = tid >> 6, lane = tid & 63, r32 = lane & 31, hi = lane >> 5;
  const int half = __builtin_amdgcn_readfirstlane(wid >> 2);
  char* V_lds = lds; char* K_lds = lds + 2 * SHM_V;
  float* ws = (float*)(lds + 2 * SHM_V + 2 * SHM_K) + wid * 64; float* li_l = ws; float* al_l = ws + 32;
  float m_reg = -1e30f, l_reg = 0; f32x16 o[DV / 32]; bf16x8 qr[DK / 16];
#pragma unroll
  for (int d = 0; d < DV / 32; ++d) o[d] = f32x16{};
  { const unsigned qoff = (unsigned)((wid * QBLK + r32) * ldq + hi * 8) * 2u;
#pragma unroll
    for (int d0 = 0; d0 < DK / 16; ++d0) qr[d0] = *reinterpret_cast<const bf16x8*>((const char*)Qb + (qoff + d0 * 32)); }
  int krow[NKL], kch[NKL], vrow[NVL], vch[NVL]; unsigned koff[NKL], voff[NVL];
#pragma unroll
  for (int i = 0; i < NKL; ++i) { const int ci = tid + 512 * i; krow[i] = ci / NKC; kch[i] = ci % NKC; koff[i] = (unsigned)(krow[i] * ldk + kch[i] * 8) * 2u; }
#pragma unroll
  for (int i = 0; i < NVL; ++i) { const int ci = tid + 512 * i; vrow[i] = ci / NVC; vch[i] = ci % NVC; voff[i] = (unsigned)(vrow[i] * ldv + vch[i] * 8) * 2u; }
  const int vb0 = (int)(uintptr_t)V_lds + v_rd_base(lane);
  const __amdgpu_buffer_rsrc_t rsK = make_rsrc(Kh), rsV = make_rsrc(Vh);
  const int NT = seq / KVBLK;
  bf16x8 ks[2][NKL], vs[2][NVL];
#define LOADK(set, t) do { const int tn_ = (t) < NT ? (t) : NT - 1; _Pragma("unroll") for (int q = 0; q < NKL; ++q) ks[set][q] = __builtin_bit_cast(bf16x8, __builtin_amdgcn_raw_buffer_load_b128(rsK, (int)koff[q], tn_ * (KVBLK * ldk * 2), 0)); } while (0)
#define LOADV(set, t) do { const int tn_ = (t) < NT ? (t) : NT - 1; _Pragma("unroll") for (int q = 0; q < NVL; ++q) vs[set][q] = __builtin_bit_cast(bf16x8, __builtin_amdgcn_raw_buffer_load_b128(rsV, (int)voff[q], tn_ * (KVBLK * ldv * 2), 0)); } while (0)
#define WRITEK(set, t) do { _Pragma("unroll") for (int q = 0; q < NKL; ++q) *(bf16x8*)(K_lds + ((t) & 1) * SHM_K + KSWZ(krow[q], kch[q] * 16)) = ks[set][q]; } while (0)
#define WRITEV(set, t) do { _Pragma("unroll") for (int q = 0; q < NVL; ++q) *(bf16x8*)(V_lds + ((t) & 1) * SHM_V + v_st(vrow[q], vch[q] * 8)) = vs[set][q]; } while (0)
  f32x16 p0, p1; bf16x8 pa0, pa1, pa2, pa3;
#define SOFTMAX() do { float mn_, al_; partialSM(p0, p1, m_reg, mn_, al_, C, THRS); \
    if (__any(al_ < 1.f)) { if (hi == 0) al_l[r32] = al_; asm volatile("s_waitcnt lgkmcnt(0)" ::: "memory"); \
      _Pragma("unroll") for (int d = 0; d < DV / 32; ++d) _Pragma("unroll") for (int r = 0; r < 16; ++r) o[d][r] *= al_l[crow(r, hi)]; } \
    finishSM(p0, p1, al_, l_reg, pa0, pa1, pa2, pa3); } while (0)
  LOADK(0, 0); LOADV(0, 0); LOADK(1, 1);
  asm volatile("s_waitcnt vmcnt(0)" ::: "memory");
  WRITEK(0, 0); WRITEV(0, 0); WRITEK(1, 1);
  LOADV(1, 1); LOADK(0, 2);
  __syncthreads();
  qkt<DK>(p0, p1, K_lds, qr, r32, hi);
  SOFTMAX();
  if (half == 1) { WRITEV(1, 1); LOADV(0, 2); __syncthreads(); }
#define MSEG(j, JP) do { \
    if (half == 0) { WRITEV((JP) ^ 1, (j) + 1); LOADV(JP, (j) + 2); } else { WRITEK(JP, (j) + 2); LOADK((JP) ^ 1, (j) + 3); } \
    SBAR(); if constexpr (DV == 64) { if ((j) + 1 < NT) mseg_compute<DK, DV, true>(p0, p1, o, (lds_cptr)(K_lds + ((JP) ^ 1) * SHM_K), (lds_cptr)(V_lds + (JP) * SHM_V), qr, r32, hi, lane, pa0, pa1, pa2, pa3); \
      else mseg_compute<DK, DV, false>(p0, p1, o, (lds_cptr)K_lds, (lds_cptr)(V_lds + (JP) * SHM_V), qr, r32, hi, lane, pa0, pa1, pa2, pa3); } \
    else { if ((j) + 1 < NT) qkt<DK>(p0, p1, K_lds + ((JP) ^ 1) * SHM_K, qr, r32, hi); pv_all<DV>(o, vb0 + (JP) * (int)SHM_V, pa0, pa1, pa2, pa3); } SBAR(); } while (0)
#define VSEG(j, JP) do { \
    if (half == 0) { WRITEK(JP, (j) + 2); LOADK((JP) ^ 1, (j) + 3); } else { WRITEV(JP, (j) + 2); LOADV((JP) ^ 1, (j) + 3); } \
    if ((j) + 1 < NT) SOFTMAX(); } while (0)
  for (int j = 0; j < NT; j += 2) {
    MSEG(j, 0); __syncthreads();
    VSEG(j, 0); __syncthreads();
    MSEG(j + 1, 1); __syncthreads();
    VSEG(j + 1, 1); __syncthreads();
  }
  if (half == 0) __syncthreads();
  if (hi == 0) li_l[r32] = l_reg; asm volatile("s_waitcnt lgkmcnt(0)" ::: "memory");
  unsigned ooff = (unsigned)((wid * QBLK + 4 * hi) * ldo + r32) * 2u;
  asm volatile("" : "+v"(ooff));
#pragma unroll
  for (int r = 0; r < 16; ++r) { const float rl = __builtin_amdgcn_rcpf(li_l[crow(r, hi)]);
    char* orow = (char*)Ob + (size_t)(((r & 3) + 8 * (r >> 2)) * ldo) * 2;
#pragma unroll
    for (int d0 = 0; d0 < DV / 32; ++d0) *(bf16_t*)(orow + (ooff + d0 * 64)) = (bf16_t)(cvt_pk_bf16(o[d0][r] * rl, 0.f) & 0xffffu);
    asm volatile("" ::: "memory"); }
  __syncthreads();
#undef LOADK
#undef LOADV
#undef WRITEK
#undef WRITEV
#undef SOFTMAX
#undef MSEG
#undef VSEG
}

template <int DK, int DV, bool DOQK>
__device__ __forceinline__ void mseg_asm(f32x16& p0, f32x16& p1, f32x16* o, lds_cptr Ks, int vb, const bf16x8* qr, int r32, int hi, bf16x8 pa0, bf16x8 pa1, bf16x8 pa2, bf16x8 pa3) {
#define TRR(dst, OFF) asm volatile("ds_read_b64_tr_b16 %0, %1 offset:%2" : "=&v"(dst) : "v"(vb), "i"(OFF) : "memory")
#define RDBLK(d, P) do { TRR(P##l0, v_rd_off(d, 0, 0)); TRR(P##h0, v_rd_off(d, 0, 1)); TRR(P##l1, v_rd_off(d, 1, 0)); TRR(P##h1, v_rd_off(d, 1, 1)); \
    TRR(P##l2, v_rd_off(d, 2, 0)); TRR(P##h2, v_rd_off(d, 2, 1)); TRR(P##l3, v_rd_off(d, 3, 0)); TRR(P##h3, v_rd_off(d, 3, 1)); } while (0)
#define WAITBLK(N, P) asm volatile("s_waitcnt lgkmcnt(" #N ")" : "+v"(P##l0), "+v"(P##h0), "+v"(P##l1), "+v"(P##h1), "+v"(P##l2), "+v"(P##h2), "+v"(P##l3), "+v"(P##h3) :: "memory")
#define PKV(L, H) (bf16x8){L[0], L[1], L[2], L[3], H[0], H[1], H[2], H[3]}
#define PVBLK(d, P) do { o[d] = __builtin_amdgcn_mfma_f32_32x32x16_bf16(pa0, PKV(P##l0, P##h0), o[d], 0, 0, 0); o[d] = __builtin_amdgcn_mfma_f32_32x32x16_bf16(pa1, PKV(P##l1, P##h1), o[d], 0, 0, 0); \
    o[d] = __builtin_amdgcn_mfma_f32_32x32x16_bf16(pa2, PKV(P##l2, P##h2), o[d], 0, 0, 0); o[d] = __builtin_amdgcn_mfma_f32_32x32x16_bf16(pa3, PKV(P##l3, P##h3), o[d], 0, 0, 0); } while (0)
  s16x4 al0, ah0, al1, ah1, al2, ah2, al3, ah3, bl0, bh0, bl1, bh1, bl2, bh2, bl3, bh3;
  RDBLK(0, a); RDBLK(1, b);
  WAITBLK(8, a); SBAR(); PVBLK(0, a);
  if constexpr (DV == 128) {
    RDBLK(2, a);
    WAITBLK(8, b); SBAR(); PVBLK(1, b);
    RDBLK(3, b);
    WAITBLK(8, a); SBAR(); PVBLK(2, a);
    WAITBLK(0, b); SBAR(); PVBLK(3, b);
  } else {
    WAITBLK(0, b); SBAR(); PVBLK(1, b);
  }
  if constexpr (DOQK) qkt<DK>(p0, p1, (const char*)Ks, qr, r32, hi);
#undef TRR
#undef RDBLK
#undef WAITBLK
#undef PKV
#undef PVBLK
}
#define PKV(L, H) (bf16x8){L[0], L[1], L[2], L[3], H[0], H[1], H[2], H[3]}
template <int KOFF, int VOFF> __device__ __forceinline__ void mseg_p128(f32x16& p0, f32x16& p1, f32x16* o, unsigned kad0, unsigned kad1, unsigned kad2, unsigned kad3, int vb, const bf16x8* qr, bf16x8 pa0, bf16x8 pa1, bf16x8 pa2, bf16x8 pa3) {
  bf16x8 ka0, kb0; bf16x8 ka1, kb1; bf16x8 ka2, kb2; bf16x8 ka3, kb3; bf16x8 ka4, kb4; bf16x8 ka5, kb5; bf16x8 ka6, kb6; bf16x8 ka7, kb7;
  s16x4 l0_0, h0_0; s16x4 l0_1, h0_1; s16x4 l0_2, h0_2; s16x4 l0_3, h0_3; s16x4 l1_0, h1_0; s16x4 l1_1, h1_1; s16x4 l1_2, h1_2; s16x4 l1_3, h1_3; s16x4 l2_0, h2_0; s16x4 l2_1, h2_1; s16x4 l2_2, h2_2; s16x4 l2_3, h2_3; s16x4 l3_0, h3_0; s16x4 l3_1, h3_1; s16x4 l3_2, h3_2; s16x4 l3_3, h3_3;
  p0 = f32x16{}; p1 = f32x16{};
  asm volatile("ds_read_b128 %0, %2 offset:%3\n\tds_read_b128 %1, %2 offset:%4" : "=&v"(ka0), "=&v"(kb0) : "v"(kad0), "i"(KOFF + 0), "i"(KOFF + 8192) : "memory");
  asm volatile("ds_read_b128 %0, %2 offset:%3\n\tds_read_b128 %1, %2 offset:%4" : "=&v"(ka1), "=&v"(kb1) : "v"(kad1), "i"(KOFF + 0), "i"(KOFF + 8192) : "memory");
  asm volatile("ds_read_b128 %0, %2 offset:%3\n\tds_read_b128 %1, %2 offset:%4" : "=&v"(ka2), "=&v"(kb2) : "v"(kad2), "i"(KOFF + 0), "i"(KOFF + 8192) : "memory");
  asm volatile("ds_read_b128 %0, %2 offset:%3\n\tds_read_b128 %1, %2 offset:%4" : "=&v"(ka3), "=&v"(kb3) : "v"(kad3), "i"(KOFF + 0), "i"(KOFF + 8192) : "memory");
  asm volatile("ds_read_b128 %0, %2 offset:%3\n\tds_read_b128 %1, %2 offset:%4" : "=&v"(ka4), "=&v"(kb4) : "v"(kad0), "i"(KOFF + 128), "i"(KOFF + 8320) : "memory");
  asm volatile("ds_read_b128 %0, %2 offset:%3\n\tds_read_b128 %1, %2 offset:%4" : "=&v"(ka5), "=&v"(kb5) : "v"(kad1), "i"(KOFF + 128), "i"(KOFF + 8320) : "memory");
  asm volatile("s_waitcnt lgkmcnt(10)" : "+v"(ka0), "+v"(kb0) :: "memory"); SBAR();
  p0 = __builtin_amdgcn_mfma_f32_32x32x16_bf16(ka0, qr[0], p0, 0, 0, 0); p1 = __builtin_amdgcn_mfma_f32_32x32x16_bf16(kb0, qr[0], p1, 0, 0, 0); SBAR();
  asm volatile("ds_read_b128 %0, %2 offset:%3\n\tds_read_b128 %1, %2 offset:%4" : "=&v"(ka6), "=&v"(kb6) : "v"(kad2), "i"(KOFF + 128), "i"(KOFF + 8320) : "memory");
  asm volatile("s_waitcnt lgkmcnt(10)" : "+v"(ka1), "+v"(kb1) :: "memory"); SBAR();
  p0 = __builtin_amdgcn_mfma_f32_32x32x16_bf16(ka1, qr[1], p0, 0, 0, 0); p1 = __builtin_amdgcn_mfma_f32_32x32x16_bf16(kb1, qr[1], p1, 0, 0, 0); SBAR();
  asm volatile("ds_read_b128 %0, %2 offset:%3\n\tds_read_b128 %1, %2 offset:%4" : "=&v"(ka7), "=&v"(kb7) : "v"(kad3), "i"(KOFF + 128), "i"(KOFF + 8320) : "memory");
  asm volatile("s_waitcnt lgkmcnt(10)" : "+v"(ka2), "+v"(kb2) :: "memory"); SBAR();
  p0 = __builtin_amdgcn_mfma_f32_32x32x16_bf16(ka2, qr[2], p0, 0, 0, 0); p1 = __builtin_amdgcn_mfma_f32_32x32x16_bf16(kb2, qr[2], p1, 0, 0, 0); SBAR();
  asm volatile("s_waitcnt lgkmcnt(8)" : "+v"(ka3), "+v"(kb3) :: "memory"); SBAR();
  p0 = __builtin_amdgcn_mfma_f32_32x32x16_bf16(ka3, qr[3], p0, 0, 0, 0); p1 = __builtin_amdgcn_mfma_f32_32x32x16_bf16(kb3, qr[3], p1, 0, 0, 0); SBAR();
  asm volatile("ds_read_b64_tr_b16 %0, %4 offset:%5\n\tds_read_b64_tr_b16 %1, %4 offset:%6\n\tds_read_b64_tr_b16 %2, %4 offset:%7\n\tds_read_b64_tr_b16 %3, %4 offset:%8" : "=&v"(l0_0), "=&v"(h0_0), "=&v"(l0_1), "=&v"(h0_1) : "v"(vb), "i"(VOFF + v_rd_off(0, 0, 0)), "i"(VOFF + v_rd_off(0, 0, 1)), "i"(VOFF + v_rd_off(0, 1, 0)), "i"(VOFF + v_rd_off(0, 1, 1)) : "memory");
  asm volatile("s_waitcnt lgkmcnt(10)" : "+v"(ka4), "+v"(kb4) :: "memory"); SBAR();
  p0 = __builtin_amdgcn_mfma_f32_32x32x16_bf16(ka4, qr[4], p0, 0, 0, 0); p1 = __builtin_amdgcn_mfma_f32_32x32x16_bf16(kb4, qr[4], p1, 0, 0, 0); SBAR();
  asm volatile("s_waitcnt lgkmcnt(8)" : "+v"(ka5), "+v"(kb5) :: "memory"); SBAR();
  p0 = __builtin_amdgcn_mfma_f32_32x32x16_bf16(ka5, qr[5], p0, 0, 0, 0); p1 = __builtin_amdgcn_mfma_f32_32x32x16_bf16(kb5, qr[5], p1, 0, 0, 0); SBAR();
  asm volatile("ds_read_b64_tr_b16 %0, %4 offset:%5\n\tds_read_b64_tr_b16 %1, %4 offset:%6\n\tds_read_b64_tr_b16 %2, %4 offset:%7\n\tds_read_b64_tr_b16 %3, %4 offset:%8" : "=&v"(l0_2), "=&v"(h0_2), "=&v"(l0_3), "=&v"(h0_3) : "v"(vb), "i"(VOFF + v_rd_off(0, 2, 0)), "i"(VOFF + v_rd_off(0, 2, 1)), "i"(VOFF + v_rd_off(0, 3, 0)), "i"(VOFF + v_rd_off(0, 3, 1)) : "memory");
  asm volatile("s_waitcnt lgkmcnt(10)" : "+v"(ka6), "+v"(kb6) :: "memory"); SBAR();
  p0 = __builtin_amdgcn_mfma_f32_32x32x16_bf16(ka6, qr[6], p0, 0, 0, 0); p1 = __builtin_amdgcn_mfma_f32_32x32x16_bf16(kb6, qr[6], p1, 0, 0, 0); SBAR();
  asm volatile("s_waitcnt lgkmcnt(8)" : "+v"(ka7), "+v"(kb7) :: "memory"); SBAR();
  p0 = __builtin_amdgcn_mfma_f32_32x32x16_bf16(ka7, qr[7], p0, 0, 0, 0); p1 = __builtin_amdgcn_mfma_f32_32x32x16_bf16(kb7, qr[7], p1, 0, 0, 0); SBAR();
  asm volatile("ds_read_b64_tr_b16 %0, %4 offset:%5\n\tds_read_b64_tr_b16 %1, %4 offset:%6\n\tds_read_b64_tr_b16 %2, %4 offset:%7\n\tds_read_b64_tr_b16 %3, %4 offset:%8" : "=&v"(l1_0), "=&v"(h1_0), "=&v"(l1_1), "=&v"(h1_1) : "v"(vb), "i"(VOFF + v_rd_off(1, 0, 0)), "i"(VOFF + v_rd_off(1, 0, 1)), "i"(VOFF + v_rd_off(1, 1, 0)), "i"(VOFF + v_rd_off(1, 1, 1)) : "memory");
  asm volatile("s_waitcnt lgkmcnt(8)" : "+v"(l0_0), "+v"(h0_0), "+v"(l0_1), "+v"(h0_1) :: "memory"); SBAR();
  o[0] = __builtin_amdgcn_mfma_f32_32x32x16_bf16(pa0, PKV(l0_0, h0_0), o[0], 0, 0, 0); o[0] = __builtin_amdgcn_mfma_f32_32x32x16_bf16(pa1, PKV(l0_1, h0_1), o[0], 0, 0, 0); SBAR();
  asm volatile("ds_read_b64_tr_b16 %0, %4 offset:%5\n\tds_read_b64_tr_b16 %1, %4 offset:%6\n\tds_read_b64_tr_b16 %2, %4 offset:%7\n\tds_read_b64_tr_b16 %3, %4 offset:%8" : "=&v"(l1_2), "=&v"(h1_2), "=&v"(l1_3), "=&v"(h1_3) : "v"(vb), "i"(VOFF + v_rd_off(1, 2, 0)), "i"(VOFF + v_rd_off(1, 2, 1)), "i"(VOFF + v_rd_off(1, 3, 0)), "i"(VOFF + v_rd_off(1, 3, 1)) : "memory");
  asm volatile("s_waitcnt lgkmcnt(8)" : "+v"(l0_2), "+v"(h0_2), "+v"(l0_3), "+v"(h0_3) :: "memory"); SBAR();
  o[0] = __builtin_amdgcn_mfma_f32_32x32x16_bf16(pa2, PKV(l0_2, h0_2), o[0], 0, 0, 0); o[0] = __builtin_amdgcn_mfma_f32_32x32x16_bf16(pa3, PKV(l0_3, h0_3), o[0], 0, 0, 0); SBAR();
  asm volatile("ds_read_b64_tr_b16 %0, %4 offset:%5\n\tds_read_b64_tr_b16 %1, %4 offset:%6\n\tds_read_b64_tr_b16 %2, %4 offset:%7\n\tds_read_b64_tr_b16 %3, %4 offset:%8" : "=&v"(l2_0), "=&v"(h2_0), "=&v"(l2_1), "=&v"(h2_1) : "v"(vb), "i"(VOFF + v_rd_off(2, 0, 0)), "i"(VOFF + v_rd_off(2, 0, 1)), "i"(VOFF + v_rd_off(2, 1, 0)), "i"(VOFF + v_rd_off(2, 1, 1)) : "memory");
  asm volatile("s_waitcnt lgkmcnt(8)" : "+v"(l1_0), "+v"(h1_0), "+v"(l1_1), "+v"(h1_1) :: "memory"); SBAR();
  o[1] = __builtin_amdgcn_mfma_f32_32x32x16_bf16(pa0, PKV(l1_0, h1_0), o[1], 0, 0, 0); o[1] = __builtin_amdgcn_mfma_f32_32x32x16_bf16(pa1, PKV(l1_1, h1_1), o[1], 0, 0, 0); SBAR();
  asm volatile("ds_read_b64_tr_b16 %0, %4 offset:%5\n\tds_read_b64_tr_b16 %1, %4 offset:%6\n\tds_read_b64_tr_b16 %2, %4 offset:%7\n\tds_read_b64_tr_b16 %3, %4 offset:%8" : "=&v"(l2_2), "=&v"(h2_2), "=&v"(l2_3), "=&v"(h2_3) : "v"(vb), "i"(VOFF + v_rd_off(2, 2, 0)), "i"(VOFF + v_rd_off(2, 2, 1)), "i"(VOFF + v_rd_off(2, 3, 0)), "i"(VOFF + v_rd_off(2, 3, 1)) : "memory");
  asm volatile("s_waitcnt lgkmcnt(8)" : "+v"(l1_2), "+v"(h1_2), "+v"(l1_3), "+v"(h1_3) :: "memory"); SBAR();
  o[1] = __builtin_amdgcn_mfma_f32_32x32x16_bf16(pa2, PKV(l1_2, h1_2), o[1], 0, 0, 0); o[1] = __builtin_amdgcn_mfma_f32_32x32x16_bf16(pa3, PKV(l1_3, h1_3), o[1], 0, 0, 0); SBAR();
  asm volatile("ds_read_b64_tr_b16 %0, %4 offset:%5\n\tds_read_b64_tr_b16 %1, %4 offset:%6\n\tds_read_b64_tr_b16 %2, %4 offset:%7\n\tds_read_b64_tr_b16 %3, %4 offset:%8" : "=&v"(l3_0), "=&v"(h3_0), "=&v"(l3_1), "=&v"(h3_1) : "v"(vb), "i"(VOFF + v_rd_off(3, 0, 0)), "i"(VOFF + v_rd_off(3, 0, 1)), "i"(VOFF + v_rd_off(3, 1, 0)), "i"(VOFF + v_rd_off(3, 1, 1)) : "memory");
  asm volatile("s_waitcnt lgkmcnt(8)" : "+v"(l2_0), "+v"(h2_0), "+v"(l2_1), "+v"(h2_1) :: "memory"); SBAR();
  o[2] = __builtin_amdgcn_mfma_f32_32x32x16_bf16(pa0, PKV(l2_0, h2_0), o[2], 0, 0, 0); o[2] = __builtin_amdgcn_mfma_f32_32x32x16_bf16(pa1, PKV(l2_1, h2_1), o[2], 0, 0, 0); SBAR();
  asm volatile("ds_read_b64_tr_b16 %0, %4 offset:%5\n\tds_read_b64_tr_b16 %1, %4 offset:%6\n\tds_read_b64_tr_b16 %2, %4 offset:%7\n\tds_read_b64_tr_b16 %3, %4 offset:%8" : "=&v"(l3_2), "=&v"(h3_2), "=&v"(l3_3), "=&v"(h3_3) : "v"(vb), "i"(VOFF + v_rd_off(3, 2, 0)), "i"(VOFF + v_rd_off(3, 2, 1)), "i"(VOFF + v_rd_off(3, 3, 0)), "i"(VOFF + v_rd_off(3, 3, 1)) : "memory");
  asm volatile("s_waitcnt lgkmcnt(8)" : "+v"(l2_2), "+v"(h2_2), "+v"(l2_3), "+v"(h2_3) :: "memory"); SBAR();
  o[2] = __builtin_amdgcn_mfma_f32_32x32x16_bf16(pa2, PKV(l2_2, h2_2), o[2], 0, 0, 0); o[2] = __builtin_amdgcn_mfma_f32_32x32x16_bf16(pa3, PKV(l2_3, h2_3), o[2], 0, 0, 0); SBAR();
  asm volatile("s_waitcnt lgkmcnt(4)" : "+v"(l3_0), "+v"(h3_0), "+v"(l3_1), "+v"(h3_1) :: "memory"); SBAR();
  o[3] = __builtin_amdgcn_mfma_f32_32x32x16_bf16(pa0, PKV(l3_0, h3_0), o[3], 0, 0, 0); o[3] = __builtin_amdgcn_mfma_f32_32x32x16_bf16(pa1, PKV(l3_1, h3_1), o[3], 0, 0, 0); SBAR();
  asm volatile("s_waitcnt lgkmcnt(0)" : "+v"(l3_2), "+v"(h3_2), "+v"(l3_3), "+v"(h3_3) :: "memory"); SBAR();
  o[3] = __builtin_amdgcn_mfma_f32_32x32x16_bf16(pa2, PKV(l3_2, h3_2), o[3], 0, 0, 0); o[3] = __builtin_amdgcn_mfma_f32_32x32x16_bf16(pa3, PKV(l3_3, h3_3), o[3], 0, 0, 0); SBAR();
}
template <int KOFF, int VOFF> __device__ __forceinline__ void mseg_p96(f32x16& p0, f32x16& p1, f32x16* o, unsigned kad0, unsigned kad1, unsigned kad2, unsigned kad3, int vb, const bf16x8* qr, bf16x8 pa0, bf16x8 pa1, bf16x8 pa2, bf16x8 pa3) {
  bf16x8 ka0, kb0; bf16x8 ka1, kb1; bf16x8 ka2, kb2; bf16x8 ka3, kb3; bf16x8 ka4, kb4; bf16x8 ka5, kb5;
  s16x4 l0_0, h0_0; s16x4 l0_1, h0_1; s16x4 l0_2, h0_2; s16x4 l0_3, h0_3; s16x4 l1_0, h1_0; s16x4 l1_1, h1_1; s16x4 l1_2, h1_2; s16x4 l1_3, h1_3;
  p0 = f32x16{}; p1 = f32x16{};
  asm volatile("ds_read_b128 %0, %2 offset:%3\n\tds_read_b128 %1, %2 offset:%4" : "=&v"(ka0), "=&v"(kb0) : "v"(kad0), "i"(KOFF + 0), "i"(KOFF + 8192) : "memory");
  asm volatile("ds_read_b128 %0, %2 offset:%3\n\tds_read_b128 %1, %2 offset:%4" : "=&v"(ka1), "=&v"(kb1) : "v"(kad1), "i"(KOFF + 0), "i"(KOFF + 8192) : "memory");
  asm volatile("ds_read_b128 %0, %2 offset:%3\n\tds_read_b128 %1, %2 offset:%4" : "=&v"(ka2), "=&v"(kb2) : "v"(kad2), "i"(KOFF + 0), "i"(KOFF + 8192) : "memory");
  asm volatile("ds_read_b128 %0, %2 offset:%3\n\tds_read_b128 %1, %2 offset:%4" : "=&v"(ka3), "=&v"(kb3) : "v"(kad3), "i"(KOFF + 0), "i"(KOFF + 8192) : "memory");
  asm volatile("ds_read_b128 %0, %2 offset:%3\n\tds_read_b128 %1, %2 offset:%4" : "=&v"(ka4), "=&v"(kb4) : "v"(kad0), "i"(KOFF + 128), "i"(KOFF + 8320) : "memory");
  asm volatile("ds_read_b128 %0, %2 offset:%3\n\tds_read_b128 %1, %2 offset:%4" : "=&v"(ka5), "=&v"(kb5) : "v"(kad1), "i"(KOFF + 128), "i"(KOFF + 8320) : "memory");
  asm volatile("s_waitcnt lgkmcnt(10)" : "+v"(ka0), "+v"(kb0) :: "memory"); SBAR();
  p0 = __builtin_amdgcn_mfma_f32_32x32x16_bf16(ka0, qr[0], p0, 0, 0, 0); p1 = __builtin_amdgcn_mfma_f32_32x32x16_bf16(kb0, qr[0], p1, 0, 0, 0); SBAR();
  asm volatile("ds_read_b64_tr_b16 %0, %4 offset:%5\n\tds_read_b64_tr_b16 %1, %4 offset:%6\n\tds_read_b64_tr_b16 %2, %4 offset:%7\n\tds_read_b64_tr_b16 %3, %4 offset:%8" : "=&v"(l0_0), "=&v"(h0_0), "=&v"(l0_1), "=&v"(h0_1) : "v"(vb), "i"(VOFF + v_rd_off(0, 0, 0)), "i"(VOFF + v_rd_off(0, 0, 1)), "i"(VOFF + v_rd_off(0, 1, 0)), "i"(VOFF + v_rd_off(0, 1, 1)) : "memory");
  asm volatile("s_waitcnt lgkmcnt(12)" : "+v"(ka1), "+v"(kb1) :: "memory"); SBAR();
  p0 = __builtin_amdgcn_mfma_f32_32x32x16_bf16(ka1, qr[1], p0, 0, 0, 0); p1 = __builtin_amdgcn_mfma_f32_32x32x16_bf16(kb1, qr[1], p1, 0, 0, 0); SBAR();
  asm volatile("s_waitcnt lgkmcnt(10)" : "+v"(ka2), "+v"(kb2) :: "memory"); SBAR();
  p0 = __builtin_amdgcn_mfma_f32_32x32x16_bf16(ka2, qr[2], p0, 0, 0, 0); p1 = __builtin_amdgcn_mfma_f32_32x32x16_bf16(kb2, qr[2], p1, 0, 0, 0); SBAR();
  asm volatile("ds_read_b64_tr_b16 %0, %4 offset:%5\n\tds_read_b64_tr_b16 %1, %4 offset:%6\n\tds_read_b64_tr_b16 %2, %4 offset:%7\n\tds_read_b64_tr_b16 %3, %4 offset:%8" : "=&v"(l0_2), "=&v"(h0_2), "=&v"(l0_3), "=&v"(h0_3) : "v"(vb), "i"(VOFF + v_rd_off(0, 2, 0)), "i"(VOFF + v_rd_off(0, 2, 1)), "i"(VOFF + v_rd_off(0, 3, 0)), "i"(VOFF + v_rd_off(0, 3, 1)) : "memory");
  asm volatile("s_waitcnt lgkmcnt(12)" : "+v"(ka3), "+v"(kb3) :: "memory"); SBAR();
  p0 = __builtin_amdgcn_mfma_f32_32x32x16_bf16(ka3, qr[3], p0, 0, 0, 0); p1 = __builtin_amdgcn_mfma_f32_32x32x16_bf16(kb3, qr[3], p1, 0, 0, 0); SBAR();
  asm volatile("s_waitcnt lgkmcnt(10)" : "+v"(ka4), "+v"(kb4) :: "memory"); SBAR();
  p0 = __builtin_amdgcn_mfma_f32_32x32x16_bf16(ka4, qr[4], p0, 0, 0, 0); p1 = __builtin_amdgcn_mfma_f32_32x32x16_bf16(kb4, qr[4], p1, 0, 0, 0); SBAR();
  asm volatile("ds_read_b64_tr_b16 %0, %4 offset:%5\n\tds_read_b64_tr_b16 %1, %4 offset:%6\n\tds_read_b64_tr_b16 %2, %4 offset:%7\n\tds_read_b64_tr_b16 %3, %4 offset:%8" : "=&v"(l1_0), "=&v"(h1_0), "=&v"(l1_1), "=&v"(h1_1) : "v"(vb), "i"(VOFF + v_rd_off(1, 0, 0)), "i"(VOFF + v_rd_off(1, 0, 1)), "i"(VOFF + v_rd_off(1, 1, 0)), "i"(VOFF + v_rd_off(1, 1, 1)) : "memory");
  asm volatile("s_waitcnt lgkmcnt(12)" : "+v"(ka5), "+v"(kb5) :: "memory"); SBAR();
  p0 = __builtin_amdgcn_mfma_f32_32x32x16_bf16(ka5, qr[5], p0, 0, 0, 0); p1 = __builtin_amdgcn_mfma_f32_32x32x16_bf16(kb5, qr[5], p1, 0, 0, 0); SBAR();
  asm volatile("s_waitcnt lgkmcnt(8)" : "+v"(l0_0), "+v"(h0_0), "+v"(l0_1), "+v"(h0_1) :: "memory"); SBAR();
  o[0] = __builtin_amdgcn_mfma_f32_32x32x16_bf16(pa0, PKV(l0_0, h0_0), o[0], 0, 0, 0); o[0] = __builtin_amdgcn_mfma_f32_32x32x16_bf16(pa1, PKV(l0_1, h0_1), o[0], 0, 0, 0); SBAR();
  asm volatile("ds_read_b64_tr_b16 %0, %4 offset:%5\n\tds_read_b64_tr_b16 %1, %4 offset:%6\n\tds_read_b64_tr_b16 %2, %4 offset:%7\n\tds_read_b64_tr_b16 %3, %4 offset:%8" : "=&v"(l1_2), "=&v"(h1_2), "=&v"(l1_3), "=&v"(h1_3) : "v"(vb), "i"(VOFF + v_rd_off(1, 2, 0)), "i"(VOFF + v_rd_off(1, 2, 1)), "i"(VOFF + v_rd_off(1, 3, 0)), "i"(VOFF + v_rd_off(1, 3, 1)) : "memory");
  asm volatile("s_waitcnt lgkmcnt(8)" : "+v"(l0_2), "+v"(h0_2), "+v"(l0_3), "+v"(h0_3) :: "memory"); SBAR();
  o[0] = __builtin_amdgcn_mfma_f32_32x32x16_bf16(pa2, PKV(l0_2, h0_2), o[0], 0, 0, 0); o[0] = __builtin_amdgcn_mfma_f32_32x32x16_bf16(pa3, PKV(l0_3, h0_3), o[0], 0, 0, 0); SBAR();
  asm volatile("s_waitcnt lgkmcnt(4)" : "+v"(l1_0), "+v"(h1_0), "+v"(l1_1), "+v"(h1_1) :: "memory"); SBAR();
  o[1] = __builtin_amdgcn_mfma_f32_32x32x16_bf16(pa0, PKV(l1_0, h1_0), o[1], 0, 0, 0); o[1] = __builtin_amdgcn_mfma_f32_32x32x16_bf16(pa1, PKV(l1_1, h1_1), o[1], 0, 0, 0); SBAR();
  asm volatile("s_waitcnt lgkmcnt(0)" : "+v"(l1_2), "+v"(h1_2), "+v"(l1_3), "+v"(h1_3) :: "memory"); SBAR();
  o[1] = __builtin_amdgcn_mfma_f32_32x32x16_bf16(pa2, PKV(l1_2, h1_2), o[1], 0, 0, 0); o[1] = __builtin_amdgcn_mfma_f32_32x32x16_bf16(pa3, PKV(l1_3, h1_3), o[1], 0, 0, 0); SBAR();
}
#undef PKV
template <int DK, int DV, int ldq, int ldk, int ldv, int ldo>
__device__ __forceinline__ void attn_unit3(const bf16_t* __restrict__ Qb, const bf16_t* __restrict__ Kh, const bf16_t* __restrict__ Vh,
                                           bf16_t* __restrict__ Ob, int seq, char* lds) {
  constexpr float C = (DK == 96 ? 0.10206207261596577f : 0.08838834764831845f) * 1.4426950408889634f;
  constexpr float THRS = 8.0f * 1.4426950408889634f / C;
  constexpr int NVOP = DV / 64;
  const int tid = threadIdx.x, wid = __builtin_amdgcn_readfirstlane(tid >> 6), lane = tid & 63, r32 = lane & 31, hi = lane >> 5;
  const int half = wid >> 2;
  char* V_lds = lds; char* K_lds = lds + 2 * SHM_V;
  float* ws = (float*)(lds + 2 * SHM_V + 2 * SHM_K) + wid * 64; float* li_l = ws; float* al_l = ws + 32;
  float m_reg = -1e30f, l_reg = 0; f32x16 o[DV / 32]; bf16x8 qr[DK / 16];
#pragma unroll
  for (int d = 0; d < DV / 32; ++d) o[d] = f32x16{};
  { const unsigned qoff = (unsigned)((wid * QBLK + r32) * ldq + hi * 8) * 2u;
#pragma unroll
    for (int d0 = 0; d0 < DK / 16; ++d0) qr[d0] = *reinterpret_cast<const bf16x8*>((const char*)Qb + (qoff + d0 * 32)); }
  unsigned ksrc[2], vsrc[NVOP]; unsigned kdst[2], vdst[NVOP];
#pragma unroll
  for (int i = 0; i < 2; ++i) { const int ch = wid + 8 * i, row = 4 * ch + (lane >> 4), pos = lane & 15; ksrc[i] = (unsigned)(row * ldk * 2 + ((pos ^ (row & 7)) << 4)); kdst[i] = (unsigned)(ch * 1024); }
#pragma unroll
  for (int i = 0; i < NVOP; ++i) { const int ch = (DV == 64) ? 2 * wid : wid + 8 * i;
    const int ob = ch * 1024 + 16 * lane, st = ob >> 9, rem = ob & 511, kk = (st >> 2) * 8 + (rem >> 6), c = (st & 3) * 32 + ((rem & 63) >> 1);
    const int k = (kk & ~0xC) | ((kk & 4) << 1) | ((kk & 8) >> 1);
    vsrc[i] = (unsigned)(k * ldv * 2 + c * 2); vdst[i] = (unsigned)(ch * 1024); }
  const int vb0 = (int)(uintptr_t)V_lds + v_rd_base(lane);
  const unsigned kbase_ = (unsigned)(uintptr_t)K_lds + (unsigned)r32 * 256u;
  const unsigned kad0 = kbase_ + (unsigned)(((0 + hi) ^ (r32 & 7)) << 4), kad1 = kbase_ + (unsigned)(((2 + hi) ^ (r32 & 7)) << 4),
                 kad2 = kbase_ + (unsigned)(((4 + hi) ^ (r32 & 7)) << 4), kad3 = kbase_ + (unsigned)(((6 + hi) ^ (r32 & 7)) << 4);
  const int NT = seq / KVBLK;
#define DMAK(t) do { const int tn_ = (t) < NT ? (t) : NT - 1; const char* kt_ = (const char*)Kh + (size_t)tn_ * (KVBLK * ldk * 2); \
    _Pragma("unroll") for (int q = 0; q < 2; ++q) __builtin_amdgcn_global_load_lds((const unsigned*)(kt_ + q * (32 * ldk * 2) + ksrc[0]), (LAS unsigned*)(K_lds + ((t) & 1) * SHM_K + kdst[q]), 16, 0, 0); } while (0)
#define DMAV(t) do { const int tn_ = (t) < NT ? (t) : NT - 1; const char* vt_ = (const char*)Vh + (size_t)tn_ * (KVBLK * ldv * 2); \
    _Pragma("unroll") for (int q = 0; q < NVOP; ++q) __builtin_amdgcn_global_load_lds((const unsigned*)(vt_ + q * (32 * ldv * 2) + vsrc[0]), (LAS unsigned*)(V_lds + ((t) & 1) * SHM_V + vdst[q]), 16, 0, 0); } while (0)
#define BAR_PLAIN() asm volatile("s_waitcnt lgkmcnt(0)\n\ts_barrier" ::: "memory")
#define BAR_DMA() asm volatile("s_waitcnt vmcnt(0) lgkmcnt(0)\n\ts_barrier" ::: "memory")
  f32x16 p0, p1; bf16x8 pa0, pa1, pa2, pa3;
#define SOFTMAX() do { float mn_, al_; partialSM(p0, p1, m_reg, mn_, al_, C, THRS); \
    if (__any(al_ < 1.f)) { if (hi == 0) al_l[r32] = al_; asm volatile("s_waitcnt lgkmcnt(0)" ::: "memory"); \
      _Pragma("unroll") for (int d = 0; d < DV / 32; ++d) _Pragma("unroll") for (int r = 0; r < 16; ++r) o[d][r] *= al_l[crow(r, hi)]; } \
    finishSM(p0, p1, al_, l_reg, pa0, pa1, pa2, pa3); } while (0)
  DMAK(0); DMAV(0); DMAK(1);
  BAR_DMA();
  if (ATT3_PLAIN == 5) { p0 = f32x16{}; p1 = f32x16{};
#pragma unroll
    for (int d0 = 0; d0 < DK / 16; ++d0) { const unsigned ka_ = ((d0 & 3) == 0 ? kad0 : (d0 & 3) == 1 ? kad1 : (d0 & 3) == 2 ? kad2 : kad3) + (unsigned)((d0 >> 2) * 128);
      const bf16x8 b0 = *(const __attribute__((address_space(3))) bf16x8*)(uintptr_t)ka_, b1 = *(const __attribute__((address_space(3))) bf16x8*)(uintptr_t)(ka_ + 8192u);
      p0 = __builtin_amdgcn_mfma_f32_32x32x16_bf16(b0, qr[d0], p0, 0, 0, 0); p1 = __builtin_amdgcn_mfma_f32_32x32x16_bf16(b1, qr[d0], p1, 0, 0, 0); } }
  else qkt<DK>(p0, p1, K_lds, qr, r32, hi);
  BAR_PLAIN();
  SOFTMAX();
  if (half == 1) { DMAK(2); DMAV(1); BAR_PLAIN(); }
#define MSEG(j, JP) do { if (half == 0) { DMAK((j) + 2); DMAV((j) + 1); } \
    if (ATT_PRIO == 1) __builtin_amdgcn_s_setprio(1); if (ATT_PRIO == 3) __builtin_amdgcn_s_setprio(0); \
    if (ATT_EXP & 16) __builtin_amdgcn_s_sleep(4); \
    SBAR(); if (false) {} \
    else if (ATT3_PLAIN == 5) { if ((j) + 1 < NT) { if constexpr (DK == 128) mseg_p128<((JP) ^ 1) * (int)SHM_K, (JP) * (int)SHM_V>(p0, p1, o, kad0, kad1, kad2, kad3, vb0, qr, pa0, pa1, pa2, pa3); \
        else mseg_p96<((JP) ^ 1) * (int)SHM_K, (JP) * (int)SHM_V>(p0, p1, o, kad0, kad1, kad2, kad3, vb0, qr, pa0, pa1, pa2, pa3); } else pv_all<DV>(o, vb0 + (JP) * (int)SHM_V, pa0, pa1, pa2, pa3); } \
    else if (ATT3_PLAIN == 2 && DV == 128) { if ((j) + 1 < NT) mseg_asm<DK, DV, true>(p0, p1, o, (lds_cptr)(K_lds + ((JP) ^ 1) * SHM_K), vb0 + (JP) * (int)SHM_V, qr, r32, hi, pa0, pa1, pa2, pa3); else mseg_asm<DK, DV, false>(p0, p1, o, (lds_cptr)K_lds, vb0 + (JP) * (int)SHM_V, qr, r32, hi, pa0, pa1, pa2, pa3); } \
    else if ((ATT3_PLAIN && DV == 128) || ATT3_PLAIN == 4) { if ((j) + 1 < NT) qkt<DK>(p0, p1, K_lds + ((JP) ^ 1) * SHM_K, qr, r32, hi); pv_all<DV>(o, vb0 + (JP) * (int)SHM_V, pa0, pa1, pa2, pa3); } \
    else if ((j) + 1 < NT) mseg_compute<DK, DV, true>(p0, p1, o, (lds_cptr)(K_lds + ((JP) ^ 1) * SHM_K), (lds_cptr)(V_lds + (JP) * SHM_V), qr, r32, hi, lane, pa0, pa1, pa2, pa3); \
    else mseg_compute<DK, DV, false>(p0, p1, o, (lds_cptr)K_lds, (lds_cptr)(V_lds + (JP) * SHM_V), qr, r32, hi, lane, pa0, pa1, pa2, pa3); SBAR(); \
    if (ATT_PRIO == 1) __builtin_amdgcn_s_setprio(0); if (ATT_PRIO == 3) __builtin_amdgcn_s_setprio(1); \
    if (half == 0) BAR_PLAIN(); else BAR_DMA(); } while (0)
#define VSEG(j, JP) do { if (half == 1) { DMAK((j) + 3); DMAV((j) + 2); } \
    if (ATT_EXP & 8) __builtin_amdgcn_s_sleep(4); \
    if ((j) + 1 < NT) SOFTMAX(); \
    if (half == 0) BAR_DMA(); else BAR_PLAIN(); } while (0)
  if (ATT_PRIO == 2 && half == 1) __builtin_amdgcn_s_setprio(1);
  if (ATT_PRIO == 4 && half == 0) __builtin_amdgcn_s_setprio(1);
  for (int j = 0; j < NT; j += 2) { MSEG(j, 0); VSEG(j, 0); MSEG(j + 1, 1); VSEG(j + 1, 1); }
  __builtin_amdgcn_s_setprio(0);
  if (half == 0) BAR_PLAIN();
  asm volatile("s_waitcnt vmcnt(0)" ::: "memory");
  int lane2 = lane; asm volatile("" : "+v"(lane2)); const int r32e = lane2 & 31, hie = lane2 >> 5;
  if (hie == 0) li_l[r32e] = l_reg; asm volatile("s_waitcnt lgkmcnt(0)" ::: "memory");
  unsigned ooff = (unsigned)((wid * QBLK + 4 * hie) * ldo + r32e) * 2u;
  asm volatile("" : "+v"(ooff));
#pragma unroll
  for (int r = 0; r < 16; ++r) { const float rl = __builtin_amdgcn_rcpf(li_l[crow(r, hie)]);
    char* orow = (char*)Ob + (size_t)(((r & 3) + 8 * (r >> 2)) * ldo) * 2;
#pragma unroll
    for (int d0 = 0; d0 < DV / 32; ++d0) *(bf16_t*)(orow + (ooff + d0 * 64)) = (bf16_t)(cvt_pk_bf16(o[d0][r] * rl, 0.f) & 0xffffu);
    asm volatile("" ::: "memory"); }
  asm volatile("s_waitcnt vmcnt(0) lgkmcnt(0)\n\ts_barrier" ::: "memory");
#undef DMAK
#undef DMAV
#undef BAR_PLAIN
#undef BAR_DMA
#undef SOFTMAX
#undef MSEG
#undef VSEG
}
#if ATT4_NOFENCE
#undef SBAR
#define SBAR() do {} while (0)
#endif
#define PKV(L, H) (bf16x8){L[0], L[1], L[2], L[3], H[0], H[1], H[2], H[3]}
template <int KOFF> __device__ __forceinline__ void a4_stepA_128(f32x16& X0, f32x16& X1, f32x16& Y0, f32x16& Y1, const float alphaY, float& l_reg, bf16x8& pa0, bf16x8& pa1, bf16x8& pa2, bf16x8& pa3, const unsigned* kad, const bf16x8* qr) {
  X0 = f32x16{}; X1 = f32x16{};
  const bf16x8 ka0 = *(const __attribute__((address_space(3))) bf16x8*)(uintptr_t)(kad[0] + (unsigned)(KOFF)); const bf16x8 kb0 = *(const __attribute__((address_space(3))) bf16x8*)(uintptr_t)(kad[0] + (unsigned)(KOFF + 8192));
  const bf16x8 ka1 = *(const __attribute__((address_space(3))) bf16x8*)(uintptr_t)(kad[1] + (unsigned)(KOFF)); const bf16x8 kb1 = *(const __attribute__((address_space(3))) bf16x8*)(uintptr_t)(kad[1] + (unsigned)(KOFF + 8192));
  const bf16x8 ka2 = *(const __attribute__((address_space(3))) bf16x8*)(uintptr_t)(kad[2] + (unsigned)(KOFF)); const bf16x8 kb2 = *(const __attribute__((address_space(3))) bf16x8*)(uintptr_t)(kad[2] + (unsigned)(KOFF + 8192));
  SBAR();
  X0 = __builtin_amdgcn_mfma_f32_32x32x16_bf16(ka0, qr[0], X0, 0, 0, 0); SBAR();
  Y1[0] = __builtin_amdgcn_exp2f(Y1[0]); float ps0 = Y0[0] + Y0[1]; Y1[1] = __builtin_amdgcn_exp2f(Y1[1]); ps0 += Y0[2]; ps0 += Y0[3]; const bf16x8 ka3 = *(const __attribute__((address_space(3))) bf16x8*)(uintptr_t)(kad[3] + (unsigned)(KOFF)); const bf16x8 kb3 = *(const __attribute__((address_space(3))) bf16x8*)(uintptr_t)(kad[3] + (unsigned)(KOFF + 8192)); SBAR();
  X1 = __builtin_amdgcn_mfma_f32_32x32x16_bf16(kb0, qr[0], X1, 0, 0, 0); SBAR();
  Y1[2] = __builtin_amdgcn_exp2f(Y1[2]); ps0 += Y0[4]; ps0 += Y0[5]; Y1[3] = __builtin_amdgcn_exp2f(Y1[3]); SBAR();
  X0 = __builtin_amdgcn_mfma_f32_32x32x16_bf16(ka1, qr[1], X0, 0, 0, 0); SBAR();
  ps0 += Y0[6]; ps0 += Y0[7]; Y1[4] = __builtin_amdgcn_exp2f(Y1[4]); ps0 += Y0[8]; ps0 += Y0[9]; const bf16x8 ka4 = *(const __attribute__((address_space(3))) bf16x8*)(uintptr_t)(kad[4] + (unsigned)(KOFF)); const bf16x8 kb4 = *(const __attribute__((address_space(3))) bf16x8*)(uintptr_t)(kad[4] + (unsigned)(KOFF + 8192)); SBAR();
  X1 = __builtin_amdgcn_mfma_f32_32x32x16_bf16(kb1, qr[1], X1, 0, 0, 0); SBAR();
  Y1[5] = __builtin_amdgcn_exp2f(Y1[5]); ps0 += Y0[10]; Y1[6] = __builtin_amdgcn_exp2f(Y1[6]); ps0 += Y0[11]; SBAR();
  X0 = __builtin_amdgcn_mfma_f32_32x32x16_bf16(ka2, qr[2], X0, 0, 0, 0); SBAR();
  ps0 += Y0[12]; Y1[7] = __builtin_amdgcn_exp2f(Y1[7]); ps0 += Y0[13]; ps0 += Y0[14]; Y1[8] = __builtin_amdgcn_exp2f(Y1[8]); const bf16x8 ka5 = *(const __attribute__((address_space(3))) bf16x8*)(uintptr_t)(kad[5] + (unsigned)(KOFF)); const bf16x8 kb5 = *(const __attribute__((address_space(3))) bf16x8*)(uintptr_t)(kad[5] + (unsigned)(KOFF + 8192)); SBAR();
  X1 = __builtin_amdgcn_mfma_f32_32x32x16_bf16(kb2, qr[2], X1, 0, 0, 0); SBAR();
  ps0 += Y0[15]; const unsigned ca0 = cvt_pk_bf16(Y0[0], Y0[1]); Y1[9] = __builtin_amdgcn_exp2f(Y1[9]); const unsigned cb0 = cvt_pk_bf16(Y0[2], Y0[3]); const unsigned cc0 = cvt_pk_bf16(Y0[4], Y0[5]); SBAR();
  X0 = __builtin_amdgcn_mfma_f32_32x32x16_bf16(ka3, qr[3], X0, 0, 0, 0); SBAR();
  Y1[10] = __builtin_amdgcn_exp2f(Y1[10]); const unsigned cd0 = cvt_pk_bf16(Y0[6], Y0[7]); Y1[11] = __builtin_amdgcn_exp2f(Y1[11]); const auto ra0 = __builtin_amdgcn_permlane32_swap(ca0, cc0, false, false); const bf16x8 ka6 = *(const __attribute__((address_space(3))) bf16x8*)(uintptr_t)(kad[6] + (unsigned)(KOFF)); const bf16x8 kb6 = *(const __attribute__((address_space(3))) bf16x8*)(uintptr_t)(kad[6] + (unsigned)(KOFF + 8192)); SBAR();
  X1 = __builtin_amdgcn_mfma_f32_32x32x16_bf16(kb3, qr[3], X1, 0, 0, 0); SBAR();
  const auto rb0 = __builtin_amdgcn_permlane32_swap(cb0, cd0, false, false); Y1[12] = __builtin_amdgcn_exp2f(Y1[12]); { u32x4 w_ = {ra0[0], rb0[0], ra0[1], rb0[1]}; pa0 = __builtin_bit_cast(bf16x8, w_); } const unsigned ca1 = cvt_pk_bf16(Y0[8], Y0[9]); SBAR();
  X0 = __builtin_amdgcn_mfma_f32_32x32x16_bf16(ka4, qr[4], X0, 0, 0, 0); SBAR();
  Y1[13] = __builtin_amdgcn_exp2f(Y1[13]); const unsigned cb1 = cvt_pk_bf16(Y0[10], Y0[11]); const unsigned cc1 = cvt_pk_bf16(Y0[12], Y0[13]); Y1[14] = __builtin_amdgcn_exp2f(Y1[14]); const bf16x8 ka7 = *(const __attribute__((address_space(3))) bf16x8*)(uintptr_t)(kad[7] + (unsigned)(KOFF)); const bf16x8 kb7 = *(const __attribute__((address_space(3))) bf16x8*)(uintptr_t)(kad[7] + (unsigned)(KOFF + 8192)); SBAR();
  X1 = __builtin_amdgcn_mfma_f32_32x32x16_bf16(kb4, qr[4], X1, 0, 0, 0); SBAR();
  const unsigned cd1 = cvt_pk_bf16(Y0[14], Y0[15]); const auto ra1 = __builtin_amdgcn_permlane32_swap(ca1, cc1, false, false); Y1[15] = __builtin_amdgcn_exp2f(Y1[15]); const auto rb1 = __builtin_amdgcn_permlane32_swap(cb1, cd1, false, false); SBAR();
  X0 = __builtin_amdgcn_mfma_f32_32x32x16_bf16(ka5, qr[5], X0, 0, 0, 0); SBAR();
  { u32x4 w_ = {ra1[0], rb1[0], ra1[1], rb1[1]}; pa1 = __builtin_bit_cast(bf16x8, w_); } float ps1 = Y1[0] + Y1[1]; ps1 += Y1[2]; ps1 += Y1[3]; ps1 += Y1[4]; ps1 += Y1[5]; ps1 += Y1[6]; SBAR();
  X1 = __builtin_amdgcn_mfma_f32_32x32x16_bf16(kb5, qr[5], X1, 0, 0, 0); SBAR();
  ps1 += Y1[7]; ps1 += Y1[8]; ps1 += Y1[9]; ps1 += Y1[10]; ps1 += Y1[11]; ps1 += Y1[12]; SBAR();
  X0 = __builtin_amdgcn_mfma_f32_32x32x16_bf16(ka6, qr[6], X0, 0, 0, 0); SBAR();
  ps1 += Y1[13]; ps1 += Y1[14]; ps1 += Y1[15]; const unsigned ca2 = cvt_pk_bf16(Y1[0], Y1[1]); const unsigned cb2 = cvt_pk_bf16(Y1[2], Y1[3]); const unsigned cc2 = cvt_pk_bf16(Y1[4], Y1[5]); SBAR();
  X1 = __builtin_amdgcn_mfma_f32_32x32x16_bf16(kb6, qr[6], X1, 0, 0, 0); SBAR();
  const unsigned cd2 = cvt_pk_bf16(Y1[6], Y1[7]); const auto ra2 = __builtin_amdgcn_permlane32_swap(ca2, cc2, false, false); const auto rb2 = __builtin_amdgcn_permlane32_swap(cb2, cd2, false, false); { u32x4 w_ = {ra2[0], rb2[0], ra2[1], rb2[1]}; pa2 = __builtin_bit_cast(bf16x8, w_); } const unsigned ca3 = cvt_pk_bf16(Y1[8], Y1[9]); SBAR();
  X0 = __builtin_amdgcn_mfma_f32_32x32x16_bf16(ka7, qr[7], X0, 0, 0, 0); SBAR();
  const unsigned cb3 = cvt_pk_bf16(Y1[10], Y1[11]); const unsigned cc3 = cvt_pk_bf16(Y1[12], Y1[13]); const unsigned cd3 = cvt_pk_bf16(Y1[14], Y1[15]); const auto ra3 = __builtin_amdgcn_permlane32_swap(ca3, cc3, false, false); const auto rb3 = __builtin_amdgcn_permlane32_swap(cb3, cd3, false, false); SBAR();
  X1 = __builtin_amdgcn_mfma_f32_32x32x16_bf16(kb7, qr[7], X1, 0, 0, 0); SBAR();
  { u32x4 w_ = {ra3[0], rb3[0], ra3[1], rb3[1]}; pa3 = __builtin_bit_cast(bf16x8, w_); } float ps_ = ps0 + ps1; const auto rs_ = __builtin_amdgcn_permlane32_swap(__float_as_uint(ps_), __float_as_uint(ps_), false, false); ps_ = __uint_as_float(rs_[0]) + __uint_as_float(rs_[1]); l_reg = l_reg * alphaY + ps_; SBAR();
}
template <int KOFF> __device__ __forceinline__ void a4_stepA_128_first(f32x16& X0, f32x16& X1, f32x16& Y0, f32x16& Y1, const float alphaY, float& l_reg, bf16x8& pa0, bf16x8& pa1, bf16x8& pa2, bf16x8& pa3, const unsigned* kad, const bf16x8* qr) {
  X0 = f32x16{}; X1 = f32x16{};
  const bf16x8 ka0 = *(const __attribute__((address_space(3))) bf16x8*)(uintptr_t)(kad[0] + (unsigned)(KOFF)); const bf16x8 kb0 = *(const __attribute__((address_space(3))) bf16x8*)(uintptr_t)(kad[0] + (unsigned)(KOFF + 8192));
  const bf16x8 ka1 = *(const __attribute__((address_space(3))) bf16x8*)(uintptr_t)(kad[1] + (unsigned)(KOFF)); const bf16x8 kb1 = *(const __attribute__((address_space(3))) bf16x8*)(uintptr_t)(kad[1] + (unsigned)(KOFF + 8192));
  const bf16x8 ka2 = *(const __attribute__((address_space(3))) bf16x8*)(uintptr_t)(kad[2] + (unsigned)(KOFF)); const bf16x8 kb2 = *(const __attribute__((address_space(3))) bf16x8*)(uintptr_t)(kad[2] + (unsigned)(KOFF + 8192));
  SBAR();
  X0 = __builtin_amdgcn_mfma_f32_32x32x16_bf16(ka0, qr[0], X0, 0, 0, 0); SBAR();
  const bf16x8 ka3 = *(const __attribute__((address_space(3))) bf16x8*)(uintptr_t)(kad[3] + (unsigned)(KOFF)); const bf16x8 kb3 = *(const __attribute__((address_space(3))) bf16x8*)(uintptr_t)(kad[3] + (unsigned)(KOFF + 8192)); SBAR();
  X1 = __builtin_amdgcn_mfma_f32_32x32x16_bf16(kb0, qr[0], X1, 0, 0, 0); SBAR();
  X0 = __builtin_amdgcn_mfma_f32_32x32x16_bf16(ka1, qr[1], X0, 0, 0, 0); SBAR();
  const bf16x8 ka4 = *(const __attribute__((address_space(3))) bf16x8*)(uintptr_t)(kad[4] + (unsigned)(KOFF)); const bf16x8 kb4 = *(const __attribute__((address_space(3))) bf16x8*)(uintptr_t)(kad[4] + (unsigned)(KOFF + 8192)); SBAR();
  X1 = __builtin_amdgcn_mfma_f32_32x32x16_bf16(kb1, qr[1], X1, 0, 0, 0); SBAR();
  X0 = __builtin_amdgcn_mfma_f32_32x32x16_bf16(ka2, qr[2], X0, 0, 0, 0); SBAR();
  const bf16x8 ka5 = *(const __attribute__((address_space(3))) bf16x8*)(uintptr_t)(kad[5] + (unsigned)(KOFF)); const bf16x8 kb5 = *(const __attribute__((address_space(3))) bf16x8*)(uintptr_t)(kad[5] + (unsigned)(KOFF + 8192)); SBAR();
  X1 = __builtin_amdgcn_mfma_f32_32x32x16_bf16(kb2, qr[2], X1, 0, 0, 0); SBAR();
  X0 = __builtin_amdgcn_mfma_f32_32x32x16_bf16(ka3, qr[3], X0, 0, 0, 0); SBAR();
  const bf16x8 ka6 = *(const __attribute__((address_space(3))) bf16x8*)(uintptr_t)(kad[6] + (unsigned)(KOFF)); const bf16x8 kb6 = *(const __attribute__((address_space(3))) bf16x8*)(uintptr_t)(kad[6] + (unsigned)(KOFF + 8192)); SBAR();
  X1 = __builtin_amdgcn_mfma_f32_32x32x16_bf16(kb3, qr[3], X1, 0, 0, 0); SBAR();
  X0 = __builtin_amdgcn_mfma_f32_32x32x16_bf16(ka4, qr[4], X0, 0, 0, 0); SBAR();
  const bf16x8 ka7 = *(const __attribute__((address_space(3))) bf16x8*)(uintptr_t)(kad[7] + (unsigned)(KOFF)); const bf16x8 kb7 = *(const __attribute__((address_space(3))) bf16x8*)(uintptr_t)(kad[7] + (unsigned)(KOFF + 8192)); SBAR();
  X1 = __builtin_amdgcn_mfma_f32_32x32x16_bf16(kb4, qr[4], X1, 0, 0, 0); SBAR();
  X0 = __builtin_amdgcn_mfma_f32_32x32x16_bf16(ka5, qr[5], X0, 0, 0, 0); SBAR();
  X1 = __builtin_amdgcn_mfma_f32_32x32x16_bf16(kb5, qr[5], X1, 0, 0, 0); SBAR();
  X0 = __builtin_amdgcn_mfma_f32_32x32x16_bf16(ka6, qr[6], X0, 0, 0, 0); SBAR();
  X1 = __builtin_amdgcn_mfma_f32_32x32x16_bf16(kb6, qr[6], X1, 0, 0, 0); SBAR();
  X0 = __builtin_amdgcn_mfma_f32_32x32x16_bf16(ka7, qr[7], X0, 0, 0, 0); SBAR();
  X1 = __builtin_amdgcn_mfma_f32_32x32x16_bf16(kb7, qr[7], X1, 0, 0, 0); SBAR();
}
template <int KOFF> __device__ __forceinline__ void a4_stepA_96(f32x16& X0, f32x16& X1, f32x16& Y0, f32x16& Y1, const float alphaY, float& l_reg, bf16x8& pa0, bf16x8& pa1, bf16x8& pa2, bf16x8& pa3, const unsigned* kad, const bf16x8* qr) {
  X0 = f32x16{}; X1 = f32x16{};
  const bf16x8 ka0 = *(const __attribute__((address_space(3))) bf16x8*)(uintptr_t)(kad[0] + (unsigned)(KOFF)); const bf16x8 kb0 = *(const __attribute__((address_space(3))) bf16x8*)(uintptr_t)(kad[0] + (unsigned)(KOFF + 8192));
  const bf16x8 ka1 = *(const __attribute__((address_space(3))) bf16x8*)(uintptr_t)(kad[1] + (unsigned)(KOFF)); const bf16x8 kb1 = *(const __attribute__((address_space(3))) bf16x8*)(uintptr_t)(kad[1] + (unsigned)(KOFF + 8192));
  const bf16x8 ka2 = *(const __attribute__((address_space(3))) bf16x8*)(uintptr_t)(kad[2] + (unsigned)(KOFF)); const bf16x8 kb2 = *(const __attribute__((address_space(3))) bf16x8*)(uintptr_t)(kad[2] + (unsigned)(KOFF + 8192));
  SBAR();
  X0 = __builtin_amdgcn_mfma_f32_32x32x16_bf16(ka0, qr[0], X0, 0, 0, 0); SBAR();
  Y1[0] = __builtin_amdgcn_exp2f(Y1[0]); float ps0 = Y0[0] + Y0[1]; Y1[1] = __builtin_amdgcn_exp2f(Y1[1]); ps0 += Y0[2]; ps0 += Y0[3]; Y1[2] = __builtin_amdgcn_exp2f(Y1[2]); const bf16x8 ka3 = *(const __attribute__((address_space(3))) bf16x8*)(uintptr_t)(kad[3] + (unsigned)(KOFF)); const bf16x8 kb3 = *(const __attribute__((address_space(3))) bf16x8*)(uintptr_t)(kad[3] + (unsigned)(KOFF + 8192)); SBAR();
  X1 = __builtin_amdgcn_mfma_f32_32x32x16_bf16(kb0, qr[0], X1, 0, 0, 0); SBAR();
  ps0 += Y0[4]; ps0 += Y0[5]; Y1[3] = __builtin_amdgcn_exp2f(Y1[3]); ps0 += Y0[6]; ps0 += Y0[7]; Y1[4] = __builtin_amdgcn_exp2f(Y1[4]); SBAR();
  X0 = __builtin_amdgcn_mfma_f32_32x32x16_bf16(ka1, qr[1], X0, 0, 0, 0); SBAR();
  ps0 += Y0[8]; ps0 += Y0[9]; Y1[5] = __builtin_amdgcn_exp2f(Y1[5]); ps0 += Y0[10]; Y1[6] = __builtin_amdgcn_exp2f(Y1[6]); ps0 += Y0[11]; const bf16x8 ka4 = *(const __attribute__((address_space(3))) bf16x8*)(uintptr_t)(kad[4] + (unsigned)(KOFF)); const bf16x8 kb4 = *(const __attribute__((address_space(3))) bf16x8*)(uintptr_t)(kad[4] + (unsigned)(KOFF + 8192)); SBAR();
  X1 = __builtin_amdgcn_mfma_f32_32x32x16_bf16(kb1, qr[1], X1, 0, 0, 0); SBAR();
  ps0 += Y0[12]; Y1[7] = __builtin_amdgcn_exp2f(Y1[7]); ps0 += Y0[13]; ps0 += Y0[14]; Y1[8] = __builtin_amdgcn_exp2f(Y1[8]); ps0 += Y0[15]; SBAR();
  X0 = __builtin_amdgcn_mfma_f32_32x32x16_bf16(ka2, qr[2], X0, 0, 0, 0); SBAR();
  const unsigned ca0 = cvt_pk_bf16(Y0[0], Y0[1]); Y1[9] = __builtin_amdgcn_exp2f(Y1[9]); const unsigned cb0 = cvt_pk_bf16(Y0[2], Y0[3]); const unsigned cc0 = cvt_pk_bf16(Y0[4], Y0[5]); Y1[10] = __builtin_amdgcn_exp2f(Y1[10]); const unsigned cd0 = cvt_pk_bf16(Y0[6], Y0[7]); Y1[11] = __builtin_amdgcn_exp2f(Y1[11]); const bf16x8 ka5 = *(const __attribute__((address_space(3))) bf16x8*)(uintptr_t)(kad[5] + (unsigned)(KOFF)); const bf16x8 kb5 = *(const __attribute__((address_space(3))) bf16x8*)(uintptr_t)(kad[5] + (unsigned)(KOFF + 8192)); SBAR();
  X1 = __builtin_amdgcn_mfma_f32_32x32x16_bf16(kb2, qr[2], X1, 0, 0, 0); SBAR();
  const auto ra0 = __builtin_amdgcn_permlane32_swap(ca0, cc0, false, false); const auto rb0 = __builtin_amdgcn_permlane32_swap(cb0, cd0, false, false); Y1[12] = __builtin_amdgcn_exp2f(Y1[12]); { u32x4 w_ = {ra0[0], rb0[0], ra0[1], rb0[1]}; pa0 = __builtin_bit_cast(bf16x8, w_); } const unsigned ca1 = cvt_pk_bf16(Y0[8], Y0[9]); SBAR();
  X0 = __builtin_amdgcn_mfma_f32_32x32x16_bf16(ka3, qr[3], X0, 0, 0, 0); SBAR();
  Y1[13] = __builtin_amdgcn_exp2f(Y1[13]); const unsigned cb1 = cvt_pk_bf16(Y0[10], Y0[11]); const unsigned cc1 = cvt_pk_bf16(Y0[12], Y0[13]); Y1[14] = __builtin_amdgcn_exp2f(Y1[14]); const unsigned cd1 = cvt_pk_bf16(Y0[14], Y0[15]); const auto ra1 = __builtin_amdgcn_permlane32_swap(ca1, cc1, false, false); SBAR();
  X1 = __builtin_amdgcn_mfma_f32_32x32x16_bf16(kb3, qr[3], X1, 0, 0, 0); SBAR();
  Y1[15] = __builtin_amdgcn_exp2f(Y1[15]); const auto rb1 = __builtin_amdgcn_permlane32_swap(cb1, cd1, false, false); { u32x4 w_ = {ra1[0], rb1[0], ra1[1], rb1[1]}; pa1 = __builtin_bit_cast(bf16x8, w_); } float ps1 = Y1[0] + Y1[1]; ps1 += Y1[2]; ps1 += Y1[3]; SBAR();
  X0 = __builtin_amdgcn_mfma_f32_32x32x16_bf16(ka4, qr[4], X0, 0, 0, 0); SBAR();
  ps1 += Y1[4]; ps1 += Y1[5]; ps1 += Y1[6]; ps1 += Y1[7]; ps1 += Y1[8]; ps1 += Y1[9]; ps1 += Y1[10]; ps1 += Y1[11]; ps1 += Y1[12]; SBAR();
  X1 = __builtin_amdgcn_mfma_f32_32x32x16_bf16(kb4, qr[4], X1, 0, 0, 0); SBAR();
  ps1 += Y1[13]; ps1 += Y1[14]; ps1 += Y1[15]; const unsigned ca2 = cvt_pk_bf16(Y1[0], Y1[1]); const unsigned cb2 = cvt_pk_bf16(Y1[2], Y1[3]); const unsigned cc2 = cvt_pk_bf16(Y1[4], Y1[5]); const unsigned cd2 = cvt_pk_bf16(Y1[6], Y1[7]); const auto ra2 = __builtin_amdgcn_permlane32_swap(ca2, cc2, false, false); SBAR();
  X0 = __builtin_amdgcn_mfma_f32_32x32x16_bf16(ka5, qr[5], X0, 0, 0, 0); SBAR();
  const auto rb2 = __builtin_amdgcn_permlane32_swap(cb2, cd2, false, false); { u32x4 w_ = {ra2[0], rb2[0], ra2[1], rb2[1]}; pa2 = __builtin_bit_cast(bf16x8, w_); } const unsigned ca3 = cvt_pk_bf16(Y1[8], Y1[9]); const unsigned cb3 = cvt_pk_bf16(Y1[10], Y1[11]); const unsigned cc3 = cvt_pk_bf16(Y1[12], Y1[13]); const unsigned cd3 = cvt_pk_bf16(Y1[14], Y1[15]); const auto ra3 = __builtin_amdgcn_permlane32_swap(ca3, cc3, false, false); SBAR();
  X1 = __builtin_amdgcn_mfma_f32_32x32x16_bf16(kb5, qr[5], X1, 0, 0, 0); SBAR();
  const auto rb3 = __builtin_amdgcn_permlane32_swap(cb3, cd3, false, false); { u32x4 w_ = {ra3[0], rb3[0], ra3[1], rb3[1]}; pa3 = __builtin_bit_cast(bf16x8, w_); } float ps_ = ps0 + ps1; const auto rs_ = __builtin_amdgcn_permlane32_swap(__float_as_uint(ps_), __float_as_uint(ps_), false, false); ps_ = __uint_as_float(rs_[0]) + __uint_as_float(rs_[1]); l_reg = l_reg * alphaY + ps_; SBAR();
}
template <int KOFF> __device__ __forceinline__ void a4_stepA_96_first(f32x16& X0, f32x16& X1, f32x16& Y0, f32x16& Y1, const float alphaY, float& l_reg, bf16x8& pa0, bf16x8& pa1, bf16x8& pa2, bf16x8& pa3, const unsigned* kad, const bf16x8* qr) {
  X0 = f32x16{}; X1 = f32x16{};
  const bf16x8 ka0 = *(const __attribute__((address_space(3))) bf16x8*)(uintptr_t)(kad[0] + (unsigned)(KOFF)); const bf16x8 kb0 = *(const __attribute__((address_space(3))) bf16x8*)(uintptr_t)(kad[0] + (unsigned)(KOFF + 8192));
  const bf16x8 ka1 = *(const __attribute__((address_space(3))) bf16x8*)(uintptr_t)(kad[1] + (unsigned)(KOFF)); const bf16x8 kb1 = *(const __attribute__((address_space(3))) bf16x8*)(uintptr_t)(kad[1] + (unsigned)(KOFF + 8192));
  const bf16x8 ka2 = *(const __attribute__((address_space(3))) bf16x8*)(uintptr_t)(kad[2] + (unsigned)(KOFF)); const bf16x8 kb2 = *(const __attribute__((address_space(3))) bf16x8*)(uintptr_t)(kad[2] + (unsigned)(KOFF + 8192));
  SBAR();
  X0 = __builtin_amdgcn_mfma_f32_32x32x16_bf16(ka0, qr[0], X0, 0, 0, 0); SBAR();
  const bf16x8 ka3 = *(const __attribute__((address_space(3))) bf16x8*)(uintptr_t)(kad[3] + (unsigned)(KOFF)); const bf16x8 kb3 = *(const __attribute__((address_space(3))) bf16x8*)(uintptr_t)(kad[3] + (unsigned)(KOFF + 8192)); SBAR();
  X1 = __builtin_amdgcn_mfma_f32_32x32x16_bf16(kb0, qr[0], X1, 0, 0, 0); SBAR();
  X0 = __builtin_amdgcn_mfma_f32_32x32x16_bf16(ka1, qr[1], X0, 0, 0, 0); SBAR();
  const bf16x8 ka4 = *(const __attribute__((address_space(3))) bf16x8*)(uintptr_t)(kad[4] + (unsigned)(KOFF)); const bf16x8 kb4 = *(const __attribute__((address_space(3))) bf16x8*)(uintptr_t)(kad[4] + (unsigned)(KOFF + 8192)); SBAR();
  X1 = __builtin_amdgcn_mfma_f32_32x32x16_bf16(kb1, qr[1], X1, 0, 0, 0); SBAR();
  X0 = __builtin_amdgcn_mfma_f32_32x32x16_bf16(ka2, qr[2], X0, 0, 0, 0); SBAR();
  const bf16x8 ka5 = *(const __attribute__((address_space(3))) bf16x8*)(uintptr_t)(kad[5] + (unsigned)(KOFF)); const bf16x8 kb5 = *(const __attribute__((address_space(3))) bf16x8*)(uintptr_t)(kad[5] + (unsigned)(KOFF + 8192)); SBAR();
  X1 = __builtin_amdgcn_mfma_f32_32x32x16_bf16(kb2, qr[2], X1, 0, 0, 0); SBAR();
  X0 = __builtin_amdgcn_mfma_f32_32x32x16_bf16(ka3, qr[3], X0, 0, 0, 0); SBAR();
  X1 = __builtin_amdgcn_mfma_f32_32x32x16_bf16(kb3, qr[3], X1, 0, 0, 0); SBAR();
  X0 = __builtin_amdgcn_mfma_f32_32x32x16_bf16(ka4, qr[4], X0, 0, 0, 0); SBAR();
  X1 = __builtin_amdgcn_mfma_f32_32x32x16_bf16(kb4, qr[4], X1, 0, 0, 0); SBAR();
  X0 = __builtin_amdgcn_mfma_f32_32x32x16_bf16(ka5, qr[5], X0, 0, 0, 0); SBAR();
  X1 = __builtin_amdgcn_mfma_f32_32x32x16_bf16(kb5, qr[5], X1, 0, 0, 0); SBAR();
}
template <int VOFF> __device__ __forceinline__ void a4_stepB_128(f32x16* o, const bf16x8 pa0, const bf16x8 pa1, const bf16x8 pa2, const bf16x8 pa3, const int vb, f32x16& X0, f32x16& X1, float& m_reg, float& alphaX, bool& keepX, const float C, const float THRS) {
  const s16x4 vl0_0 = vtr((lds_cptr)(uintptr_t)(unsigned)(vb + VOFF + v_rd_off(0, 0, 0))); const s16x4 vh0_0 = vtr((lds_cptr)(uintptr_t)(unsigned)(vb + VOFF + v_rd_off(0, 0, 1)));
  const s16x4 vl1_0 = vtr((lds_cptr)(uintptr_t)(unsigned)(vb + VOFF + v_rd_off(1, 0, 0))); const s16x4 vh1_0 = vtr((lds_cptr)(uintptr_t)(unsigned)(vb + VOFF + v_rd_off(1, 0, 1)));
  const s16x4 vl2_0 = vtr((lds_cptr)(uintptr_t)(unsigned)(vb + VOFF + v_rd_off(2, 0, 0))); const s16x4 vh2_0 = vtr((lds_cptr)(uintptr_t)(unsigned)(vb + VOFF + v_rd_off(2, 0, 1)));
  const s16x4 vl3_0 = vtr((lds_cptr)(uintptr_t)(unsigned)(vb + VOFF + v_rd_off(3, 0, 0))); const s16x4 vh3_0 = vtr((lds_cptr)(uintptr_t)(unsigned)(vb + VOFF + v_rd_off(3, 0, 1)));
  SBAR();
  o[0] = __builtin_amdgcn_mfma_f32_32x32x16_bf16(pa0, PKV(vl0_0, vh0_0), o[0], 0, 0, 0); SBAR();
  float m0_ = fmaxf(fmaxf(X0[0], X0[1]), X0[2]); m0_ = fmaxf(fmaxf(m0_, X0[3]), X0[4]); m0_ = fmaxf(fmaxf(m0_, X0[5]), X0[6]); m0_ = fmaxf(fmaxf(m0_, X0[7]), X0[8]); m0_ = fmaxf(fmaxf(m0_, X0[9]), X0[10]); m0_ = fmaxf(fmaxf(m0_, X0[11]), X0[12]); const s16x4 vl0_1 = vtr((lds_cptr)(uintptr_t)(unsigned)(vb + VOFF + v_rd_off(0, 1, 0))); const s16x4 vh0_1 = vtr((lds_cptr)(uintptr_t)(unsigned)(vb + VOFF + v_rd_off(0, 1, 1))); SBAR();
  o[1] = __builtin_amdgcn_mfma_f32_32x32x16_bf16(pa0, PKV(vl1_0, vh1_0), o[1], 0, 0, 0); SBAR();
  m0_ = fmaxf(fmaxf(m0_, X0[13]), X0[14]); m0_ = fmaxf(m0_, X0[15]); float m1_ = fmaxf(fmaxf(X1[0], X1[1]), X1[2]); m1_ = fmaxf(fmaxf(m1_, X1[3]), X1[4]); m1_ = fmaxf(fmaxf(m1_, X1[5]), X1[6]); m1_ = fmaxf(fmaxf(m1_, X1[7]), X1[8]); const s16x4 vl1_1 = vtr((lds_cptr)(uintptr_t)(unsigned)(vb + VOFF + v_rd_off(1, 1, 0))); const s16x4 vh1_1 = vtr((lds_cptr)(uintptr_t)(unsigned)(vb + VOFF + v_rd_off(1, 1, 1))); SBAR();
  o[2] = __builtin_amdgcn_mfma_f32_32x32x16_bf16(pa0, PKV(vl2_0, vh2_0), o[2], 0, 0, 0); SBAR();
  m1_ = fmaxf(fmaxf(m1_, X1[9]), X1[10]); m1_ = fmaxf(fmaxf(m1_, X1[11]), X1[12]); m1_ = fmaxf(fmaxf(m1_, X1[13]), X1[14]); m1_ = fmaxf(m1_, X1[15]); float pm_ = fmaxf(m0_, m1_); const auto rm_ = __builtin_amdgcn_permlane32_swap(__float_as_uint(pm_), __float_as_uint(pm_), false, false); const s16x4 vl2_1 = vtr((lds_cptr)(uintptr_t)(unsigned)(vb + VOFF + v_rd_off(2, 1, 0))); const s16x4 vh2_1 = vtr((lds_cptr)(uintptr_t)(unsigned)(vb + VOFF + v_rd_off(2, 1, 1))); SBAR();
  o[3] = __builtin_amdgcn_mfma_f32_32x32x16_bf16(pa0, PKV(vl3_0, vh3_0), o[3], 0, 0, 0); SBAR();
  pm_ = fmaxf(__uint_as_float(rm_[0]), __uint_as_float(rm_[1])); keepX = __all(pm_ - m_reg <= THRS); const float mn_ = keepX ? m_reg : fmaxf(m_reg, pm_); const s16x4 vl3_1 = vtr((lds_cptr)(uintptr_t)(unsigned)(vb + VOFF + v_rd_off(3, 1, 0))); const s16x4 vh3_1 = vtr((lds_cptr)(uintptr_t)(unsigned)(vb + VOFF + v_rd_off(3, 1, 1))); SBAR();
  o[0] = __builtin_amdgcn_mfma_f32_32x32x16_bf16(pa1, PKV(vl0_1, vh0_1), o[0], 0, 0, 0); SBAR();
  alphaX = keepX ? 1.f : __builtin_amdgcn_exp2f((m_reg - mn_) * C); m_reg = mn_; const float mnC_ = -mn_ * C; const s16x4 vl0_2 = vtr((lds_cptr)(uintptr_t)(unsigned)(vb + VOFF + v_rd_off(0, 2, 0))); const s16x4 vh0_2 = vtr((lds_cptr)(uintptr_t)(unsigned)(vb + VOFF + v_rd_off(0, 2, 1))); SBAR();
  o[1] = __builtin_amdgcn_mfma_f32_32x32x16_bf16(pa1, PKV(vl1_1, vh1_1), o[1], 0, 0, 0); SBAR();
  X0[0] = fmaf(X0[0], C, mnC_); X1[0] = fmaf(X1[0], C, mnC_); X0[1] = fmaf(X0[1], C, mnC_); X1[1] = fmaf(X1[1], C, mnC_); X0[0] = __builtin_amdgcn_exp2f(X0[0]); const s16x4 vl1_2 = vtr((lds_cptr)(uintptr_t)(unsigned)(vb + VOFF + v_rd_off(1, 2, 0))); const s16x4 vh1_2 = vtr((lds_cptr)(uintptr_t)(unsigned)(vb + VOFF + v_rd_off(1, 2, 1))); SBAR();
  o[2] = __builtin_amdgcn_mfma_f32_32x32x16_bf16(pa1, PKV(vl2_1, vh2_1), o[2], 0, 0, 0); SBAR();
  X0[2] = fmaf(X0[2], C, mnC_); X1[2] = fmaf(X1[2], C, mnC_); X0[1] = __builtin_amdgcn_exp2f(X0[1]); X0[3] = fmaf(X0[3], C, mnC_); X1[3] = fmaf(X1[3], C, mnC_); const s16x4 vl2_2 = vtr((lds_cptr)(uintptr_t)(unsigned)(vb + VOFF + v_rd_off(2, 2, 0))); const s16x4 vh2_2 = vtr((lds_cptr)(uintptr_t)(unsigned)(vb + VOFF + v_rd_off(2, 2, 1))); SBAR();
  o[3] = __builtin_amdgcn_mfma_f32_32x32x16_bf16(pa1, PKV(vl3_1, vh3_1), o[3], 0, 0, 0); SBAR();
  X0[2] = __builtin_amdgcn_exp2f(X0[2]); X0[4] = fmaf(X0[4], C, mnC_); X1[4] = fmaf(X1[4], C, mnC_); X0[3] = __builtin_amdgcn_exp2f(X0[3]); const s16x4 vl3_2 = vtr((lds_cptr)(uintptr_t)(unsigned)(vb + VOFF + v_rd_off(3, 2, 0))); const s16x4 vh3_2 = vtr((lds_cptr)(uintptr_t)(unsigned)(vb + VOFF + v_rd_off(3, 2, 1))); SBAR();
  o[0] = __builtin_amdgcn_mfma_f32_32x32x16_bf16(pa2, PKV(vl0_2, vh0_2), o[0], 0, 0, 0); SBAR();
  X0[5] = fmaf(X0[5], C, mnC_); X1[5] = fmaf(X1[5], C, mnC_); X0[4] = __builtin_amdgcn_exp2f(X0[4]); X0[6] = fmaf(X0[6], C, mnC_); const s16x4 vl0_3 = vtr((lds_cptr)(uintptr_t)(unsigned)(vb + VOFF + v_rd_off(0, 3, 0))); const s16x4 vh0_3 = vtr((lds_cptr)(uintptr_t)(unsigned)(vb + VOFF + v_rd_off(0, 3, 1))); SBAR();
  o[1] = __builtin_amdgcn_mfma_f32_32x32x16_bf16(pa2, PKV(vl1_2, vh1_2), o[1], 0, 0, 0); SBAR();
  X1[6] = fmaf(X1[6], C, mnC_); X0[5] = __builtin_amdgcn_exp2f(X0[5]); X0[7] = fmaf(X0[7], C, mnC_); X1[7] = fmaf(X1[7], C, mnC_); X0[6] = __builtin_amdgcn_exp2f(X0[6]); const s16x4 vl1_3 = vtr((lds_cptr)(uintptr_t)(unsigned)(vb + VOFF + v_rd_off(1, 3, 0))); const s16x4 vh1_3 = vtr((lds_cptr)(uintptr_t)(unsigned)(vb + VOFF + v_rd_off(1, 3, 1))); SBAR();
  o[2] = __builtin_amdgcn_mfma_f32_32x32x16_bf16(pa2, PKV(vl2_2, vh2_2), o[2], 0, 0, 0); SBAR();
  X0[8] = fmaf(X0[8], C, mnC_); X1[8] = fmaf(X1[8], C, mnC_); X0[7] = __builtin_amdgcn_exp2f(X0[7]); X0[9] = fmaf(X0[9], C, mnC_); const s16x4 vl2_3 = vtr((lds_cptr)(uintptr_t)(unsigned)(vb + VOFF + v_rd_off(2, 3, 0))); const s16x4 vh2_3 = vtr((lds_cptr)(uintptr_t)(unsigned)(vb + VOFF + v_rd_off(2, 3, 1))); SBAR();
  o[3] = __builtin_amdgcn_mfma_f32_32x32x16_bf16(pa2, PKV(vl3_2, vh3_2), o[3], 0, 0, 0); SBAR();
  X1[9] = fmaf(X1[9], C, mnC_); X0[8] = __builtin_amdgcn_exp2f(X0[8]); X0[10] = fmaf(X0[10], C, mnC_); X1[10] = fmaf(X1[10], C, mnC_); X0[9] = __builtin_amdgcn_exp2f(X0[9]); const s16x4 vl3_3 = vtr((lds_cptr)(uintptr_t)(unsigned)(vb + VOFF + v_rd_off(3, 3, 0))); const s16x4 vh3_3 = vtr((lds_cptr)(uintptr_t)(unsigned)(vb + VOFF + v_rd_off(3, 3, 1))); SBAR();
  o[0] = __builtin_amdgcn_mfma_f32_32x32x16_bf16(pa3, PKV(vl0_3, vh0_3), o[0], 0, 0, 0); SBAR();
  X0[11] = fmaf(X0[11], C, mnC_); X1[11] = fmaf(X1[11], C, mnC_); X0[10] = __builtin_amdgcn_exp2f(X0[10]); X0[12] = fmaf(X0[12], C, mnC_); SBAR();
  o[1] = __builtin_amdgcn_mfma_f32_32x32x16_bf16(pa3, PKV(vl1_3, vh1_3), o[1], 0, 0, 0); SBAR();
  X1[12] = fmaf(X1[12], C, mnC_); X0[11] = __builtin_amdgcn_exp2f(X0[11]); X0[13] = fmaf(X0[13], C, mnC_); X1[13] = fmaf(X1[13], C, mnC_); X0[12] = __builtin_amdgcn_exp2f(X0[12]); SBAR();
  o[2] = __builtin_amdgcn_mfma_f32_32x32x16_bf16(pa3, PKV(vl2_3, vh2_3), o[2], 0, 0, 0); SBAR();
  X0[14] = fmaf(X0[14], C, mnC_); X1[14] = fmaf(X1[14], C, mnC_); X0[13] = __builtin_amdgcn_exp2f(X0[13]); X0[15] = fmaf(X0[15], C, mnC_); SBAR();
  o[3] = __builtin_amdgcn_mfma_f32_32x32x16_bf16(pa3, PKV(vl3_3, vh3_3), o[3], 0, 0, 0); SBAR();
  X1[15] = fmaf(X1[15], C, mnC_); X0[14] = __builtin_amdgcn_exp2f(X0[14]); X0[15] = __builtin_amdgcn_exp2f(X0[15]); SBAR();
}
template <int VOFF> __device__ __forceinline__ void a4_stepB_64(f32x16* o, const bf16x8 pa0, const bf16x8 pa1, const bf16x8 pa2, const bf16x8 pa3, const int vb, f32x16& X0, f32x16& X1, float& m_reg, float& alphaX, bool& keepX, const float C, const float THRS) {
  const s16x4 vl0_0 = vtr((lds_cptr)(uintptr_t)(unsigned)(vb + VOFF + v_rd_off(0, 0, 0))); const s16x4 vh0_0 = vtr((lds_cptr)(uintptr_t)(unsigned)(vb + VOFF + v_rd_off(0, 0, 1)));
  const s16x4 vl1_0 = vtr((lds_cptr)(uintptr_t)(unsigned)(vb + VOFF + v_rd_off(1, 0, 0))); const s16x4 vh1_0 = vtr((lds_cptr)(uintptr_t)(unsigned)(vb + VOFF + v_rd_off(1, 0, 1)));
  const s16x4 vl0_1 = vtr((lds_cptr)(uintptr_t)(unsigned)(vb + VOFF + v_rd_off(0, 1, 0))); const s16x4 vh0_1 = vtr((lds_cptr)(uintptr_t)(unsigned)(vb + VOFF + v_rd_off(0, 1, 1)));
  const s16x4 vl1_1 = vtr((lds_cptr)(uintptr_t)(unsigned)(vb + VOFF + v_rd_off(1, 1, 0))); const s16x4 vh1_1 = vtr((lds_cptr)(uintptr_t)(unsigned)(vb + VOFF + v_rd_off(1, 1, 1)));
  SBAR();
  o[0] = __builtin_amdgcn_mfma_f32_32x32x16_bf16(pa0, PKV(vl0_0, vh0_0), o[0], 0, 0, 0); SBAR();
  float m0_ = fmaxf(fmaxf(X0[0], X0[1]), X0[2]); m0_ = fmaxf(fmaxf(m0_, X0[3]), X0[4]); m0_ = fmaxf(fmaxf(m0_, X0[5]), X0[6]); m0_ = fmaxf(fmaxf(m0_, X0[7]), X0[8]); m0_ = fmaxf(fmaxf(m0_, X0[9]), X0[10]); m0_ = fmaxf(fmaxf(m0_, X0[11]), X0[12]); m0_ = fmaxf(fmaxf(m0_, X0[13]), X0[14]); m0_ = fmaxf(m0_, X0[15]); float m1_ = fmaxf(fmaxf(X1[0], X1[1]), X1[2]); m1_ = fmaxf(fmaxf(m1_, X1[3]), X1[4]); m1_ = fmaxf(fmaxf(m1_, X1[5]), X1[6]); m1_ = fmaxf(fmaxf(m1_, X1[7]), X1[8]); const s16x4 vl0_2 = vtr((lds_cptr)(uintptr_t)(unsigned)(vb + VOFF + v_rd_off(0, 2, 0))); const s16x4 vh0_2 = vtr((lds_cptr)(uintptr_t)(unsigned)(vb + VOFF + v_rd_off(0, 2, 1))); SBAR();
  o[1] = __builtin_amdgcn_mfma_f32_32x32x16_bf16(pa0, PKV(vl1_0, vh1_0), o[1], 0, 0, 0); SBAR();
  m1_ = fmaxf(fmaxf(m1_, X1[9]), X1[10]); m1_ = fmaxf(fmaxf(m1_, X1[11]), X1[12]); m1_ = fmaxf(fmaxf(m1_, X1[13]), X1[14]); m1_ = fmaxf(m1_, X1[15]); float pm_ = fmaxf(m0_, m1_); const auto rm_ = __builtin_amdgcn_permlane32_swap(__float_as_uint(pm_), __float_as_uint(pm_), false, false); pm_ = fmaxf(__uint_as_float(rm_[0]), __uint_as_float(rm_[1])); keepX = __all(pm_ - m_reg <= THRS); const float mn_ = keepX ? m_reg : fmaxf(m_reg, pm_); const s16x4 vl1_2 = vtr((lds_cptr)(uintptr_t)(unsigned)(vb + VOFF + v_rd_off(1, 2, 0))); const s16x4 vh1_2 = vtr((lds_cptr)(uintptr_t)(unsigned)(vb + VOFF + v_rd_off(1, 2, 1))); SBAR();
  o[0] = __builtin_amdgcn_mfma_f32_32x32x16_bf16(pa1, PKV(vl0_1, vh0_1), o[0], 0, 0, 0); SBAR();
  alphaX = keepX ? 1.f : __builtin_amdgcn_exp2f((m_reg - mn_) * C); m_reg = mn_; const float mnC_ = -mn_ * C; X0[0] = fmaf(X0[0], C, mnC_); X1[0] = fmaf(X1[0], C, mnC_); X0[1] = fmaf(X0[1], C, mnC_); X1[1] = fmaf(X1[1], C, mnC_); X0[0] = __builtin_amdgcn_exp2f(X0[0]); const s16x4 vl0_3 = vtr((lds_cptr)(uintptr_t)(unsigned)(vb + VOFF + v_rd_off(0, 3, 0))); const s16x4 vh0_3 = vtr((lds_cptr)(uintptr_t)(unsigned)(vb + VOFF + v_rd_off(0, 3, 1))); SBAR();
  o[1] = __builtin_amdgcn_mfma_f32_32x32x16_bf16(pa1, PKV(vl1_1, vh1_1), o[1], 0, 0, 0); SBAR();
  X0[2] = fmaf(X0[2], C, mnC_); X1[2] = fmaf(X1[2], C, mnC_); X0[1] = __builtin_amdgcn_exp2f(X0[1]); X0[3] = fmaf(X0[3], C, mnC_); X1[3] = fmaf(X1[3], C, mnC_); X0[2] = __builtin_amdgcn_exp2f(X0[2]); X0[4] = fmaf(X0[4], C, mnC_); X1[4] = fmaf(X1[4], C, mnC_); X0[3] = __builtin_amdgcn_exp2f(X0[3]); const s16x4 vl1_3 = vtr((lds_cptr)(uintptr_t)(unsigned)(vb + VOFF + v_rd_off(1, 3, 0))); const s16x4 vh1_3 = vtr((lds_cptr)(uintptr_t)(unsigned)(vb + VOFF + v_rd_off(1, 3, 1))); SBAR();
  o[0] = __builtin_amdgcn_mfma_f32_32x32x16_bf16(pa2, PKV(vl0_2, vh0_2), o[0], 0, 0, 0); SBAR();
  X0[5] = fmaf(X0[5], C, mnC_); X1[5] = fmaf(X1[5], C, mnC_); X0[4] = __builtin_amdgcn_exp2f(X0[4]); X0[6] = fmaf(X0[6], C, mnC_); X1[6] = fmaf(X1[6], C, mnC_); X0[5] = __builtin_amdgcn_exp2f(X0[5]); X0[7] = fmaf(X0[7], C, mnC_); X1[7] = fmaf(X1[7], C, mnC_); X0[6] = __builtin_amdgcn_exp2f(X0[6]); SBAR();
  o[1] = __builtin_amdgcn_mfma_f32_32x32x16_bf16(pa2, PKV(vl1_2, vh1_2), o[1], 0, 0, 0); SBAR();
  X0[8] = fmaf(X0[8], C, mnC_); X1[8] = fmaf(X1[8], C, mnC_); X0[7] = __builtin_amdgcn_exp2f(X0[7]); X0[9] = fmaf(X0[9], C, mnC_); X1[9] = fmaf(X1[9], C, mnC_); X0[8] = __builtin_amdgcn_exp2f(X0[8]); X0[10] = fmaf(X0[10], C, mnC_); X1[10] = fmaf(X1[10], C, mnC_); X0[9] = __builtin_amdgcn_exp2f(X0[9]); SBAR();
  o[0] = __builtin_amdgcn_mfma_f32_32x32x16_bf16(pa3, PKV(vl0_3, vh0_3), o[0], 0, 0, 0); SBAR();
  X0[11] = fmaf(X0[11], C, mnC_); X1[11] = fmaf(X1[11], C, mnC_); X0[10] = __builtin_amdgcn_exp2f(X0[10]); X0[12] = fmaf(X0[12], C, mnC_); X1[12] = fmaf(X1[12], C, mnC_); X0[11] = __builtin_amdgcn_exp2f(X0[11]); X0[13] = fmaf(X0[13], C, mnC_); X1[13] = fmaf(X1[13], C, mnC_); X0[12] = __builtin_amdgcn_exp2f(X0[12]); SBAR();
  o[1] = __builtin_amdgcn_mfma_f32_32x32x16_bf16(pa3, PKV(vl1_3, vh1_3), o[1], 0, 0, 0); SBAR();
  X0[14] = fmaf(X0[14], C, mnC_); X1[14] = fmaf(X1[14], C, mnC_); X0[13] = __builtin_amdgcn_exp2f(X0[13]); X0[15] = fmaf(X0[15], C, mnC_); X1[15] = fmaf(X1[15], C, mnC_); X0[14] = __builtin_amdgcn_exp2f(X0[14]); X0[15] = __builtin_amdgcn_exp2f(X0[15]); SBAR();
}
template <int KOFF, int VOFF> __device__ __forceinline__ void a4_step_128_128(f32x16& X0, f32x16& X1, f32x16& Y0, f32x16& Y1, const float alphaY, float& l_reg, bf16x8& pa0, bf16x8& pa1, bf16x8& pa2, bf16x8& pa3, f32x16* o, const unsigned* kad, const int vb, const bf16x8* qr, float& m_reg, float& alphaX, bool& keepX, const float C, const float THRS, const char* kg, const char* vg, const unsigned kdst, const unsigned vdst, const int kstr, const int vstr) {
  bf16x8 ka0, kb0; bf16x8 ka1, kb1; bf16x8 ka2, kb2; bf16x8 ka3, kb3; bf16x8 ka4, kb4; bf16x8 ka5, kb5; bf16x8 ka6, kb6; bf16x8 ka7, kb7;
  s16x4 vl0_0, vh0_0; s16x4 vl0_1, vh0_1; s16x4 vl0_2, vh0_2; s16x4 vl0_3, vh0_3; s16x4 vl1_0, vh1_0; s16x4 vl1_1, vh1_1; s16x4 vl1_2, vh1_2; s16x4 vl1_3, vh1_3; s16x4 vl2_0, vh2_0; s16x4 vl2_1, vh2_1; s16x4 vl2_2, vh2_2; s16x4 vl2_3, vh2_3; s16x4 vl3_0, vh3_0; s16x4 vl3_1, vh3_1; s16x4 vl3_2, vh3_2; s16x4 vl3_3, vh3_3;
  X0 = f32x16{}; X1 = f32x16{};
  asm volatile("ds_read_b128 %0, %2 offset:%3\n\tds_read_b128 %1, %2 offset:%4" : "=&v"(ka0), "=&v"(kb0) : "v"(kad[0]), "i"(KOFF), "i"(KOFF + 8192) : "memory"); asm volatile("ds_read_b128 %0, %2 offset:%3\n\tds_read_b128 %1, %2 offset:%4" : "=&v"(ka1), "=&v"(kb1) : "v"(kad[1]), "i"(KOFF), "i"(KOFF + 8192) : "memory"); asm volatile("ds_read_b128 %0, %2 offset:%3\n\tds_read_b128 %1, %2 offset:%4" : "=&v"(ka2), "=&v"(kb2) : "v"(kad[2]), "i"(KOFF), "i"(KOFF + 8192) : "memory"); asm volatile("ds_read_b128 %0, %2 offset:%3\n\tds_read_b128 %1, %2 offset:%4" : "=&v"(ka3), "=&v"(kb3) : "v"(kad[3]), "i"(KOFF), "i"(KOFF + 8192) : "memory"); SBAR();
  Y1[0] = __builtin_amdgcn_exp2f(Y1[0]); float ps0 = Y0[0] + Y0[1]; Y1[1] = __builtin_amdgcn_exp2f(Y1[1]); ps0 += Y0[2]; ps0 += Y0[3]; Y1[2] = __builtin_amdgcn_exp2f(Y1[2]); ps0 += Y0[4]; ps0 += Y0[5]; Y1[3] = __builtin_amdgcn_exp2f(Y1[3]); ps0 += Y0[6]; ps0 += Y0[7]; Y1[4] = __builtin_amdgcn_exp2f(Y1[4]); SBAR();
  asm volatile("s_waitcnt lgkmcnt(6)" : "+v"(ka0), "+v"(kb0) :: "memory"); X0 = __builtin_amdgcn_mfma_f32_32x32x16_bf16(ka0, qr[0], X0, 0, 0, 0); SBAR();
  ps0 += Y0[8]; ps0 += Y0[9]; Y1[5] = __builtin_amdgcn_exp2f(Y1[5]); SBAR();
  X1 = __builtin_amdgcn_mfma_f32_32x32x16_bf16(kb0, qr[0], X1, 0, 0, 0); SBAR();
  ps0 += Y0[10]; Y1[6] = __builtin_amdgcn_exp2f(Y1[6]); ps0 += Y0[11]; ps0 += Y0[12]; Y1[7] = __builtin_amdgcn_exp2f(Y1[7]); asm volatile("ds_read_b128 %0, %2 offset:%3\n\tds_read_b128 %1, %2 offset:%4" : "=&v"(ka4), "=&v"(kb4) : "v"(kad[4]), "i"(KOFF), "i"(KOFF + 8192) : "memory"); if (kstr > 0) __builtin_amdgcn_global_load_lds((const unsigned*)(kg + 0 * kstr), (LAS unsigned*)(uintptr_t)(kdst + 0u), 16, 0, 0); SBAR();
  asm volatile("s_waitcnt lgkmcnt(6)" : "+v"(ka1), "+v"(kb1) :: "memory"); X0 = __builtin_amdgcn_mfma_f32_32x32x16_bf16(ka1, qr[1], X0, 0, 0, 0); SBAR();
  ps0 += Y0[13]; ps0 += Y0[14]; Y1[8] = __builtin_amdgcn_exp2f(Y1[8]); SBAR();
  X1 = __builtin_amdgcn_mfma_f32_32x32x16_bf16(kb1, qr[1], X1, 0, 0, 0); SBAR();
  ps0 += Y0[15]; const unsigned ca0 = cvt_pk_bf16(Y0[0], Y0[1]); Y1[9] = __builtin_amdgcn_exp2f(Y1[9]); const unsigned cb0 = cvt_pk_bf16(Y0[2], Y0[3]); asm volatile("ds_read_b128 %0, %2 offset:%3\n\tds_read_b128 %1, %2 offset:%4" : "=&v"(ka5), "=&v"(kb5) : "v"(kad[5]), "i"(KOFF), "i"(KOFF + 8192) : "memory"); SBAR();
  asm volatile("s_waitcnt lgkmcnt(6)" : "+v"(ka2), "+v"(kb2) :: "memory"); X0 = __builtin_amdgcn_mfma_f32_32x32x16_bf16(ka2, qr[2], X0, 0, 0, 0); SBAR();
  const unsigned cc0 = cvt_pk_bf16(Y0[4], Y0[5]); Y1[10] = __builtin_amdgcn_exp2f(Y1[10]); const unsigned cd0 = cvt_pk_bf16(Y0[6], Y0[7]); Y1[11] = __builtin_amdgcn_exp2f(Y1[11]); SBAR();
  X1 = __builtin_amdgcn_mfma_f32_32x32x16_bf16(kb2, qr[2], X1, 0, 0, 0); SBAR();
  const auto ra0 = __builtin_amdgcn_permlane32_swap(ca0, cc0, false, false); const auto rb0 = __builtin_amdgcn_permlane32_swap(cb0, cd0, false, false); asm volatile("ds_read_b128 %0, %2 offset:%3\n\tds_read_b128 %1, %2 offset:%4" : "=&v"(ka6), "=&v"(kb6) : "v"(kad[6]), "i"(KOFF), "i"(KOFF + 8192) : "memory"); if (kstr > 0) __builtin_amdgcn_global_load_lds((const unsigned*)(kg + 1 * kstr), (LAS unsigned*)(uintptr_t)(kdst + 8192u), 16, 0, 0); SBAR();
  asm volatile("s_waitcnt lgkmcnt(6)" : "+v"(ka3), "+v"(kb3) :: "memory"); X0 = __builtin_amdgcn_mfma_f32_32x32x16_bf16(ka3, qr[3], X0, 0, 0, 0); SBAR();
  Y1[12] = __builtin_amdgcn_exp2f(Y1[12]); { u32x4 w_ = {ra0[0], rb0[0], ra0[1], rb0[1]}; pa0 = __builtin_bit_cast(bf16x8, w_); } const unsigned ca1 = cvt_pk_bf16(Y0[8], Y0[9]); Y1[13] = __builtin_amdgcn_exp2f(Y1[13]); const unsigned cb1 = cvt_pk_bf16(Y0[10], Y0[11]); SBAR();
  X1 = __builtin_amdgcn_mfma_f32_32x32x16_bf16(kb3, qr[3], X1, 0, 0, 0); SBAR();
  const unsigned cc1 = cvt_pk_bf16(Y0[12], Y0[13]); Y1[14] = __builtin_amdgcn_exp2f(Y1[14]); const unsigned cd1 = cvt_pk_bf16(Y0[14], Y0[15]); const auto ra1 = __builtin_amdgcn_permlane32_swap(ca1, cc1, false, false); asm volatile("ds_read_b128 %0, %2 offset:%3\n\tds_read_b128 %1, %2 offset:%4" : "=&v"(ka7), "=&v"(kb7) : "v"(kad[7]), "i"(KOFF), "i"(KOFF + 8192) : "memory"); SBAR();
  asm volatile("s_waitcnt lgkmcnt(6)" : "+v"(ka4), "+v"(kb4) :: "memory"); X0 = __builtin_amdgcn_mfma_f32_32x32x16_bf16(ka4, qr[4], X0, 0, 0, 0); SBAR();
  Y1[15] = __builtin_amdgcn_exp2f(Y1[15]); const auto rb1 = __builtin_amdgcn_permlane32_swap(cb1, cd1, false, false); SBAR();
  X1 = __builtin_amdgcn_mfma_f32_32x32x16_bf16(kb4, qr[4], X1, 0, 0, 0); SBAR();
  { u32x4 w_ = {ra1[0], rb1[0], ra1[1], rb1[1]}; pa1 = __builtin_bit_cast(bf16x8, w_); } float ps1 = Y1[0] + Y1[1]; ps1 += Y1[2]; ps1 += Y1[3]; ps1 += Y1[4]; ps1 += Y1[5]; asm volatile("ds_read_b64_tr_b16 %0, %2 offset:%3\n\tds_read_b64_tr_b16 %1, %2 offset:%4" : "=&v"(vl0_0), "=&v"(vh0_0) : "v"(vb), "i"(VOFF + v_rd_off(0, 0, 0)), "i"(VOFF + v_rd_off(0, 0, 1)) : "memory"); if (kstr > 0) __builtin_amdgcn_global_load_lds((const unsigned*)(vg + 0 * vstr), (LAS unsigned*)(uintptr_t)(vdst + 0u), 16, 0, 0); SBAR();
  asm volatile("s_waitcnt lgkmcnt(6)" : "+v"(ka5), "+v"(kb5) :: "memory"); X0 = __builtin_amdgcn_mfma_f32_32x32x16_bf16(ka5, qr[5], X0, 0, 0, 0); SBAR();
  ps1 += Y1[6]; ps1 += Y1[7]; ps1 += Y1[8]; ps1 += Y1[9]; ps1 += Y1[10]; asm volatile("ds_read_b64_tr_b16 %0, %2 offset:%3\n\tds_read_b64_tr_b16 %1, %2 offset:%4" : "=&v"(vl1_0), "=&v"(vh1_0) : "v"(vb), "i"(VOFF + v_rd_off(1, 0, 0)), "i"(VOFF + v_rd_off(1, 0, 1)) : "memory"); SBAR();
  X1 = __builtin_amdgcn_mfma_f32_32x32x16_bf16(kb5, qr[5], X1, 0, 0, 0); SBAR();
  ps1 += Y1[11]; ps1 += Y1[12]; ps1 += Y1[13]; ps1 += Y1[14]; ps1 += Y1[15]; const unsigned ca2 = cvt_pk_bf16(Y1[0], Y1[1]); asm volatile("ds_read_b64_tr_b16 %0, %2 offset:%3\n\tds_read_b64_tr_b16 %1, %2 offset:%4" : "=&v"(vl2_0), "=&v"(vh2_0) : "v"(vb), "i"(VOFF + v_rd_off(2, 0, 0)), "i"(VOFF + v_rd_off(2, 0, 1)) : "memory"); SBAR();
  asm volatile("s_waitcnt lgkmcnt(8)" : "+v"(ka6), "+v"(kb6) :: "memory"); X0 = __builtin_amdgcn_mfma_f32_32x32x16_bf16(ka6, qr[6], X0, 0, 0, 0); SBAR();
  const unsigned cb2 = cvt_pk_bf16(Y1[2], Y1[3]); const unsigned cc2 = cvt_pk_bf16(Y1[4], Y1[5]); const unsigned cd2 = cvt_pk_bf16(Y1[6], Y1[7]); const auto ra2 = __builtin_amdgcn_permlane32_swap(ca2, cc2, false, false); asm volatile("ds_read_b64_tr_b16 %0, %2 offset:%3\n\tds_read_b64_tr_b16 %1, %2 offset:%4" : "=&v"(vl3_0), "=&v"(vh3_0) : "v"(vb), "i"(VOFF + v_rd_off(3, 0, 0)), "i"(VOFF + v_rd_off(3, 0, 1)) : "memory"); SBAR();
  X1 = __builtin_amdgcn_mfma_f32_32x32x16_bf16(kb6, qr[6], X1, 0, 0, 0); SBAR();
  const auto rb2 = __builtin_amdgcn_permlane32_swap(cb2, cd2, false, false); { u32x4 w_ = {ra2[0], rb2[0], ra2[1], rb2[1]}; pa2 = __builtin_bit_cast(bf16x8, w_); } const unsigned ca3 = cvt_pk_bf16(Y1[8], Y1[9]); const unsigned cb3 = cvt_pk_bf16(Y1[10], Y1[11]); const unsigned cc3 = cvt_pk_bf16(Y1[12], Y1[13]); asm volatile("ds_read_b64_tr_b16 %0, %2 offset:%3\n\tds_read_b64_tr_b16 %1, %2 offset:%4" : "=&v"(vl0_1), "=&v"(vh0_1) : "v"(vb), "i"(VOFF + v_rd_off(0, 1, 0)), "i"(VOFF + v_rd_off(0, 1, 1)) : "memory"); if (kstr > 0) __builtin_amdgcn_global_load_lds((const unsigned*)(vg + 1 * vstr), (LAS unsigned*)(uintptr_t)(vdst + 8192u), 16, 0, 0); SBAR();
  asm volatile("s_waitcnt lgkmcnt(10)" : "+v"(ka7), "+v"(kb7) :: "memory"); X0 = __builtin_amdgcn_mfma_f32_32x32x16_bf16(ka7, qr[7], X0, 0, 0, 0); SBAR();
  const unsigned cd3 = cvt_pk_bf16(Y1[14], Y1[15]); const auto ra3 = __builtin_amdgcn_permlane32_swap(ca3, cc3, false, false); const auto rb3 = __builtin_amdgcn_permlane32_swap(cb3, cd3, false, false); asm volatile("ds_read_b64_tr_b16 %0, %2 offset:%3\n\tds_read_b64_tr_b16 %1, %2 offset:%4" : "=&v"(vl1_1), "=&v"(vh1_1) : "v"(vb), "i"(VOFF + v_rd_off(1, 1, 0)), "i"(VOFF + v_rd_off(1, 1, 1)) : "memory"); SBAR();
  X1 = __builtin_amdgcn_mfma_f32_32x32x16_bf16(kb7, qr[7], X1, 0, 0, 0); SBAR();
  { u32x4 w_ = {ra3[0], rb3[0], ra3[1], rb3[1]}; pa3 = __builtin_bit_cast(bf16x8, w_); } float ps_ = ps0 + ps1; const auto rs_ = __builtin_amdgcn_permlane32_swap(__float_as_uint(ps_), __float_as_uint(ps_), false, false); ps_ = __uint_as_float(rs_[0]) + __uint_as_float(rs_[1]); l_reg = l_reg * alphaY + ps_; asm volatile("ds_read_b64_tr_b16 %0, %2 offset:%3\n\tds_read_b64_tr_b16 %1, %2 offset:%4" : "=&v"(vl2_1), "=&v"(vh2_1) : "v"(vb), "i"(VOFF + v_rd_off(2, 1, 0)), "i"(VOFF + v_rd_off(2, 1, 1)) : "memory"); SBAR();
  asm volatile("s_waitcnt lgkmcnt(12)" : "+v"(vl0_0), "+v"(vh0_0) :: "memory"); o[0] = __builtin_amdgcn_mfma_f32_32x32x16_bf16(pa0, PKV(vl0_0, vh0_0), o[0], 0, 0, 0); SBAR();
  float m0_ = fmaxf(fmaxf(X0[0], X0[1]), X0[2]); m0_ = fmaxf(fmaxf(m0_, X0[3]), X0[4]); m0_ = fmaxf(fmaxf(m0_, X0[5]), X0[6]); m0_ = fmaxf(fmaxf(m0_, X0[7]), X0[8]); m0_ = fmaxf(fmaxf(m0_, X0[9]), X0[10]); m0_ = fmaxf(fmaxf(m0_, X0[11]), X0[12]); asm volatile("ds_read_b64_tr_b16 %0, %2 offset:%3\n\tds_read_b64_tr_b16 %1, %2 offset:%4" : "=&v"(vl3_1), "=&v"(vh3_1) : "v"(vb), "i"(VOFF + v_rd_off(3, 1, 0)), "i"(VOFF + v_rd_off(3, 1, 1)) : "memory"); SBAR();
  asm volatile("s_waitcnt lgkmcnt(12)" : "+v"(vl1_0), "+v"(vh1_0) :: "memory"); o[1] = __builtin_amdgcn_mfma_f32_32x32x16_bf16(pa0, PKV(vl1_0, vh1_0), o[1], 0, 0, 0); SBAR();
  m0_ = fmaxf(fmaxf(m0_, X0[13]), X0[14]); m0_ = fmaxf(m0_, X0[15]); float m1_ = fmaxf(fmaxf(X1[0], X1[1]), X1[2]); m1_ = fmaxf(fmaxf(m1_, X1[3]), X1[4]); m1_ = fmaxf(fmaxf(m1_, X1[5]), X1[6]); m1_ = fmaxf(fmaxf(m1_, X1[7]), X1[8]); asm volatile("ds_read_b64_tr_b16 %0, %2 offset:%3\n\tds_read_b64_tr_b16 %1, %2 offset:%4" : "=&v"(vl0_2), "=&v"(vh0_2) : "v"(vb), "i"(VOFF + v_rd_off(0, 2, 0)), "i"(VOFF + v_rd_off(0, 2, 1)) : "memory"); SBAR();
  asm volatile("s_waitcnt lgkmcnt(12)" : "+v"(vl2_0), "+v"(vh2_0) :: "memory"); o[2] = __builtin_amdgcn_mfma_f32_32x32x16_bf16(pa0, PKV(vl2_0, vh2_0), o[2], 0, 0, 0); SBAR();
  m1_ = fmaxf(fmaxf(m1_, X1[9]), X1[10]); m1_ = fmaxf(fmaxf(m1_, X1[11]), X1[12]); m1_ = fmaxf(fmaxf(m1_, X1[13]), X1[14]); m1_ = fmaxf(m1_, X1[15]); float pm_ = fmaxf(m0_, m1_); const auto rm_ = __builtin_amdgcn_permlane32_swap(__float_as_uint(pm_), __float_as_uint(pm_), false, false); asm volatile("ds_read_b64_tr_b16 %0, %2 offset:%3\n\tds_read_b64_tr_b16 %1, %2 offset:%4" : "=&v"(vl1_2), "=&v"(vh1_2) : "v"(vb), "i"(VOFF + v_rd_off(1, 2, 0)), "i"(VOFF + v_rd_off(1, 2, 1)) : "memory"); SBAR();
  asm volatile("s_waitcnt lgkmcnt(12)" : "+v"(vl3_0), "+v"(vh3_0) :: "memory"); o[3] = __builtin_amdgcn_mfma_f32_32x32x16_bf16(pa0, PKV(vl3_0, vh3_0), o[3], 0, 0, 0); SBAR();
  pm_ = fmaxf(__uint_as_float(rm_[0]), __uint_as_float(rm_[1])); keepX = __all(pm_ - m_reg <= THRS); const float mn_ = keepX ? m_reg : fmaxf(m_reg, pm_); asm volatile("ds_read_b64_tr_b16 %0, %2 offset:%3\n\tds_read_b64_tr_b16 %1, %2 offset:%4" : "=&v"(vl2_2), "=&v"(vh2_2) : "v"(vb), "i"(VOFF + v_rd_off(2, 2, 0)), "i"(VOFF + v_rd_off(2, 2, 1)) : "memory"); SBAR();
  asm volatile("s_waitcnt lgkmcnt(12)" : "+v"(vl0_1), "+v"(vh0_1) :: "memory"); o[0] = __builtin_amdgcn_mfma_f32_32x32x16_bf16(pa1, PKV(vl0_1, vh0_1), o[0], 0, 0, 0); SBAR();
  alphaX = keepX ? 1.f : __builtin_amdgcn_exp2f((m_reg - mn_) * C); m_reg = mn_; const float mnC_ = -mn_ * C; asm volatile("ds_read_b64_tr_b16 %0, %2 offset:%3\n\tds_read_b64_tr_b16 %1, %2 offset:%4" : "=&v"(vl3_2), "=&v"(vh3_2) : "v"(vb), "i"(VOFF + v_rd_off(3, 2, 0)), "i"(VOFF + v_rd_off(3, 2, 1)) : "memory"); SBAR();
  asm volatile("s_waitcnt lgkmcnt(12)" : "+v"(vl1_1), "+v"(vh1_1) :: "memory"); o[1] = __builtin_amdgcn_mfma_f32_32x32x16_bf16(pa1, PKV(vl1_1, vh1_1), o[1], 0, 0, 0); SBAR();
  X0[0] = fmaf(X0[0], C, mnC_); X1[0] = fmaf(X1[0], C, mnC_); X0[1] = fmaf(X0[1], C, mnC_); X1[1] = fmaf(X1[1], C, mnC_); X0[0] = __builtin_amdgcn_exp2f(X0[0]); asm volatile("ds_read_b64_tr_b16 %0, %2 offset:%3\n\tds_read_b64_tr_b16 %1, %2 offset:%4" : "=&v"(vl0_3), "=&v"(vh0_3) : "v"(vb), "i"(VOFF + v_rd_off(0, 3, 0)), "i"(VOFF + v_rd_off(0, 3, 1)) : "memory"); SBAR();
  asm volatile("s_waitcnt lgkmcnt(12)" : "+v"(vl2_1), "+v"(vh2_1) :: "memory"); o[2] = __builtin_amdgcn_mfma_f32_32x32x16_bf16(pa1, PKV(vl2_1, vh2_1), o[2], 0, 0, 0); SBAR();
  X0[2] = fmaf(X0[2], C, mnC_); X1[2] = fmaf(X1[2], C, mnC_); X0[1] = __builtin_amdgcn_exp2f(X0[1]); X0[3] = fmaf(X0[3], C, mnC_); X1[3] = fmaf(X1[3], C, mnC_); asm volatile("ds_read_b64_tr_b16 %0, %2 offset:%3\n\tds_read_b64_tr_b16 %1, %2 offset:%4" : "=&v"(vl1_3), "=&v"(vh1_3) : "v"(vb), "i"(VOFF + v_rd_off(1, 3, 0)), "i"(VOFF + v_rd_off(1, 3, 1)) : "memory"); SBAR();
  asm volatile("s_waitcnt lgkmcnt(12)" : "+v"(vl3_1), "+v"(vh3_1) :: "memory"); o[3] = __builtin_amdgcn_mfma_f32_32x32x16_bf16(pa1, PKV(vl3_1, vh3_1), o[3], 0, 0, 0); SBAR();
  X0[2] = __builtin_amdgcn_exp2f(X0[2]); X0[4] = fmaf(X0[4], C, mnC_); X1[4] = fmaf(X1[4], C, mnC_); X0[3] = __builtin_amdgcn_exp2f(X0[3]); asm volatile("ds_read_b64_tr_b16 %0, %2 offset:%3\n\tds_read_b64_tr_b16 %1, %2 offset:%4" : "=&v"(vl2_3), "=&v"(vh2_3) : "v"(vb), "i"(VOFF + v_rd_off(2, 3, 0)), "i"(VOFF + v_rd_off(2, 3, 1)) : "memory"); SBAR();
  asm volatile("s_waitcnt lgkmcnt(12)" : "+v"(vl0_2), "+v"(vh0_2) :: "memory"); o[0] = __builtin_amdgcn_mfma_f32_32x32x16_bf16(pa2, PKV(vl0_2, vh0_2), o[0], 0, 0, 0); SBAR();
  X0[5] = fmaf(X0[5], C, mnC_); X1[5] = fmaf(X1[5], C, mnC_); X0[4] = __builtin_amdgcn_exp2f(X0[4]); X0[6] = fmaf(X0[6], C, mnC_); asm volatile("ds_read_b64_tr_b16 %0, %2 offset:%3\n\tds_read_b64_tr_b16 %1, %2 offset:%4" : "=&v"(vl3_3), "=&v"(vh3_3) : "v"(vb), "i"(VOFF + v_rd_off(3, 3, 0)), "i"(VOFF + v_rd_off(3, 3, 1)) : "memory"); SBAR();
  asm volatile("s_waitcnt lgkmcnt(12)" : "+v"(vl1_2), "+v"(vh1_2) :: "memory"); o[1] = __builtin_amdgcn_mfma_f32_32x32x16_bf16(pa2, PKV(vl1_2, vh1_2), o[1], 0, 0, 0); SBAR();
  X1[6] = fmaf(X1[6], C, mnC_); X0[5] = __builtin_amdgcn_exp2f(X0[5]); X0[7] = fmaf(X0[7], C, mnC_); X1[7] = fmaf(X1[7], C, mnC_); X0[6] = __builtin_amdgcn_exp2f(X0[6]); SBAR();
  asm volatile("s_waitcnt lgkmcnt(10)" : "+v"(vl2_2), "+v"(vh2_2) :: "memory"); o[2] = __builtin_amdgcn_mfma_f32_32x32x16_bf16(pa2, PKV(vl2_2, vh2_2), o[2], 0, 0, 0); SBAR();
  X0[8] = fmaf(X0[8], C, mnC_); X1[8] = fmaf(X1[8], C, mnC_); X0[7] = __builtin_amdgcn_exp2f(X0[7]); X0[9] = fmaf(X0[9], C, mnC_); SBAR();
  asm volatile("s_waitcnt lgkmcnt(8)" : "+v"(vl3_2), "+v"(vh3_2) :: "memory"); o[3] = __builtin_amdgcn_mfma_f32_32x32x16_bf16(pa2, PKV(vl3_2, vh3_2), o[3], 0, 0, 0); SBAR();
  X1[9] = fmaf(X1[9], C, mnC_); X0[8] = __builtin_amdgcn_exp2f(X0[8]); X0[10] = fmaf(X0[10], C, mnC_); X1[10] = fmaf(X1[10], C, mnC_); X0[9] = __builtin_amdgcn_exp2f(X0[9]); SBAR();
  asm volatile("s_waitcnt lgkmcnt(6)" : "+v"(vl0_3), "+v"(vh0_3) :: "memory"); o[0] = __builtin_amdgcn_mfma_f32_32x32x16_bf16(pa3, PKV(vl0_3, vh0_3), o[0], 0, 0, 0); SBAR();
  X0[11] = fmaf(X0[11], C, mnC_); X1[11] = fmaf(X1[11], C, mnC_); X0[10] = __builtin_amdgcn_exp2f(X0[10]); X0[12] = fmaf(X0[12], C, mnC_); SBAR();
  asm volatile("s_waitcnt lgkmcnt(4)" : "+v"(vl1_3), "+v"(vh1_3) :: "memory"); o[1] = __builtin_amdgcn_mfma_f32_32x32x16_bf16(pa3, PKV(vl1_3, vh1_3), o[1], 0, 0, 0); SBAR();
  X1[12] = fmaf(X1[12], C, mnC_); X0[11] = __builtin_amdgcn_exp2f(X0[11]); X0[13] = fmaf(X0[13], C, mnC_); X1[13] = fmaf(X1[13], C, mnC_); X0[12] = __builtin_amdgcn_exp2f(X0[12]); SBAR();
  asm volatile("s_waitcnt lgkmcnt(2)" : "+v"(vl2_3), "+v"(vh2_3) :: "memory"); o[2] = __builtin_amdgcn_mfma_f32_32x32x16_bf16(pa3, PKV(vl2_3, vh2_3), o[2], 0, 0, 0); SBAR();
  X0[14] = fmaf(X0[14], C, mnC_); X1[14] = fmaf(X1[14], C, mnC_); X0[13] = __builtin_amdgcn_exp2f(X0[13]); X0[15] = fmaf(X0[15], C, mnC_); SBAR();
  asm volatile("s_waitcnt lgkmcnt(0)" : "+v"(vl3_3), "+v"(vh3_3) :: "memory"); o[3] = __builtin_amdgcn_mfma_f32_32x32x16_bf16(pa3, PKV(vl3_3, vh3_3), o[3], 0, 0, 0); SBAR();
  X1[15] = fmaf(X1[15], C, mnC_); X0[14] = __builtin_amdgcn_exp2f(X0[14]); X0[15] = __builtin_amdgcn_exp2f(X0[15]); SBAR();
  asm volatile("" : "+v"(X0), "+v"(X1));
}
template <int KOFF, int VOFF> __device__ __forceinline__ void a4_step_96_64(f32x16& X0, f32x16& X1, f32x16& Y0, f32x16& Y1, const float alphaY, float& l_reg, bf16x8& pa0, bf16x8& pa1, bf16x8& pa2, bf16x8& pa3, f32x16* o, const unsigned* kad, const int vb, const bf16x8* qr, float& m_reg, float& alphaX, bool& keepX, const float C, const float THRS, const char* kg, const char* vg, const unsigned kdst, const unsigned vdst, const int kstr, const int vstr) {
  bf16x8 ka0, kb0; bf16x8 ka1, kb1; bf16x8 ka2, kb2; bf16x8 ka3, kb3; bf16x8 ka4, kb4; bf16x8 ka5, kb5;
  s16x4 vl0_0, vh0_0; s16x4 vl0_1, vh0_1; s16x4 vl0_2, vh0_2; s16x4 vl0_3, vh0_3; s16x4 vl1_0, vh1_0; s16x4 vl1_1, vh1_1; s16x4 vl1_2, vh1_2; s16x4 vl1_3, vh1_3;
  X0 = f32x16{}; X1 = f32x16{};
  asm volatile("ds_read_b128 %0, %2 offset:%3\n\tds_read_b128 %1, %2 offset:%4" : "=&v"(ka0), "=&v"(kb0) : "v"(kad[0]), "i"(KOFF), "i"(KOFF + 8192) : "memory"); asm volatile("ds_read_b128 %0, %2 offset:%3\n\tds_read_b128 %1, %2 offset:%4" : "=&v"(ka1), "=&v"(kb1) : "v"(kad[1]), "i"(KOFF), "i"(KOFF + 8192) : "memory"); asm volatile("ds_read_b128 %0, %2 offset:%3\n\tds_read_b128 %1, %2 offset:%4" : "=&v"(ka2), "=&v"(kb2) : "v"(kad[2]), "i"(KOFF), "i"(KOFF + 8192) : "memory"); asm volatile("ds_read_b128 %0, %2 offset:%3\n\tds_read_b128 %1, %2 offset:%4" : "=&v"(ka3), "=&v"(kb3) : "v"(kad[3]), "i"(KOFF), "i"(KOFF + 8192) : "memory"); SBAR();
  Y1[0] = __builtin_amdgcn_exp2f(Y1[0]); float ps0 = Y0[0] + Y0[1]; Y1[1] = __builtin_amdgcn_exp2f(Y1[1]); ps0 += Y0[2]; ps0 += Y0[3]; Y1[2] = __builtin_amdgcn_exp2f(Y1[2]); ps0 += Y0[4]; ps0 += Y0[5]; Y1[3] = __builtin_amdgcn_exp2f(Y1[3]); ps0 += Y0[6]; ps0 += Y0[7]; Y1[4] = __builtin_amdgcn_exp2f(Y1[4]); ps0 += Y0[8]; ps0 += Y0[9]; Y1[5] = __builtin_amdgcn_exp2f(Y1[5]); SBAR();
  asm volatile("s_waitcnt lgkmcnt(6)" : "+v"(ka0), "+v"(kb0) :: "memory"); X0 = __builtin_amdgcn_mfma_f32_32x32x16_bf16(ka0, qr[0], X0, 0, 0, 0); SBAR();
  ps0 += Y0[10]; Y1[6] = __builtin_amdgcn_exp2f(Y1[6]); ps0 += Y0[11]; ps0 += Y0[12]; Y1[7] = __builtin_amdgcn_exp2f(Y1[7]); SBAR();
  X1 = __builtin_amdgcn_mfma_f32_32x32x16_bf16(kb0, qr[0], X1, 0, 0, 0); SBAR();
  ps0 += Y0[13]; ps0 += Y0[14]; Y1[8] = __builtin_amdgcn_exp2f(Y1[8]); ps0 += Y0[15]; asm volatile("ds_read_b128 %0, %2 offset:%3\n\tds_read_b128 %1, %2 offset:%4" : "=&v"(ka4), "=&v"(kb4) : "v"(kad[4]), "i"(KOFF), "i"(KOFF + 8192) : "memory"); if (kstr > 0) __builtin_amdgcn_global_load_lds((const unsigned*)(kg + 0 * kstr), (LAS unsigned*)(uintptr_t)(kdst + 0u), 16, 0, 0); SBAR();
  asm volatile("s_waitcnt lgkmcnt(6)" : "+v"(ka1), "+v"(kb1) :: "memory"); X0 = __builtin_amdgcn_mfma_f32_32x32x16_bf16(ka1, qr[1], X0, 0, 0, 0); SBAR();
  const unsigned ca0 = cvt_pk_bf16(Y0[0], Y0[1]); Y1[9] = __builtin_amdgcn_exp2f(Y1[9]); const unsigned cb0 = cvt_pk_bf16(Y0[2], Y0[3]); const unsigned cc0 = cvt_pk_bf16(Y0[4], Y0[5]); Y1[10] = __builtin_amdgcn_exp2f(Y1[10]); SBAR();
  X1 = __builtin_amdgcn_mfma_f32_32x32x16_bf16(kb1, qr[1], X1, 0, 0, 0); SBAR();
  const unsigned cd0 = cvt_pk_bf16(Y0[6], Y0[7]); Y1[11] = __builtin_amdgcn_exp2f(Y1[11]); const auto ra0 = __builtin_amdgcn_permlane32_swap(ca0, cc0, false, false); const auto rb0 = __builtin_amdgcn_permlane32_swap(cb0, cd0, false, false); asm volatile("ds_read_b128 %0, %2 offset:%3\n\tds_read_b128 %1, %2 offset:%4" : "=&v"(ka5), "=&v"(kb5) : "v"(kad[5]), "i"(KOFF), "i"(KOFF + 8192) : "memory"); SBAR();
  asm volatile("s_waitcnt lgkmcnt(6)" : "+v"(ka2), "+v"(kb2) :: "memory"); X0 = __builtin_amdgcn_mfma_f32_32x32x16_bf16(ka2, qr[2], X0, 0, 0, 0); SBAR();
  Y1[12] = __builtin_amdgcn_exp2f(Y1[12]); { u32x4 w_ = {ra0[0], rb0[0], ra0[1], rb0[1]}; pa0 = __builtin_bit_cast(bf16x8, w_); } const unsigned ca1 = cvt_pk_bf16(Y0[8], Y0[9]); Y1[13] = __builtin_amdgcn_exp2f(Y1[13]); const unsigned cb1 = cvt_pk_bf16(Y0[10], Y0[11]); SBAR();
  X1 = __builtin_amdgcn_mfma_f32_32x32x16_bf16(kb2, qr[2], X1, 0, 0, 0); SBAR();
  const unsigned cc1 = cvt_pk_bf16(Y0[12], Y0[13]); Y1[14] = __builtin_amdgcn_exp2f(Y1[14]); const unsigned cd1 = cvt_pk_bf16(Y0[14], Y0[15]); const auto ra1 = __builtin_amdgcn_permlane32_swap(ca1, cc1, false, false); Y1[15] = __builtin_amdgcn_exp2f(Y1[15]); asm volatile("ds_read_b64_tr_b16 %0, %2 offset:%3\n\tds_read_b64_tr_b16 %1, %2 offset:%4" : "=&v"(vl0_0), "=&v"(vh0_0) : "v"(vb), "i"(VOFF + v_rd_off(0, 0, 0)), "i"(VOFF + v_rd_off(0, 0, 1)) : "memory"); if (kstr > 0) __builtin_amdgcn_global_load_lds((const unsigned*)(kg + 1 * kstr), (LAS unsigned*)(uintptr_t)(kdst + 8192u), 16, 0, 0); SBAR();
  asm volatile("s_waitcnt lgkmcnt(6)" : "+v"(ka3), "+v"(kb3) :: "memory"); X0 = __builtin_amdgcn_mfma_f32_32x32x16_bf16(ka3, qr[3], X0, 0, 0, 0); SBAR();
  const auto rb1 = __builtin_amdgcn_permlane32_swap(cb1, cd1, false, false); { u32x4 w_ = {ra1[0], rb1[0], ra1[1], rb1[1]}; pa1 = __builtin_bit_cast(bf16x8, w_); } float ps1 = Y1[0] + Y1[1]; ps1 += Y1[2]; ps1 += Y1[3]; asm volatile("ds_read_b64_tr_b16 %0, %2 offset:%3\n\tds_read_b64_tr_b16 %1, %2 offset:%4" : "=&v"(vl1_0), "=&v"(vh1_0) : "v"(vb), "i"(VOFF + v_rd_off(1, 0, 0)), "i"(VOFF + v_rd_off(1, 0, 1)) : "memory"); SBAR();
  X1 = __builtin_amdgcn_mfma_f32_32x32x16_bf16(kb3, qr[3], X1, 0, 0, 0); SBAR();
  ps1 += Y1[4]; ps1 += Y1[5]; ps1 += Y1[6]; ps1 += Y1[7]; ps1 += Y1[8]; ps1 += Y1[9]; ps1 += Y1[10]; asm volatile("ds_read_b64_tr_b16 %0, %2 offset:%3\n\tds_read_b64_tr_b16 %1, %2 offset:%4" : "=&v"(vl0_1), "=&v"(vh0_1) : "v"(vb), "i"(VOFF + v_rd_off(0, 1, 0)), "i"(VOFF + v_rd_off(0, 1, 1)) : "memory"); SBAR();
  asm volatile("s_waitcnt lgkmcnt(8)" : "+v"(ka4), "+v"(kb4) :: "memory"); X0 = __builtin_amdgcn_mfma_f32_32x32x16_bf16(ka4, qr[4], X0, 0, 0, 0); SBAR();
  ps1 += Y1[11]; ps1 += Y1[12]; ps1 += Y1[13]; ps1 += Y1[14]; ps1 += Y1[15]; const unsigned ca2 = cvt_pk_bf16(Y1[0], Y1[1]); const unsigned cb2 = cvt_pk_bf16(Y1[2], Y1[3]); asm volatile("ds_read_b64_tr_b16 %0, %2 offset:%3\n\tds_read_b64_tr_b16 %1, %2 offset:%4" : "=&v"(vl1_1), "=&v"(vh1_1) : "v"(vb), "i"(VOFF + v_rd_off(1, 1, 0)), "i"(VOFF + v_rd_off(1, 1, 1)) : "memory"); SBAR();
  X1 = __builtin_amdgcn_mfma_f32_32x32x16_bf16(kb4, qr[4], X1, 0, 0, 0); SBAR();
  const unsigned cc2 = cvt_pk_bf16(Y1[4], Y1[5]); const unsigned cd2 = cvt_pk_bf16(Y1[6], Y1[7]); const auto ra2 = __builtin_amdgcn_permlane32_swap(ca2, cc2, false, false); const auto rb2 = __builtin_amdgcn_permlane32_swap(cb2, cd2, false, false); asm volatile("ds_read_b64_tr_b16 %0, %2 offset:%3\n\tds_read_b64_tr_b16 %1, %2 offset:%4" : "=&v"(vl0_2), "=&v"(vh0_2) : "v"(vb), "i"(VOFF + v_rd_off(0, 2, 0)), "i"(VOFF + v_rd_off(0, 2, 1)) : "memory"); if (kstr > 0) __builtin_amdgcn_global_load_lds((const unsigned*)(vg + 0 * vstr), (LAS unsigned*)(uintptr_t)(vdst + 0u), 16, 0, 0); SBAR();
  asm volatile("s_waitcnt lgkmcnt(10)" : "+v"(ka5), "+v"(kb5) :: "memory"); X0 = __builtin_amdgcn_mfma_f32_32x32x16_bf16(ka5, qr[5], X0, 0, 0, 0); SBAR();
  { u32x4 w_ = {ra2[0], rb2[0], ra2[1], rb2[1]}; pa2 = __builtin_bit_cast(bf16x8, w_); } const unsigned ca3 = cvt_pk_bf16(Y1[8], Y1[9]); const unsigned cb3 = cvt_pk_bf16(Y1[10], Y1[11]); const unsigned cc3 = cvt_pk_bf16(Y1[12], Y1[13]); const unsigned cd3 = cvt_pk_bf16(Y1[14], Y1[15]); const auto ra3 = __builtin_amdgcn_permlane32_swap(ca3, cc3, false, false); const auto rb3 = __builtin_amdgcn_permlane32_swap(cb3, cd3, false, false); asm volatile("ds_read_b64_tr_b16 %0, %2 offset:%3\n\tds_read_b64_tr_b16 %1, %2 offset:%4" : "=&v"(vl1_2), "=&v"(vh1_2) : "v"(vb), "i"(VOFF + v_rd_off(1, 2, 0)), "i"(VOFF + v_rd_off(1, 2, 1)) : "memory"); SBAR();
  X1 = __builtin_amdgcn_mfma_f32_32x32x16_bf16(kb5, qr[5], X1, 0, 0, 0); SBAR();
  { u32x4 w_ = {ra3[0], rb3[0], ra3[1], rb3[1]}; pa3 = __builtin_bit_cast(bf16x8, w_); } float ps_ = ps0 + ps1; const auto rs_ = __builtin_amdgcn_permlane32_swap(__float_as_uint(ps_), __float_as_uint(ps_), false, false); ps_ = __uint_as_float(rs_[0]) + __uint_as_float(rs_[1]); l_reg = l_reg * alphaY + ps_; asm volatile("ds_read_b64_tr_b16 %0, %2 offset:%3\n\tds_read_b64_tr_b16 %1, %2 offset:%4" : "=&v"(vl0_3), "=&v"(vh0_3) : "v"(vb), "i"(VOFF + v_rd_off(0, 3, 0)), "i"(VOFF + v_rd_off(0, 3, 1)) : "memory"); SBAR();
  asm volatile("s_waitcnt lgkmcnt(12)" : "+v"(vl0_0), "+v"(vh0_0) :: "memory"); o[0] = __builtin_amdgcn_mfma_f32_32x32x16_bf16(pa0, PKV(vl0_0, vh0_0), o[0], 0, 0, 0); SBAR();
  float m0_ = fmaxf(fmaxf(X0[0], X0[1]), X0[2]); m0_ = fmaxf(fmaxf(m0_, X0[3]), X0[4]); m0_ = fmaxf(fmaxf(m0_, X0[5]), X0[6]); m0_ = fmaxf(fmaxf(m0_, X0[7]), X0[8]); m0_ = fmaxf(fmaxf(m0_, X0[9]), X0[10]); m0_ = fmaxf(fmaxf(m0_, X0[11]), X0[12]); m0_ = fmaxf(fmaxf(m0_, X0[13]), X0[14]); m0_ = fmaxf(m0_, X0[15]); float m1_ = fmaxf(fmaxf(X1[0], X1[1]), X1[2]); m1_ = fmaxf(fmaxf(m1_, X1[3]), X1[4]); m1_ = fmaxf(fmaxf(m1_, X1[5]), X1[6]); m1_ = fmaxf(fmaxf(m1_, X1[7]), X1[8]); asm volatile("ds_read_b64_tr_b16 %0, %2 offset:%3\n\tds_read_b64_tr_b16 %1, %2 offset:%4" : "=&v"(vl1_3), "=&v"(vh1_3) : "v"(vb), "i"(VOFF + v_rd_off(1, 3, 0)), "i"(VOFF + v_rd_off(1, 3, 1)) : "memory"); SBAR();
  asm volatile("s_waitcnt lgkmcnt(12)" : "+v"(vl1_0), "+v"(vh1_0) :: "memory"); o[1] = __builtin_amdgcn_mfma_f32_32x32x16_bf16(pa0, PKV(vl1_0, vh1_0), o[1], 0, 0, 0); SBAR();
  m1_ = fmaxf(fmaxf(m1_, X1[9]), X1[10]); m1_ = fmaxf(fmaxf(m1_, X1[11]), X1[12]); m1_ = fmaxf(fmaxf(m1_, X1[13]), X1[14]); m1_ = fmaxf(m1_, X1[15]); float pm_ = fmaxf(m0_, m1_); const auto rm_ = __builtin_amdgcn_permlane32_swap(__float_as_uint(pm_), __float_as_uint(pm_), false, false); pm_ = fmaxf(__uint_as_float(rm_[0]), __uint_as_float(rm_[1])); keepX = __all(pm_ - m_reg <= THRS); const float mn_ = keepX ? m_reg : fmaxf(m_reg, pm_); SBAR();
  asm volatile("s_waitcnt lgkmcnt(10)" : "+v"(vl0_1), "+v"(vh0_1) :: "memory"); o[0] = __builtin_amdgcn_mfma_f32_32x32x16_bf16(pa1, PKV(vl0_1, vh0_1), o[0], 0, 0, 0); SBAR();
  alphaX = keepX ? 1.f : __builtin_amdgcn_exp2f((m_reg - mn_) * C); m_reg = mn_; const float mnC_ = -mn_ * C; X0[0] = fmaf(X0[0], C, mnC_); X1[0] = fmaf(X1[0], C, mnC_); X0[1] = fmaf(X0[1], C, mnC_); X1[1] = fmaf(X1[1], C, mnC_); X0[0] = __builtin_amdgcn_exp2f(X0[0]); SBAR();
  asm volatile("s_waitcnt lgkmcnt(8)" : "+v"(vl1_1), "+v"(vh1_1) :: "memory"); o[1] = __builtin_amdgcn_mfma_f32_32x32x16_bf16(pa1, PKV(vl1_1, vh1_1), o[1], 0, 0, 0); SBAR();
  X0[2] = fmaf(X0[2], C, mnC_); X1[2] = fmaf(X1[2], C, mnC_); X0[1] = __builtin_amdgcn_exp2f(X0[1]); X0[3] = fmaf(X0[3], C, mnC_); X1[3] = fmaf(X1[3], C, mnC_); X0[2] = __builtin_amdgcn_exp2f(X0[2]); X0[4] = fmaf(X0[4], C, mnC_); X1[4] = fmaf(X1[4], C, mnC_); X0[3] = __builtin_amdgcn_exp2f(X0[3]); SBAR();
  asm volatile("s_waitcnt lgkmcnt(6)" : "+v"(vl0_2), "+v"(vh0_2) :: "memory"); o[0] = __builtin_amdgcn_mfma_f32_32x32x16_bf16(pa2, PKV(vl0_2, vh0_2), o[0], 0, 0, 0); SBAR();
  X0[5] = fmaf(X0[5], C, mnC_); X1[5] = fmaf(X1[5], C, mnC_); X0[4] = __builtin_amdgcn_exp2f(X0[4]); X0[6] = fmaf(X0[6], C, mnC_); X1[6] = fmaf(X1[6], C, mnC_); X0[5] = __builtin_amdgcn_exp2f(X0[5]); X0[7] = fmaf(X0[7], C, mnC_); X1[7] = fmaf(X1[7], C, mnC_); X0[6] = __builtin_amdgcn_exp2f(X0[6]); SBAR();
  asm volatile("s_waitcnt lgkmcnt(4)" : "+v"(vl1_2), "+v"(vh1_2) :: "memory"); o[1] = __builtin_amdgcn_mfma_f32_32x32x16_bf16(pa2, PKV(vl1_2, vh1_2), o[1], 0, 0, 0); SBAR();
  X0[8] = fmaf(X0[8], C, mnC_); X1[8] = fmaf(X1[8], C, mnC_); X0[7] = __builtin_amdgcn_exp2f(X0[7]); X0[9] = fmaf(X0[9], C, mnC_); X1[9] = fmaf(X1[9], C, mnC_); X0[8] = __builtin_amdgcn_exp2f(X0[8]); X0[10] = fmaf(X0[10], C, mnC_); X1[10] = fmaf(X1[10], C, mnC_); X0[9] = __builtin_amdgcn_exp2f(X0[9]); SBAR();
  asm volatile("s_waitcnt lgkmcnt(2)" : "+v"(vl0_3), "+v"(vh0_3) :: "memory"); o[0] = __builtin_amdgcn_mfma_f32_32x32x16_bf16(pa3, PKV(vl0_3, vh0_3), o[0], 0, 0, 0); SBAR();
  X0[11] = fmaf(X0[11], C, mnC_); X1[11] = fmaf(X1[11], C, mnC_); X0[10] = __builtin_amdgcn_exp2f(X0[10]); X0[12] = fmaf(X0[12], C, mnC_); X1[12] = fmaf(X1[12], C, mnC_); X0[11] = __builtin_amdgcn_exp2f(X0[11]); X0[13] = fmaf(X0[13], C, mnC_); X1[13] = fmaf(X1[13], C, mnC_); X0[12] = __builtin_amdgcn_exp2f(X0[12]); SBAR();
  asm volatile("s_waitcnt lgkmcnt(0)" : "+v"(vl1_3), "+v"(vh1_3) :: "memory"); o[1] = __builtin_amdgcn_mfma_f32_32x32x16_bf16(pa3, PKV(vl1_3, vh1_3), o[1], 0, 0, 0); SBAR();
  X0[14] = fmaf(X0[14], C, mnC_); X1[14] = fmaf(X1[14], C, mnC_); X0[13] = __builtin_amdgcn_exp2f(X0[13]); X0[15] = fmaf(X0[15], C, mnC_); X1[15] = fmaf(X1[15], C, mnC_); X0[14] = __builtin_amdgcn_exp2f(X0[14]); X0[15] = __builtin_amdgcn_exp2f(X0[15]); SBAR();
  asm volatile("" : "+v"(X0), "+v"(X1));
}
__device__ __forceinline__ void a4_psm_plain(f32x16& X0, f32x16& X1, float& m_reg, float& alphaX, bool& keepX, const float C, const float THRS) {
  float m0_ = fmaxf(fmaxf(X0[0], X0[1]), X0[2]); m0_ = fmaxf(fmaxf(m0_, X0[3]), X0[4]); m0_ = fmaxf(fmaxf(m0_, X0[5]), X0[6]); m0_ = fmaxf(fmaxf(m0_, X0[7]), X0[8]); m0_ = fmaxf(fmaxf(m0_, X0[9]), X0[10]); m0_ = fmaxf(fmaxf(m0_, X0[11]), X0[12]); m0_ = fmaxf(fmaxf(m0_, X0[13]), X0[14]); m0_ = fmaxf(m0_, X0[15]); float m1_ = fmaxf(fmaxf(X1[0], X1[1]), X1[2]); m1_ = fmaxf(fmaxf(m1_, X1[3]), X1[4]); m1_ = fmaxf(fmaxf(m1_, X1[5]), X1[6]); m1_ = fmaxf(fmaxf(m1_, X1[7]), X1[8]); m1_ = fmaxf(fmaxf(m1_, X1[9]), X1[10]); m1_ = fmaxf(fmaxf(m1_, X1[11]), X1[12]); m1_ = fmaxf(fmaxf(m1_, X1[13]), X1[14]); m1_ = fmaxf(m1_, X1[15]); float pm_ = fmaxf(m0_, m1_); const auto rm_ = __builtin_amdgcn_permlane32_swap(__float_as_uint(pm_), __float_as_uint(pm_), false, false); pm_ = fmaxf(__uint_as_float(rm_[0]), __uint_as_float(rm_[1])); keepX = __all(pm_ - m_reg <= THRS); const float mn_ = keepX ? m_reg : fmaxf(m_reg, pm_); alphaX = keepX ? 1.f : __builtin_amdgcn_exp2f((m_reg - mn_) * C); m_reg = mn_; const float mnC_ = -mn_ * C; X0[0] = fmaf(X0[0], C, mnC_); X1[0] = fmaf(X1[0], C, mnC_); X0[1] = fmaf(X0[1], C, mnC_); X1[1] = fmaf(X1[1], C, mnC_); X0[0] = __builtin_amdgcn_exp2f(X0[0]); X0[2] = fmaf(X0[2], C, mnC_); X1[2] = fmaf(X1[2], C, mnC_); X0[1] = __builtin_amdgcn_exp2f(X0[1]); X0[3] = fmaf(X0[3], C, mnC_); X1[3] = fmaf(X1[3], C, mnC_); X0[2] = __builtin_amdgcn_exp2f(X0[2]); X0[4] = fmaf(X0[4], C, mnC_); X1[4] = fmaf(X1[4], C, mnC_); X0[3] = __builtin_amdgcn_exp2f(X0[3]); X0[5] = fmaf(X0[5], C, mnC_); X1[5] = fmaf(X1[5], C, mnC_); X0[4] = __builtin_amdgcn_exp2f(X0[4]); X0[6] = fmaf(X0[6], C, mnC_); X1[6] = fmaf(X1[6], C, mnC_); X0[5] = __builtin_amdgcn_exp2f(X0[5]); X0[7] = fmaf(X0[7], C, mnC_); X1[7] = fmaf(X1[7], C, mnC_); X0[6] = __builtin_amdgcn_exp2f(X0[6]); X0[8] = fmaf(X0[8], C, mnC_); X1[8] = fmaf(X1[8], C, mnC_); X0[7] = __builtin_amdgcn_exp2f(X0[7]); X0[9] = fmaf(X0[9], C, mnC_); X1[9] = fmaf(X1[9], C, mnC_); X0[8] = __builtin_amdgcn_exp2f(X0[8]); X0[10] = fmaf(X0[10], C, mnC_); X1[10] = fmaf(X1[10], C, mnC_); X0[9] = __builtin_amdgcn_exp2f(X0[9]); X0[11] = fmaf(X0[11], C, mnC_); X1[11] = fmaf(X1[11], C, mnC_); X0[10] = __builtin_amdgcn_exp2f(X0[10]); X0[12] = fmaf(X0[12], C, mnC_); X1[12] = fmaf(X1[12], C, mnC_); X0[11] = __builtin_amdgcn_exp2f(X0[11]); X0[13] = fmaf(X0[13], C, mnC_); X1[13] = fmaf(X1[13], C, mnC_); X0[12] = __builtin_amdgcn_exp2f(X0[12]); X0[14] = fmaf(X0[14], C, mnC_); X1[14] = fmaf(X1[14], C, mnC_); X0[13] = __builtin_amdgcn_exp2f(X0[13]); X0[15] = fmaf(X0[15], C, mnC_); X1[15] = fmaf(X1[15], C, mnC_); X0[14] = __builtin_amdgcn_exp2f(X0[14]); X0[15] = __builtin_amdgcn_exp2f(X0[15]);
}
#undef PKV
#if ATT4_NOFENCE
#undef SBAR
#define SBAR() __builtin_amdgcn_sched_barrier(0)
#endif

template <int DK, int DV, int ldq, int ldk, int ldv, int ldo, int STRIP = 0>
__device__ __forceinline__ void attn_unit4(const bf16_t* __restrict__ Qb, const bf16_t* __restrict__ Kh, const bf16_t* __restrict__ Vh,
                                           bf16_t* __restrict__ Ob, int seq, char* lds) {
  constexpr float C = (DK == 96 ? 0.10206207261596577f : 0.08838834764831845f) * 1.4426950408889634f;
  constexpr float THRS = 8.0f * 1.4426950408889634f / C;
  constexpr int NVOP = DV / 64;
  const int tid = threadIdx.x, wid = __builtin_amdgcn_readfirstlane(tid >> 6), lane = tid & 63, r32 = lane & 31, hi = lane >> 5;
  char* V_lds = lds; char* K_lds = lds + 2 * SHM_V;
  float* ws = (float*)(lds + 2 * SHM_V + 2 * SHM_K) + wid * 64; float* li_l = ws; float* al_l = ws + 32;
  float m_reg = -1e30f, l_reg = 0; f32x16 o[DV / 32]; bf16x8 qr[DK / 16];
#pragma unroll
  for (int d = 0; d < DV / 32; ++d) o[d] = f32x16{};
  { const unsigned qoff = (unsigned)((wid * QBLK + r32) * ldq + hi * 8) * 2u;
#pragma unroll
    for (int d0 = 0; d0 < DK / 16; ++d0) qr[d0] = *reinterpret_cast<const bf16x8*>((const char*)Qb + (qoff + d0 * 32)); }
  unsigned ksrc[2], vsrc[NVOP]; unsigned kdst[2], vdst[NVOP];
#pragma unroll
  for (int i = 0; i < 2; ++i) { const int ch = wid + 8 * i, row = 4 * ch + (lane >> 4), pos = lane & 15; ksrc[i] = (unsigned)(row * ldk * 2 + ((pos ^ (row & 15)) << 4)); kdst[i] = (unsigned)(ch * 1024); }
#pragma unroll
  for (int i = 0; i < NVOP; ++i) { const int ch = (DV == 64) ? 2 * wid : wid + 8 * i;
    const int ob = ch * 1024 + 16 * lane, st = ob >> 9, rem = ob & 511, kk = (st >> 2) * 8 + (rem >> 6), c = (st & 3) * 32 + ((rem & 63) >> 1);
    const int k = (kk & ~0xC) | ((kk & 4) << 1) | ((kk & 8) >> 1);
    vsrc[i] = (unsigned)(k * ldv * 2 + c * 2); vdst[i] = (unsigned)(ch * 1024); }
  const int vb0 = (int)(uintptr_t)V_lds + v_rd_base(lane);
  const unsigned kbase_ = (unsigned)(uintptr_t)K_lds + (unsigned)r32 * 256u;
  unsigned kad[DK / 16];
#pragma unroll
  for (int d0 = 0; d0 < DK / 16; ++d0) kad[d0] = kbase_ + (unsigned)(((2 * d0 + hi) ^ (r32 & 15)) << 4);
  const int NT = seq / KVBLK;
#define DMAK(t) do { const int tn_ = (t) < NT ? (t) : NT - 1; const char* kt_ = (const char*)Kh + (size_t)tn_ * (KVBLK * ldk * 2); \
    _Pragma("unroll") for (int q = 0; q < 2; ++q) __builtin_amdgcn_global_load_lds((const unsigned*)(kt_ + q * (32 * ldk * 2) + ksrc[0]), (LAS unsigned*)(K_lds + ((t) & 1) * SHM_K + kdst[q]), 16, 0, 0); } while (0)
#define DMAV(t) do { const int tn_ = (t) < NT ? (t) : NT - 1; const char* vt_ = (const char*)Vh + (size_t)tn_ * (KVBLK * ldv * 2); \
    _Pragma("unroll") for (int q = 0; q < NVOP; ++q) __builtin_amdgcn_global_load_lds((const unsigned*)(vt_ + q * (32 * ldv * 2) + vsrc[0]), (LAS unsigned*)(V_lds + ((t) & 1) * SHM_V + vdst[q]), 16, 0, 0); } while (0)
#define BAR_DMA() asm volatile("s_waitcnt vmcnt(0) lgkmcnt(0)\n\ts_barrier" ::: "memory")
#define RESCALE(keep_, al_) do { if (!(keep_)) { if (hi == 0) al_l[r32] = (al_); asm volatile("s_waitcnt lgkmcnt(0)" ::: "memory"); \
      _Pragma("unroll") for (int d = 0; d < DV / 32; ++d) _Pragma("unroll") for (int r = 0; r < 16; ++r) o[d][r] *= al_l[crow(r, hi)]; } } while (0)
#define STEPA(KOFF, X0, X1, Y0, Y1, alY) do { if constexpr (DK == 128) a4_stepA_128<KOFF>(X0, X1, Y0, Y1, alY, l_reg, pa0, pa1, pa2, pa3, kad, qr); \
    else a4_stepA_96<KOFF>(X0, X1, Y0, Y1, alY, l_reg, pa0, pa1, pa2, pa3, kad, qr); } while (0)
#define STEPB(VOFF, X0, X1, alX, keepX) do { if constexpr (DV == 128) a4_stepB_128<VOFF>(o, pa0, pa1, pa2, pa3, vb0, X0, X1, m_reg, alX, keepX, C, THRS); \
    else a4_stepB_64<VOFF>(o, pa0, pa1, pa2, pa3, vb0, X0, X1, m_reg, alX, keepX, C, THRS); } while (0)
  f32x16 A0, A1, B0, B1; bf16x8 pa0, pa1, pa2, pa3; float alA = 1.f, alB = 1.f; bool keepA = true, keepB = true;
  DMAK(0);
  BAR_DMA();
  DMAK(1); DMAV(0);
  if constexpr (DK == 128) a4_stepA_128_first<0>(A0, A1, B0, B1, 1.f, l_reg, pa0, pa1, pa2, pa3, kad, qr);
  else a4_stepA_96_first<0>(A0, A1, B0, B1, 1.f, l_reg, pa0, pa1, pa2, pa3, kad, qr);
  a4_psm_plain(A0, A1, m_reg, alA, keepA, C, THRS);
#define STEPARGS(X0, X1, Y0, Y1, alY, alX, keepX) (X0, X1, Y0, Y1, alY, l_reg, pa0, pa1, pa2, pa3, o, kad, vb0, qr, m_reg, alX, keepX, C, THRS, kg_, vg_, kd_, vd_, 32 * ldk * 2, 32 * ldv * 2)
#ifdef ATT4_STRIPGEN
#define STEPU(KOFF, VOFF, X0, X1, Y0, Y1, alY, alX, keepX) do { constexpr int SM_ = STRIP & 14; \
    if constexpr (DK == 128) { if constexpr (SM_ == 0 && (STRIP & 64)) a4_step_128_128d<KOFF, VOFF> STEPARGS(X0, X1, Y0, Y1, alY, alX, keepX); else if constexpr (SM_ == 0 && (STRIP & 128)) a4_step_128_128e<KOFF, VOFF> STEPARGS(X0, X1, Y0, Y1, alY, alX, keepX); else if constexpr (SM_ == 0) a4_step_128_128<KOFF, VOFF> STEPARGS(X0, X1, Y0, Y1, alY, alX, keepX); else if constexpr (SM_ == 2) a4_step_128_128_s2<KOFF, VOFF> STEPARGS(X0, X1, Y0, Y1, alY, alX, keepX); \
      else if constexpr (SM_ == 4) a4_step_128_128_s4<KOFF, VOFF> STEPARGS(X0, X1, Y0, Y1, alY, alX, keepX); else if constexpr (SM_ == 6) a4_step_128_128_s6<KOFF, VOFF> STEPARGS(X0, X1, Y0, Y1, alY, alX, keepX); \
      else if constexpr (SM_ == 8) a4_step_128_128_s8<KOFF, VOFF> STEPARGS(X0, X1, Y0, Y1, alY, alX, keepX); else if constexpr (SM_ == 10) a4_step_128_128_s10<KOFF, VOFF> STEPARGS(X0, X1, Y0, Y1, alY, alX, keepX); \
      else a4_step_128_128_s12<KOFF, VOFF> STEPARGS(X0, X1, Y0, Y1, alY, alX, keepX); } \
    else { if constexpr (SM_ == 0) a4_step_96_64<KOFF, VOFF> STEPARGS(X0, X1, Y0, Y1, alY, alX, keepX); else if constexpr (SM_ == 2) a4_step_96_64_s2<KOFF, VOFF> STEPARGS(X0, X1, Y0, Y1, alY, alX, keepX); \
      else if constexpr (SM_ == 4) a4_step_96_64_s4<KOFF, VOFF> STEPARGS(X0, X1, Y0, Y1, alY, alX, keepX); else if constexpr (SM_ == 6) a4_step_96_64_s6<KOFF, VOFF> STEPARGS(X0, X1, Y0, Y1, alY, alX, keepX); \
      else if constexpr (SM_ == 8) a4_step_96_64_s8<KOFF, VOFF> STEPARGS(X0, X1, Y0, Y1, alY, alX, keepX); else if constexpr (SM_ == 10) a4_step_96_64_s10<KOFF, VOFF> STEPARGS(X0, X1, Y0, Y1, alY, alX, keepX); \
      else a4_step_96_64_s12<KOFF, VOFF> STEPARGS(X0, X1, Y0, Y1, alY, alX, keepX); } } while (0)
#else
#define STEPU(KOFF, VOFF, X0, X1, Y0, Y1, alY, alX, keepX) do { if constexpr (DK == 128) a4_step_128_128<KOFF, VOFF> STEPARGS(X0, X1, Y0, Y1, alY, alX, keepX); \
    else a4_step_96_64<KOFF, VOFF> STEPARGS(X0, X1, Y0, Y1, alY, alX, keepX); } while (0)
#endif
#if ATT4_SPLIT
#define STEP_ODD(j)  do { BAR_DMA(); DMAK((j) + 1); DMAV(j); STEPA((int)SHM_K, B0, B1, A0, A1, alA); STEPB(0, B0, B1, alB, keepB); RESCALE(keepB, alB); } while (0)
#define STEP_EVEN(j) do { BAR_DMA(); DMAK((j) + 1); DMAV(j); STEPA(0, A0, A1, B0, B1, alB); STEPB((int)SHM_V, A0, A1, alA, keepA); RESCALE(keepA, alA); } while (0)
#else
#define DMAPTRS(j, KB, VB) const int tk_ = (j) + 1 < NT ? (j) + 1 : NT - 1; const char* kg_ = (const char*)Kh + (size_t)tk_ * (KVBLK * ldk * 2) + ksrc[0]; const char* vg_ = (const char*)Vh + (size_t)(j) * (KVBLK * ldv * 2) + vsrc[0]; \
    const unsigned kd_ = (unsigned)(uintptr_t)K_lds + (unsigned)(KB) + kdst[0], vd_ = (unsigned)(uintptr_t)V_lds + (unsigned)(VB) + vdst[0];
#define STEP_ODD(j)  do { if constexpr (!(STRIP & 32)) BAR_DMA(); DMAPTRS(j, 0, SHM_V) STEPU((int)SHM_K, 0, B0, B1, A0, A1, alA, alB, keepB); RESCALE(keepB, alB); } while (0)
#define STEP_EVEN(j) do { if constexpr (!(STRIP & 32)) BAR_DMA(); DMAPTRS(j, SHM_K, 0) STEPU(0, (int)SHM_V, A0, A1, B0, B1, alB, alA, keepA); RESCALE(keepA, alA); } while (0)
#endif
  if (ATT_PRIO == 2 && wid >= 4) __builtin_amdgcn_s_setprio(1);
  if (ATT_PRIO == 4 && wid < 4) __builtin_amdgcn_s_setprio(1);
  for (int j = 1; j < NT - 1; j += 2) { STEP_ODD(j); STEP_EVEN(j + 1); }
  STEP_ODD(NT - 1);
  __builtin_amdgcn_s_setprio(0);
  BAR_DMA();
  finishSM(B0, B1, alB, l_reg, pa0, pa1, pa2, pa3);
  pv_all<DV>(o, vb0 + (int)SHM_V, pa0, pa1, pa2, pa3);
  int lane2 = lane; asm volatile("" : "+v"(lane2)); const int r32e = lane2 & 31, hie = lane2 >> 5;
  if (hie == 0) li_l[r32e] = l_reg; asm volatile("s_waitcnt lgkmcnt(0)" ::: "memory");
  unsigned ooff = (unsigned)((wid * QBLK + 4 * hie) * ldo + r32e) * 2u;
  asm volatile("" : "+v"(ooff));
#pragma unroll
  for (int r = 0; r < 16; ++r) { const float rl = __builtin_amdgcn_rcpf(li_l[crow(r, hie)]);
    char* orow = (char*)Ob + (size_t)(((r & 3) + 8 * (r >> 2)) * ldo) * 2;
#pragma unroll
    for (int d0 = 0; d0 < DV / 32; ++d0) { if constexpr (STRIP & 1) { float t_ = o[d0][r] * rl; asm volatile("" :: "v"(t_)); } else *(bf16_t*)(orow + (ooff + d0 * 64)) = (bf16_t)(cvt_pk_bf16(o[d0][r] * rl, 0.f) & 0xffffu); }
    asm volatile("" ::: "memory"); }
  asm volatile("s_waitcnt vmcnt(0) lgkmcnt(0)\n\ts_barrier" ::: "memory");
#undef DMAK
#undef DMAV
#undef BAR_DMA
#undef RESCALE
#undef STEPARGS
#undef DMAPTRS
#undef STEPA
#undef STEPB
#undef STEPU
#undef STEP_ODD
#undef STEP_EVEN
}

template <int DK, int DV, int ldq, int ldk, int ldv, int ldo, int STRIP = 0>
__device__ __forceinline__ void attn_unit5(const bf16_t* __restrict__ Qb, const bf16_t* __restrict__ Kh, const bf16_t* __restrict__ Vh,
                                           bf16_t* __restrict__ Ob, int seq, char* lds) {
  constexpr float C = (DK == 96 ? 0.10206207261596577f : 0.08838834764831845f) * 1.4426950408889634f;
  constexpr float THRS = 8.0f * 1.4426950408889634f / C;
  constexpr int NVOP = DV / 64, SUP = 32768, SUB = 16384;
  const int tid = threadIdx.x, wid = __builtin_amdgcn_readfirstlane(tid >> 6), lane = tid & 63, r32 = lane & 31, hi = lane >> 5;
  char* V_lds = lds; char* K_lds = lds + 2 * SUP;
  float* ws = (float*)(lds + 4 * SUP + 4096) + wid * 64; float* li_l = ws; float* al_l = ws + 32;
  float m_reg = -1e30f, l_reg = 0; f32x16 o[DV / 32]; bf16x8 qr[DK / 16];
#pragma unroll
  for (int d = 0; d < DV / 32; ++d) o[d] = f32x16{};
  { const unsigned qoff = (unsigned)((wid * QBLK + r32) * ldq + hi * 8) * 2u;
#pragma unroll
    for (int d0 = 0; d0 < DK / 16; ++d0) qr[d0] = *reinterpret_cast<const bf16x8*>((const char*)Qb + (qoff + d0 * 32)); }
  unsigned ksrc0, vsrc0, kdst0, vdst0;
  { const int ch = wid, row = 4 * ch + (lane >> 4), pos = lane & 15; ksrc0 = (unsigned)(row * ldk * 2 + ((pos ^ (row & 15)) << 4)); kdst0 = (unsigned)(ch * 1024); }
  { const int ch = (DV == 64) ? 2 * wid : wid;
    const int ob = ch * 1024 + 16 * lane, st = ob >> 9, rem = ob & 511, kk = (st >> 2) * 8 + (rem >> 6), c = (st & 3) * 32 + ((rem & 63) >> 1);
    const int k = (kk & ~0xC) | ((kk & 4) << 1) | ((kk & 8) >> 1);
    vsrc0 = (unsigned)(k * ldv * 2 + c * 2); vdst0 = (unsigned)(ch * 1024); }
  const int vb0 = (int)(uintptr_t)V_lds + v_rd_base(lane);
  const unsigned kbase_ = (unsigned)(uintptr_t)K_lds + (unsigned)r32 * 256u;
  unsigned kad[DK / 16];
#pragma unroll
  for (int d0 = 0; d0 < DK / 16; ++d0) kad[d0] = kbase_ + (unsigned)(((2 * d0 + hi) ^ (r32 & 15)) << 4);
  const int NT = seq / KVBLK;
#define DMAK5(t, OFF) do { const int tn_ = (t) < NT ? (t) : NT - 1; const char* kt_ = (const char*)Kh + (size_t)tn_ * (KVBLK * ldk * 2) + ksrc0; \
    _Pragma("unroll") for (int q = 0; q < 2; ++q) __builtin_amdgcn_global_load_lds((const unsigned*)(kt_ + q * (32 * ldk * 2)), (LAS unsigned*)(K_lds + (OFF) + kdst0 + q * 8192), 16, 0, 0); } while (0)
#define DMAV5(t, OFF) do { const int tn_ = (t) < NT ? (t) : NT - 1; const char* vt_ = (const char*)Vh + (size_t)tn_ * (KVBLK * ldv * 2) + vsrc0; \
    _Pragma("unroll") for (int q = 0; q < NVOP; ++q) __builtin_amdgcn_global_load_lds((const unsigned*)(vt_ + q * (32 * ldv * 2)), (LAS unsigned*)(V_lds + (OFF) + vdst0 + q * 8192), 16, 0, 0); } while (0)
#define BAR_DMA() asm volatile("s_waitcnt vmcnt(0) lgkmcnt(0)\n\ts_barrier" ::: "memory")
#define RESCALE(keep_, al_) do { if (!(keep_)) { if (hi == 0) al_l[r32] = (al_); asm volatile("s_waitcnt lgkmcnt(0)" ::: "memory"); \
      _Pragma("unroll") for (int d = 0; d < DV / 32; ++d) _Pragma("unroll") for (int r = 0; r < 16; ++r) o[d][r] *= al_l[crow(r, hi)]; } } while (0)
  f32x16 A0, A1, B0, B1; bf16x8 pa0, pa1, pa2, pa3; float alA = 1.f, alB = 1.f; bool keepA = true, keepB = true;
#define STEPARGS(X0, X1, Y0, Y1, alY, alX, keepX) (X0, X1, Y0, Y1, alY, l_reg, pa0, pa1, pa2, pa3, o, kad, vb0, qr, m_reg, alX, keepX, C, THRS, kg_, vg_, kd_, vd_, (STRIP & 16) ? -1 : 32 * ldk * 2, 32 * ldv * 2)
#define STEPU(OFF, X0, X1, Y0, Y1, alY, alX, keepX) do { if constexpr (DK == 128) a4_step_128_128<OFF, OFF> STEPARGS(X0, X1, Y0, Y1, alY, alX, keepX); \
    else a4_step_96_64<OFF, OFF> STEPARGS(X0, X1, Y0, Y1, alY, alX, keepX); } while (0)
#define STEP5(j, OFF, DOFF, X0, X1, Y0, Y1, alY, alX, keepX) do { const int tk_ = (j) + 2 < NT ? (j) + 2 : NT - 1, tv_ = (j) + 1 < NT ? (j) + 1 : NT - 1; \
    const char* kg_ = (const char*)Kh + (size_t)tk_ * (KVBLK * ldk * 2) + ksrc0; const char* vg_ = (const char*)Vh + (size_t)tv_ * (KVBLK * ldv * 2) + vsrc0; \
    const unsigned kd_ = (unsigned)(uintptr_t)K_lds + (unsigned)(DOFF) + kdst0, vd_ = (unsigned)(uintptr_t)V_lds + (unsigned)(DOFF) + vdst0; \
    STEPU(OFF, X0, X1, Y0, Y1, alY, alX, keepX); RESCALE(keepX, alX); } while (0)
  DMAK5(0, 0); DMAK5(1, SUB); DMAV5(0, SUB);
  BAR_DMA();
  DMAK5(2, SUP); DMAV5(1, SUP);
  if constexpr (DK == 128) a4_stepA_128_first<0>(A0, A1, B0, B1, 1.f, l_reg, pa0, pa1, pa2, pa3, kad, qr);
  else a4_stepA_96_first<0>(A0, A1, B0, B1, 1.f, l_reg, pa0, pa1, pa2, pa3, kad, qr);
  a4_psm_plain(A0, A1, m_reg, alA, keepA, C, THRS);
  STEP5(1, SUB, SUP + SUB, B0, B1, A0, A1, alA, alB, keepB);
  for (int j = 2; j < NT - 2; j += 4) {
    if constexpr (!(STRIP & 32)) BAR_DMA();
    STEP5(j, SUP, 0, A0, A1, B0, B1, alB, alA, keepA);
    STEP5(j + 1, SUP + SUB, SUB, B0, B1, A0, A1, alA, alB, keepB);
    if constexpr (!(STRIP & 32)) BAR_DMA();
    STEP5(j + 2, 0, SUP, A0, A1, B0, B1, alB, alA, keepA);
    STEP5(j + 3, SUB, SUP + SUB, B0, B1, A0, A1, alA, alB, keepB);
  }
  BAR_DMA();
  STEP5(NT - 2, SUP, 0, A0, A1, B0, B1, alB, alA, keepA);
  STEP5(NT - 1, SUP + SUB, SUB, B0, B1, A0, A1, alA, alB, keepB);
  BAR_DMA();
  finishSM(B0, B1, alB, l_reg, pa0, pa1, pa2, pa3);
  pv_all<DV>(o, vb0, pa0, pa1, pa2, pa3);
  int lane2 = lane; asm volatile("" : "+v"(lane2)); const int r32e = lane2 & 31, hie = lane2 >> 5;
  if (hie == 0) li_l[r32e] = l_reg; asm volatile("s_waitcnt lgkmcnt(0)" ::: "memory");
  unsigned ooff = (unsigned)((wid * QBLK + 4 * hie) * ldo + r32e) * 2u;
  asm volatile("" : "+v"(ooff));
#pragma unroll
  for (int r = 0; r < 16; ++r) { const float rl = __builtin_amdgcn_rcpf(li_l[crow(r, hie)]);
    char* orow = (char*)Ob + (size_t)(((r & 3) + 8 * (r >> 2)) * ldo) * 2;
#pragma unroll
    for (int d0 = 0; d0 < DV / 32; ++d0) { if constexpr (STRIP & 1) { float t_ = o[d0][r] * rl; asm volatile("" :: "v"(t_)); } else *(bf16_t*)(orow + (ooff + d0 * 64)) = (bf16_t)(cvt_pk_bf16(o[d0][r] * rl, 0.f) & 0xffffu); }
    asm volatile("" ::: "memory"); }
  asm volatile("s_waitcnt vmcnt(0) lgkmcnt(0)\n\ts_barrier" ::: "memory");
#undef DMAK5
#undef DMAV5
#undef BAR_DMA
#undef RESCALE
#undef STEPARGS
#undef STEPU
#undef STEP5
}
#undef KSWZ
#undef SBAR
}

struct Params { const float* in[23]; float* out; unsigned char* ws; int ph_lo, ph_hi, bar_region, use_cg; };
enum { IN_X = 0, IN_C, IN_CTX, IN_CCTX, IN_ADAW, IN_ADAB, IN_NORM1, IN_NORM2, IN_ABWIN, IN_ABQN, IN_ABWUQ, IN_ABKVN, IN_ABWUKV, IN_ABWO, IN_CWIN, IN_CQG, IN_CKG, IN_CWO, IN_ROUTER, IN_WG, IN_WU, IN_WD, IN_FNORM };
constexpr int NPH = 20;
#define LDS_WAIT() asm volatile("s_waitcnt lgkmcnt(0)" ::: "memory")

__device__ __forceinline__ void transpose_item(const float* W, int ldw, bf16_t* WT, int ldt, const float* kscale, LAS float* scr, int lane) {
#pragma unroll 8
  for (int i = 0; i < 32; ++i) { const int kk = 2 * i + (lane >> 5); float v = W[(size_t)kk * ldw + (lane & 31)]; if (kscale) v *= kscale[kk]; scr[kk * 33 + (lane & 31)] = v; }
  LDS_WAIT(); asm volatile("" ::: "memory");
  const int c = lane & 7;
#pragma unroll
  for (int j = 0; j < 4; ++j) { const int n = (lane >> 3) + 8 * j; const LAS float* s = scr + (8 * c) * 33 + n;
    u32x4 o; o.x = cvt_pk_bf16(s[0 * 33], s[1 * 33]); o.y = cvt_pk_bf16(s[2 * 33], s[3 * 33]); o.z = cvt_pk_bf16(s[4 * 33], s[5 * 33]); o.w = cvt_pk_bf16(s[6 * 33], s[7 * 33]);
    *(u32x4*)(WT + (size_t)n * ldt + 8 * c) = o; }
  LDS_WAIT(); asm volatile("" ::: "memory");
}
__device__ __forceinline__ void transpose_item8(const float* W, int ldw, unsigned char* WT, int ldt, LAS float* scr, int lane) {
#pragma unroll 8
  for (int i = 0; i < 32; ++i) { const int kk = 2 * i + (lane >> 5); scr[kk * 33 + (lane & 31)] = W[(size_t)kk * ldw + (lane & 31)] * W8_SCALE; }
  LDS_WAIT(); asm volatile("" ::: "memory");
#pragma unroll
  for (int u = 0; u < 2; ++u) { const int p = lane + 64 * u, n = p >> 2, c = p & 3; const LAS float* s = scr + (16 * c) * 33 + n;
    u32x4 o; o.x = pack4_fp8(s[0 * 33], s[1 * 33], s[2 * 33], s[3 * 33]); o.y = pack4_fp8(s[4 * 33], s[5 * 33], s[6 * 33], s[7 * 33]);
    o.z = pack4_fp8(s[8 * 33], s[9 * 33], s[10 * 33], s[11 * 33]); o.w = pack4_fp8(s[12 * 33], s[13 * 33], s[14 * 33], s[15 * 33]);
    *(u32x4*)(WT + (size_t)n * ldt + 16 * c) = o; }
  LDS_WAIT(); asm volatile("" ::: "memory");
}
#ifndef MOE_FP8
#define MOE_FP8 1
#endif
__device__ __forceinline__ void moe_item(const Params& P, int r, LAS float* scr, int lane) {
  unsigned char* ws = P.ws;
  const int le = r / 3072, q = r % 3072, which = q >> 10, t = q & 1023;
  if (which < 2) { const int kb = t >> 6, nb = t & 63, n0 = nb * 32;
    const float* src = P.in[which == 0 ? IN_WG : IN_WU] + (size_t)le * 1024 * 2048 + (size_t)kb * 64 * 2048 + n0;
    const size_t doff = (size_t)le * 4096 * 1024 + (size_t)((n0 >> 7) * 256 + which * 128 + (n0 & 127)) * 1024 + kb * 64;
    if (MOE_FP8) transpose_item8(src, 2048, ws + WS_WGU + doff, 1024, scr, lane); else transpose_item(src, 2048, (bf16_t*)(ws + WS_WGU) + doff, 1024, nullptr, scr, lane);
  } else { const int kb = t >> 5, nb = t & 31;
    const float* src = P.in[IN_WD] + (size_t)le * 2048 * 1024 + (size_t)kb * 64 * 1024 + nb * 32;
    const size_t doff = (size_t)le * 1024 * 2048 + (size_t)nb * 32 * 2048 + kb * 64;
    if (MOE_FP8) transpose_item8(src, 1024, ws + WS_WD + doff, 2048, scr, lane); else transpose_item(src, 1024, (bf16_t*)(ws + WS_WD) + doff, 2048, nullptr, scr, lane);
  }
}
#ifndef FQ_GEMM
#define FQ_GEMM 64
#endif
#ifndef FQ_TOPK
#define FQ_TOPK 44
#endif
constexpr int FS_NWG[7] = {248, 248, 192, 192, 116, 224, 124};
constexpr int FS_QUOTA[7] = {FQ_GEMM, FQ_GEMM, FQ_TOPK, FQ_GEMM, FQ_GEMM, FQ_TOPK, FQ_GEMM};
constexpr int FS_L0 = FS_NWG[0] * FS_QUOTA[0] + FS_NWG[1] * FS_QUOTA[1] + FS_NWG[2] * FS_QUOTA[2];
constexpr int FS_L1 = FS_NWG[3] * FS_QUOTA[3] + FS_NWG[4] * FS_QUOTA[4] + FS_NWG[5] * FS_QUOTA[5] + FS_NWG[6] * FS_QUOTA[6];
static_assert(FS_L0 <= 49152 && FS_L1 <= 49152, "filler quotas");
__device__ __forceinline__ int fs_base(int s) {
  int b = s < 3 ? 0 : 49152;
  for (int q = (s < 3 ? 0 : 3); q < s; ++q) b += FS_NWG[q] * FS_QUOTA[q];
  return b;
}
__device__ __forceinline__ void filler(const Params& P, LAS unsigned char* lds, int s, int f, int lane, int wave) {
  LAS float* scr = (LAS float*)(lds + wave * 16384);
  const int base = fs_base(s), nwg = FS_NWG[s], quota = FS_QUOTA[s];
  for (int k = wave; k < quota; k += NWAVES) moe_item(P, base + f + k * nwg, scr, lane);
}
constexpr int GEMV_ITEMS = 2 * 16 * 24;
constexpr int MOE_ITEMS = 2 * 16 * 3072;
constexpr int SM_WIN0 = 16 * 29, SM_WUQ = 4 * 24, SM_WUKV = 2 * 32, SM_WO = 16 * 32, SM_WIN1 = 16 * 48;
constexpr int SMALL_ITEMS = SM_WIN0 + SM_WUQ + SM_WUKV + SM_WO + SM_WIN1 + SM_WO;
__device__ __forceinline__ void p0_prologue(const Params& P, LAS unsigned char* lds, int gw, int NGW, int lane, int wave, bool skip_gemv = false) {
  unsigned char* ws = P.ws;
  float* MOD = (float*)(ws + WS_CTL) + CW_MOD;
  LAS float* scr = (LAS float*)(lds + wave * 16384);
  for (int it = gw; it < GEMV_ITEMS + SM_WIN0 + SM_WUQ + SM_WUKV; it += NGW) {
    if (it < GEMV_ITEMS) {
      if (skip_gemv) continue;
      const int l = it / 384, r0 = it % 384, kc = r0 / 24, nc = r0 % 24, k0 = kc * 64, n = nc * 256 + 4 * lane;
      const float s0 = siluf(P.in[IN_C][k0 + lane]), s1 = siluf(P.in[IN_C][1024 + k0 + lane]), s2 = siluf(P.in[IN_CCTX][k0 + lane]);
      const float* w = P.in[IN_ADAW] + ((size_t)l * 1024 + k0) * 6144 + n;
      f32x4 a0 = {0.f, 0.f, 0.f, 0.f}, a1 = a0, a2 = a0;
#pragma unroll 8
      for (int kk = 0; kk < 64; ++kk) { const f32x4 wv = *(const f32x4*)(w + (size_t)kk * 6144);
        a0 += wv * __shfl(s0, kk); a1 += wv * __shfl(s1, kk); a2 += wv * __shfl(s2, kk); }
      float* part = (float*)(ws + WS_MODP) + ((size_t)(l * 24 + nc) * 16) * 768 + 4 * lane;
      { float* pp = part + (size_t)kc * 768; *(f32x4*)pp = a0; *(f32x4*)(pp + 256) = a1; *(f32x4*)(pp + 512) = a2; }
      __threadfence();
      unsigned old = 0u; if (lane == 0) old = atomicAdd((unsigned*)(ws + WS_CTL) + CW_CNT + 64 * (l * 24 + nc), 1u);
      old = __builtin_amdgcn_readfirstlane(old);
      if (old == 15u) {
        __threadfence();
        const f32x4 bv = *(const f32x4*)(P.in[IN_ADAB] + l * 6144 + n); f32x4 t0 = bv, t1 = bv, t2 = bv;
#pragma unroll 4
        for (int q = 0; q < 16; ++q) { const float* pp = part + (size_t)q * 768; t0 += *(const f32x4*)pp; t1 += *(const f32x4*)(pp + 256); t2 += *(const f32x4*)(pp + 512); }
        float* m0 = MOD + (size_t)(l * 3) * 6144 + n;
        *(f32x4*)m0 = t0; *(f32x4*)(m0 + 6144) = t1; *(f32x4*)(m0 + 2 * 6144) = t2;
      }
      continue;
    }
    int r = it - GEMV_ITEMS;
    if (r < SM_WIN0) { const int kb = r / 29, nb = r % 29; transpose_item(P.in[IN_ABWIN] + (size_t)kb * 64 * 928 + nb * 32, 928, (bf16_t*)(ws + WS_WIN0) + (size_t)nb * 32 * 1024 + kb * 64, 1024, nullptr, scr, lane); continue; } r -= SM_WIN0;
    if (r < SM_WUQ) { const int kb = r / 24, nb = r % 24; transpose_item(P.in[IN_ABWUQ] + (size_t)kb * 64 * 768 + nb * 32, 768, (bf16_t*)(ws + WS_WUQ) + (size_t)nb * 32 * 256 + kb * 64, 256, P.in[IN_ABQN] + kb * 64, scr, lane); continue; } r -= SM_WUQ;
    { const int kb = r / 32, nb = r % 32; transpose_item(P.in[IN_ABWUKV] + (size_t)kb * 64 * 1024 + nb * 32, 1024, (bf16_t*)(ws + WS_WUKV) + (size_t)nb * 32 * 256 + 128 + kb * 64, 256, P.in[IN_ABKVN] + kb * 64, scr, lane); }
  }
  const bool fill = NGW == 2048;
  const int nrest = fill ? (49152 - FS_L0) + (49152 - FS_L1) : MOE_ITEMS;
  for (int it = gw; it < SM_WO + SM_WIN1 + SM_WO + nrest; it += NGW) {
    int r = it;
    if (r < SM_WO) { const int kb = r / 32, nb = r % 32; transpose_item(P.in[IN_ABWO] + (size_t)kb * 64 * 1024 + nb * 32, 1024, (bf16_t*)(ws + WS_WO0) + (size_t)nb * 32 * 1024 + kb * 64, 1024, nullptr, scr, lane); continue; } r -= SM_WO;
    if (r < SM_WIN1) { const int kb = r / 48, nb = r % 48; transpose_item(P.in[IN_CWIN] + (size_t)kb * 64 * 1536 + nb * 32, 1536, (bf16_t*)(ws + WS_WIN1) + (size_t)nb * 32 * 1024 + kb * 64, 1024, nullptr, scr, lane); continue; } r -= SM_WIN1;
    if (r < SM_WO) { const int kb = r / 32, nb = r % 32; transpose_item(P.in[IN_CWO] + (size_t)kb * 64 * 1024 + nb * 32, 1024, (bf16_t*)(ws + WS_WO1) + (size_t)nb * 32 * 1024 + kb * 64, 1024, nullptr, scr, lane); continue; } r -= SM_WO;
    moe_item(P, !fill ? r : r < 49152 - FS_L0 ? FS_L0 + r : 49152 + FS_L1 + (r - (49152 - FS_L0)), scr, lane);
  }
  const int NT_ = NGW * 64;
  for (int g = gw * 64 + lane; g < 1024 + 4096 + 65536 + 12288 + 16384; g += NT_) {
    int q = g;
    if (q < 1024) { const int pos = q >> 3, i = q & 7; const float inv = powf(10000.f, -(float)i / 8.f); float s, c; sincos_acc((double)((float)pos * inv), s, c); ((f32x2*)(ws + WS_ROPEA))[q] = (f32x2){c, s}; continue; } q -= 1024;
    if (q < 4096) { const int pos = q >> 5, i = q & 31; const float inv = powf(10000.f, -(float)i / 32.f); float s, c; sincos_acc((double)((float)pos * inv), s, c); ((f32x2*)(ws + WS_ROPEC))[q] = (f32x2){c, s}; continue; } q -= 4096;
    if (q < 65536) {
      const int n = q >> 7, k0 = (q & 127) * 8; u32x4 o = {0u, 0u, 0u, 0u};
      if ((k0 >> 8) == (n >> 7)) { const int cp = n & 127, c0 = (k0 & 255) >> 1; float sv[4], cv[4];
#pragma unroll
        for (int j = 0; j < 4; ++j) sincos_acc(6.283185307179586476925 * (double)(((c0 + j) * cp) & 127) / 128.0, sv[j], cv[j]);
        o.x = cvt_pk_bf16(cv[0], sv[0]); o.y = cvt_pk_bf16(cv[1], sv[1]); o.z = cvt_pk_bf16(cv[2], sv[2]); o.w = cvt_pk_bf16(cv[3], sv[3]); }
      *(u32x4*)((bf16_t*)(ws + WS_WDFT) + (size_t)n * 1024 + k0) = o; continue; } q -= 65536;
    if (q < 12288) { *(u32x4*)((bf16_t*)(ws + WS_WIN0) + (size_t)928 * 1024 + (size_t)q * 8) = (u32x4){0u, 0u, 0u, 0u}; continue; } q -= 12288;
    { const int n = q >> 4, k0 = (q & 15) * 8; *(u32x4*)((bf16_t*)(ws + WS_WUKV) + (size_t)n * 256 + k0) = (u32x4){0u, 0u, 0u, 0u}; }
  }
}

__device__ __forceinline__ int mod_row(int row) { return (row % T) < L ? 2 : row / T; }
__device__ __forceinline__ void modulate4(f32x4 (&y)[4], const f32x4 (&v)[4], float rstd, const float* g, const float* sh, const float* sc, int lane) {
#pragma unroll
  for (int j = 0; j < 4; ++j) { const int o = 256 * j + 4 * lane; const f32x4 gv = *(const f32x4*)(g + o), sv = *(const f32x4*)(sh + o), cv = *(const f32x4*)(sc + o);
    y[j] = v[j] * rstd * gv * (1.f + cv) + sv; }
}
__device__ __forceinline__ void store_bf16_row(bf16_t* orow, const f32x4 (&y)[4], int lane) {
#pragma unroll
  for (int j = 0; j < 4; ++j) { u32x2 w; w.x = cvt_pk_bf16(y[j][0], y[j][1]); w.y = cvt_pk_bf16(y[j][2], y[j][3]); *(u32x2*)(orow + 256 * j + 4 * lane) = w; }
}
__device__ __forceinline__ float sumsq4(const f32x4 (&v)[4]) {
  float s = 0.f;
#pragma unroll
  for (int j = 0; j < 4; ++j) s += (v[j][0] * v[j][0] + v[j][1] * v[j][1]) + (v[j][2] * v[j][2] + v[j][3] * v[j][3]);
  return wave_sum(s);
}
__device__ __forceinline__ void phase_r0(const Params& P, int gw, int NGW, int lane) {
  float* H = (float*)(P.ws + WS_H); bf16_t* XN = (bf16_t*)(P.ws + WS_XN); const float* MOD = (const float*)(P.ws + WS_CTL) + CW_MOD;
  auto srcp = [&](int row) { const int b = row / T, i = row % T; return i < L ? P.in[IN_CTX] + ((size_t)b * L + i) * D : P.in[IN_X] + ((size_t)b * S + (i - L)) * D; };
  f32x4 v[4], vn[4];
  if (gw < M) { const float* s = srcp(gw);
#pragma unroll
    for (int j = 0; j < 4; ++j) v[j] = *(const f32x4*)(s + 256 * j + 4 * lane); }
#pragma unroll 1
  for (int row = gw; row < M; row += NGW) {
    const int nrow = row + NGW < M ? row + NGW : row;
    { const float* s = srcp(nrow);
#pragma unroll
      for (int j = 0; j < 4; ++j) vn[j] = *(const f32x4*)(s + 256 * j + 4 * lane); }
    f32x4 y[4];
    const float rstd = rsqrtf(sumsq4(v) * (1.f / D) + EPS);
    const float* mr = MOD + (size_t)mod_row(row) * 6144;
    modulate4(y, v, rstd, P.in[IN_NORM1], mr, mr + 1024, lane);
    store_bf16_row(XN + (size_t)row * D, y, lane);
#pragma unroll
    for (int j = 0; j < 4; ++j) v[j] = vn[j];
  }
}
__device__ __forceinline__ int lane_expert(int lane) { return ((lane >> 5) & 1) * 8 + ((lane >> 4) & 1) * 4 + ((lane >> 3) & 1) * 2 + ((lane >> 2) & 1); }
__device__ __forceinline__ float router_reduce(float (&p)[16], int lane) {
  float q[8], r[4], s[2], t;
  { const bool up = lane & 32;
#pragma unroll
    for (int i = 0; i < 8; ++i) { const float snd = up ? p[i] : p[i + 8], kp = up ? p[i + 8] : p[i]; q[i] = kp + __shfl_xor(snd, 32); } }
  { const bool up = lane & 16;
#pragma unroll
    for (int i = 0; i < 4; ++i) { const float snd = up ? q[i] : q[i + 4], kp = up ? q[i + 4] : q[i]; r[i] = kp + __shfl_xor(snd, 16); } }
  { const bool up = lane & 8;
#pragma unroll
    for (int i = 0; i < 2; ++i) { const float snd = up ? r[i] : r[i + 2], kp = up ? r[i + 2] : r[i]; s[i] = kp + __shfl_xor(snd, 8); } }
  { const bool up = lane & 4; const float snd = up ? s[0] : s[1], kp = up ? s[1] : s[0]; t = kp + __shfl_xor(snd, 4); }
  t += __shfl_xor(t, 2); t += __shfl_xor(t, 1);
  float mx = t;
#pragma unroll
  for (int o = 4; o < 64; o <<= 1) mx = fmaxf(mx, __shfl_xor(mx, o));
  const float ex = expf(t - mx); float sm = ex;
#pragma unroll
  for (int o = 4; o < 64; o <<= 1) sm += __shfl_xor(sm, o);
  return ex / sm;
}
__device__ __forceinline__ void router_aff2(const f32x4 (&ya)[4], const f32x4 (&yb)[4], const LAS float* WrT, int lane, float& aa, float& ab) {
  asm volatile("" : "+v"(lane));
  float pa[16], pb[16];
#pragma unroll
  for (int e = 0; e < 16; ++e) { float a = 0.f, b = 0.f;
#pragma unroll
    for (int j = 0; j < 4; ++j) { const f32x4 w = *(const LAS f32x4*)(WrT + e * 1024 + 256 * j + 4 * lane);
      a += (ya[j][0] * w[0] + ya[j][1] * w[1]) + (ya[j][2] * w[2] + ya[j][3] * w[3]); b += (yb[j][0] * w[0] + yb[j][1] * w[1]) + (yb[j][2] * w[2] + yb[j][3] * w[3]); }
    pa[e] = a; pb[e] = b; }
  aa = router_reduce(pa, lane); ab = router_reduce(pb, lane);
}
__device__ __forceinline__ void phase_router(const Params& P, LAS unsigned char* lds, int layer, int gw, int NGW, int lane) {
  const float* H = (const float*)(P.ws + WS_H); bf16_t* XN = (bf16_t*)(P.ws + WS_XN); const float* MOD = (const float*)(P.ws + WS_CTL) + CW_MOD + layer * 3 * 6144;
  float* AFFL = (float*)(P.ws + WS_AFFL); float* AFFC = (float*)(P.ws + WS_AFFC); int* INV = (int*)(P.ws + WS_INV);
  LAS float* WrT = (LAS float*)lds;
  { const float* Wr = P.in[IN_ROUTER] + (size_t)layer * D * 16;
    for (int q = threadIdx.x; q < D * 4; q += NTHR) { const int d = q >> 2, e4 = (q & 3) * 4; const f32x4 w = *(const f32x4*)(Wr + d * 16 + e4);
#pragma unroll
      for (int t = 0; t < 4; ++t) WrT[(e4 + t) * 1024 + d] = w[t]; }
    __syncthreads(); }
  const float* g = P.in[IN_NORM2] + layer * D;
  const int NR = layer == 1 ? NB * S : M;
  auto rowof = [&](int r) { return layer == 1 ? (r / S) * T + L + (r % S) : r; };
  f32x4 vA[4], vB[4], nA[4], nB[4];
  auto ldrow = [&](int r, f32x4 (&v)[4]) { const int row = rowof(r < NR ? r : NR - 1);
#pragma unroll
    for (int j = 0; j < 4; ++j) v[j] = *(const f32x4*)(H + (size_t)row * D + 256 * j + 4 * lane); };
  auto modrow = [&](int r, const f32x4 (&v)[4], f32x4 (&y)[4]) {
    const int row = rowof(r), b = row / T, i = row % T;
    const float rstd = rsqrtf(sumsq4(v) * (1.f / D) + EPS);
    const float* mr = MOD + (size_t)(i < L ? 2 : b) * 6144;
    modulate4(y, v, rstd, g, mr + 3 * 1024, mr + 4 * 1024, lane);
    if (!MOE_FP8) store_bf16_row(XN + (size_t)row * D, y, lane);
    if (MOE_FP8) {
#pragma unroll
      for (int j = 0; j < 4; ++j) *(unsigned*)(P.ws + WS_XN8 + (size_t)row * D + 256 * j + 4 * lane) = pack4_fp8(y[j][0], y[j][1], y[j][2], y[j][3]);
    } };
  auto putaff = [&](int r, float a) { const int row = rowof(r), b = row / T, i = row % T;
    if ((lane & 3) == 0) { const int e = lane_expert(lane); if (i < L) AFFC[((size_t)b * 16 + e) * L + i] = a; else AFFL[((size_t)b * 16 + e) * S + (i - L)] = a; }
    if (lane < 16) INV[(size_t)row * 16 + lane] = -1; };
  if (gw < NR) { ldrow(gw, vA); ldrow(gw + NGW, vB); }
#pragma unroll 1
  for (int r = gw; r < NR; r += 2 * NGW) {
    const bool hasB = r + NGW < NR;
    ldrow(r + 2 * NGW, nA); ldrow(r + 3 * NGW, nB);
    f32x4 yA[4], yB[4]; float aA, aB;
    modrow(r, vA, yA);
    if (hasB) modrow(r + NGW, vB, yB); else {
#pragma unroll
      for (int j = 0; j < 4; ++j) yB[j] = yA[j]; }
    router_aff2(yA, yB, WrT, lane, aA, aB);
    putaff(r, aA); if (hasB) putaff(r + NGW, aB);
#pragma unroll
    for (int j = 0; j < 4; ++j) { vA[j] = nA[j]; vB[j] = nB[j]; }
  }
}
__device__ __forceinline__ void phase_combine(const Params& P, int layer, int gw, int NGW, int lane) {
  float* H = (float*)(P.ws + WS_H); bf16_t* XN = (bf16_t*)(P.ws + WS_XN); const float* MODL = (const float*)(P.ws + WS_CTL) + CW_MOD + layer * 3 * 6144;
  const int* INV = (const int*)(P.ws + WS_INV); const float* GATE = (const float*)(P.ws + WS_GATE); const bf16_t* Y2 = (const bf16_t*)(P.ws + WS_Y2);
  const int NR = layer == 1 ? NB * S : M;
  auto rowof = [&](int r) { return layer == 1 ? (r / S) * T + L + (r % S) : r; };
  f32x4 hA[4], hB[4], nA[4], nB[4]; int peA = -1, peB = -1, pnA, pnB;
  auto ldrow = [&](int r, f32x4 (&h)[4], int& pe) { const int row = rowof(r < NR ? r : NR - 1); pe = INV[(size_t)row * 16 + (lane & 15)];
#pragma unroll
    for (int j = 0; j < 4; ++j) h[j] = *(const f32x4*)(H + (size_t)row * D + 256 * j + 4 * lane); };
  auto finish = [&](int r, f32x4 (&hv)[4], const f32x4 (&acc)[4]) {
    const int row = rowof(r), b = row / T, i = row % T;
    const float* mr = MODL + (size_t)(i < L ? 2 : b) * 6144 + 5 * 1024;
#pragma unroll
    for (int j = 0; j < 4; ++j) hv[j] += *(const f32x4*)(mr + 256 * j + 4 * lane) * acc[j];
    const float rstd = rsqrtf(sumsq4(hv) * (1.f / D) + EPS);
    if (layer == 0) {
#pragma unroll
      for (int j = 0; j < 4; ++j) *(f32x4*)(H + (size_t)row * D + 256 * j + 4 * lane) = hv[j];
      f32x4 y[4]; const float* m1 = MODL + 3 * 6144 + (size_t)(i < L ? 2 : b) * 6144;
      modulate4(y, hv, rstd, P.in[IN_NORM1] + D, m1, m1 + 1024, lane);
      store_bf16_row(XN + (size_t)row * D, y, lane);
    } else {
      float* o = P.out + ((size_t)b * S + (i - L)) * D;
#pragma unroll
      for (int j = 0; j < 4; ++j) *(f32x4*)(o + 256 * j + 4 * lane) = hv[j] * rstd * *(const f32x4*)(P.in[IN_FNORM] + 256 * j + 4 * lane);
    }
  };
  if (gw < NR) { ldrow(gw, hA, peA); ldrow(gw + NGW, hB, peB); }
#pragma unroll 1
  for (int r = gw; r < NR; r += 2 * NGW) {
    const bool hasB = r + NGW < NR;
    ldrow(r + 2 * NGW, nA, pnA); ldrow(r + 3 * NGW, nB, pnB);
    f32x4 aA[4], aB[4];
#pragma unroll
    for (int j = 0; j < 4; ++j) { aA[j] = (f32x4){0.f, 0.f, 0.f, 0.f}; aB[j] = (f32x4){0.f, 0.f, 0.f, 0.f}; }
#pragma unroll
    for (int e = 0; e < 16; ++e) {
      const int pa = __builtin_amdgcn_readlane(peA, e), pb = hasB ? __builtin_amdgcn_readlane(peB, e) : -1;
      u32x2 wa[4], wb[4]; float ga = 0.f, gb = 0.f;
      if (pa >= 0) { ga = GATE[pa];
#pragma unroll
        for (int j = 0; j < 4; ++j) wa[j] = *(const u32x2*)(Y2 + (size_t)pa * D + 256 * j + 4 * lane); }
      if (pb >= 0) { gb = GATE[pb];
#pragma unroll
        for (int j = 0; j < 4; ++j) wb[j] = *(const u32x2*)(Y2 + (size_t)pb * D + 256 * j + 4 * lane); }
      if (pa >= 0) {
#pragma unroll
        for (int j = 0; j < 4; ++j) { aA[j][0] += ga * bflo(wa[j].x); aA[j][1] += ga * bfhi(wa[j].x); aA[j][2] += ga * bflo(wa[j].y); aA[j][3] += ga * bfhi(wa[j].y); } }
      if (pb >= 0) {
#pragma unroll
        for (int j = 0; j < 4; ++j) { aB[j][0] += gb * bflo(wb[j].x); aB[j][1] += gb * bfhi(wb[j].x); aB[j][2] += gb * bflo(wb[j].y); aB[j][3] += gb * bfhi(wb[j].y); } }
    }
    finish(r, hA, aA);
    if (hasB) finish(r + NGW, hB, aB);
    peA = pnA; peB = pnB;
#pragma unroll
    for (int j = 0; j < 4; ++j) { hA[j] = nA[j]; hB[j] = nB[j]; }
  }
}
__device__ __forceinline__ void phase_qkpost(const Params& P, int gw, int NGW, int lane) {
  const bf16_t* QKR = (const bf16_t*)(P.ws + WS_QKR); bf16_t* Q = (bf16_t*)(P.ws + WS_Q); bf16_t* Kb = (bf16_t*)(P.ws + WS_K); const f32x2* ropeC = (const f32x2*)(P.ws + WS_ROPEC);
  const float gq1 = P.in[IN_CQG][lane], gq2 = P.in[IN_CQG][64 + lane], gk1 = P.in[IN_CKG][lane], gk2 = P.in[IN_CKG][64 + lane];
  float v1[10], v2[10], n1_[10], n2_[10];
  if (gw < M) {
#pragma unroll
    for (int s = 0; s < 10; ++s) { v1[s] = bf2f(QKR[(size_t)gw * 1280 + s * 128 + lane]); v2[s] = bf2f(QKR[(size_t)gw * 1280 + s * 128 + 64 + lane]); } }
#pragma unroll 1
  for (int row = gw; row < M; row += NGW) {
    const int nrow = row + NGW < M ? row + NGW : row;
#pragma unroll
    for (int s = 0; s < 10; ++s) { n1_[s] = bf2f(QKR[(size_t)nrow * 1280 + s * 128 + lane]); n2_[s] = bf2f(QKR[(size_t)nrow * 1280 + s * 128 + 64 + lane]); }
    const int i = row % T; const bool lat = i >= L; const int sp = i - L;
    f32x2 cs1 = {1.f, 0.f}, cs2 = {1.f, 0.f};
    if (lat) { cs1 = ropeC[(sp >> 6) * 32 + (lane & 31)]; cs2 = ropeC[(sp & 63) * 32 + (lane & 31)]; }
#pragma unroll
    for (int slot = 0; slot < 10; ++slot) {
      if (slot < 8 && !lat) continue;
      const float a1 = v1[slot], a2 = v2[slot];
      const float rstd = rsqrtf(wave_sum(a1 * a1 + a2 * a2) * (1.f / 128.f) + EPS);
      const float m1 = a1 * rstd * (slot < 8 ? gq1 : gk1), m2 = a2 * rstd * (slot < 8 ? gq2 : gk2);
      const float p1 = __shfl_xor(m1, 32), p2 = __shfl_xor(m2, 32);
      const float o1 = lat ? ((lane < 32) ? m1 * cs1.x - p1 * cs1.y : p1 * cs1.y + m1 * cs1.x) : m1;
      const float o2 = lat ? ((lane < 32) ? m2 * cs2.x - p2 * cs2.y : p2 * cs2.y + m2 * cs2.x) : m2;
      bf16_t* dst = slot < 8 ? Q + (size_t)row * 1024 + slot * 128 : Kb + (size_t)row * 256 + (slot - 8) * 128;
      dst[lane] = (bf16_t)(cvt_pk_bf16(o1, 0.f) & 0xffffu); dst[64 + lane] = (bf16_t)(cvt_pk_bf16(o2, 0.f) & 0xffffu);
    }
#pragma unroll
    for (int s = 0; s < 10; ++s) { v1[s] = n1_[s]; v2[s] = n2_[s]; }
  }
}

__device__ __forceinline__ void topk_problem(const float* vals, int N, int cap, int row_base, int pbase, int e, int* IDX, float* GATE, int* INV, LAS unsigned* hist, LAS unsigned* misc) {
  const int tid = threadIdx.x, lane = tid & 63, wave = tid >> 6; const bool act = 16 * tid < N;
  unsigned v[16];
#pragma unroll
  for (int q = 0; q < 4; ++q) { u32x4 w = {0u, 0u, 0u, 0u}; if (act) w = *(const u32x4*)(vals + 16 * tid + 4 * q); v[4 * q] = w.x; v[4 * q + 1] = w.y; v[4 * q + 2] = w.z; v[4 * q + 3] = w.w; }
  unsigned prefix = 0u, pmask = 0u; int krem = cap;
#pragma unroll 1
  for (int pass = 0; pass < 4; ++pass) {
    const int shift = 24 - 8 * pass;
    if (tid < 256) hist[tid] = 0u;
    __syncthreads();
    if (act) {
#pragma unroll
      for (int i = 0; i < 16; ++i) if ((v[i] & pmask) == prefix) atomicAdd((unsigned*)(hist + ((v[i] >> shift) & 255u)), 1u);
    }
    __syncthreads();
    if (wave == 0) {
      const unsigned a0 = hist[255 - 4 * lane], a1 = hist[254 - 4 * lane], a2 = hist[253 - 4 * lane], a3 = hist[252 - 4 * lane];
      const int c0 = (int)a0, c1 = c0 + (int)a1, c2 = c1 + (int)a2, c3 = c2 + (int)a3;
      int incl = c3;
#pragma unroll
      for (int o = 1; o < 64; o <<= 1) { const int t = __shfl_up(incl, o); if (lane >= o) incl += t; }
      const int excl = incl - c3;
      if (excl < krem && krem <= incl) {
        const int j = (excl + c0 >= krem) ? 0 : (excl + c1 >= krem) ? 1 : (excl + c2 >= krem) ? 2 : 3;
        const int above = excl + (j == 0 ? 0 : j == 1 ? c0 : j == 2 ? c1 : c2);
        misc[0] = (unsigned)(255 - 4 * lane - j); misc[1] = (unsigned)(krem - above);
      }
    }
    __syncthreads();
    prefix |= misc[0] << shift; pmask |= 255u << shift; krem = (int)misc[1];
    __syncthreads();
  }
  int ngt = 0, neq = 0;
  if (act) {
#pragma unroll
    for (int i = 0; i < 16; ++i) { ngt += v[i] > prefix ? 1 : 0; neq += v[i] == prefix ? 1 : 0; }
  }
  int packed = ngt | (neq << 16), incl = packed;
#pragma unroll
  for (int o = 1; o < 64; o <<= 1) { const int t = __shfl_up(incl, o); if (lane >= o) incl += t; }
  if (lane == 63) misc[2 + wave] = (unsigned)incl;
  __syncthreads();
  int wpre = 0;
#pragma unroll
  for (int w = 0; w < 8; ++w) if (w < wave) wpre += (int)misc[2 + w];
  const int excl = wpre + incl - packed, gt_before = excl & 0xffff, eq_before = excl >> 16;
  if (act) {
    int slot = gt_before + (eq_before < krem ? eq_before : krem), eqi = eq_before;
#pragma unroll
    for (int i = 0; i < 16; ++i) {
      bool sel = v[i] > prefix;
      if (v[i] == prefix) { sel = eqi < krem; ++eqi; }
      if (sel) { const int row = row_base + 16 * tid + i; IDX[pbase + slot] = row; GATE[pbase + slot] = __uint_as_float(v[i]); INV[(size_t)row * 16 + e] = pbase + slot; ++slot; }
    }
  }
  __syncthreads();
}
__device__ __forceinline__ void phase_topk(const Params& P, LAS unsigned char* lds, int layer, int G) {
  const float* AFFL = (const float*)(P.ws + WS_AFFL); const float* AFFC = (const float*)(P.ws + WS_AFFC);
  int* IDX = (int*)(P.ws + WS_IDX); float* GATE = (float*)(P.ws + WS_GATE); int* INV = (int*)(P.ws + WS_INV);
  LAS unsigned* hist = (LAS unsigned*)(lds + LDS_TAB); LAS unsigned* misc = hist + 256;
  const int nprob = layer == 0 ? 64 : 32;
  for (int id = blockIdx.x; id < nprob; id += G) {
    const int ty = id >> 5, b = (id >> 4) & 1, e = id & 15;
    if (ty == 0) topk_problem(AFFL + ((size_t)b * 16 + e) * S, S, CAPL, b * T + L, e * PR + b * CAPL, e, IDX, GATE, INV, hist, misc);
    else {
      topk_problem(AFFC + ((size_t)b * 16 + e) * L, L, CAPC, b * T, e * PR + 2 * CAPL + b * CAPC, e, IDX, GATE, INV, hist, misc);
      if (b == 1) for (int q = threadIdx.x; q < PR - 2 * CAPL - 2 * CAPC; q += NTHR) { IDX[e * PR + 2 * CAPL + 2 * CAPC + q] = 0; GATE[e * PR + 2 * CAPL + 2 * CAPC + q] = 0.f; }
    }
  }
}


struct CvtStream {
  static constexpr int VM_EXTRA = 6;
  const float* const* in; unsigned char* ws; LAS float* scr; int lane;
  int s, le, which;
  int sgu, dgu, sd, dd;
  bf16_t* pdst; int pldt;
  f32x4 st[4];
  __device__ __forceinline__ void init(const Params& P, LAS unsigned char* lds, int t, int lane_, int wave) {
    in = P.in; ws = P.ws; scr = (LAS float*)(lds + 67584 + wave * 4224); lane = lane_; s = 0; le = 0; which = 0;
    { const int kb = t >> 6, n0 = (t & 63) * 32; sgu = kb * 32 * 2048 + n0; dgu = ((n0 >> 7) * 256 + (n0 & 127)) * 1024 + kb * 32; }
    { const int kb = t >> 5, n0 = (t & 31) * 32; sd = kb * 32 * 1024 + n0; dd = n0 * 2048 + kb * 32; }
    issue_point();
  }
  __device__ __forceinline__ void issue_point() {
    const bool dn = which == 2;
    const float* src = in[IN_WG + which] + (size_t)le * (1024 * 2048) + (dn ? sd : sgu);
    const int ldw = dn ? 1024 : 2048;
    pdst = dn ? (bf16_t*)(ws + WS_WD) + (size_t)le * (1024 * 2048) + dd : (bf16_t*)(ws + WS_WGU) + (size_t)le * (4096 * 1024) + which * (128 * 1024) + dgu;
    pldt = dn ? 2048 : 1024;
#if defined(EXP_FAKELD)
    const __amdgpu_buffer_rsrc_t rs = att::make_rsrc(in[IN_ABWO]);
#else
    const __amdgpu_buffer_rsrc_t rs = att::make_rsrc(src);
#endif
    const int voff = ((lane >> 3) * ldw + 4 * (lane & 7)) * 4, so = 8 * ldw * 4;
#pragma unroll
    for (int q = 0; q < 4; ++q) st[q] = __builtin_bit_cast(f32x4, __builtin_amdgcn_raw_buffer_load_b128(rs, voff, q * so, 2  ));
    if (s < 95) { ++s; if (++which == 3) { which = 0; ++le; } }
    else s = 96;
  }
  __device__ __forceinline__ void flush_point() {
    const int r = lane >> 3, c4 = (lane & 7) * 4;
#pragma unroll
    for (int q = 0; q < 4; ++q)
#pragma unroll
      for (int t = 0; t < 4; ++t) scr[(8 * q + r) * 33 + c4 + t] = st[q][t];
    LDS_WAIT(); asm volatile("" ::: "memory");
#if defined(EXP_FAKEST)
    const __amdgpu_buffer_rsrc_t rd = att::make_rsrc(ws + WS_H1 + (size_t)(blockIdx.x * 8 + (scr - (LAS float*)0) / 1056 % 8) * 2048); pldt = 32;
#else
    const __amdgpu_buffer_rsrc_t rd = att::make_rsrc(pdst);
#endif
#pragma unroll
    for (int u = 0; u < 2; ++u) { const int ii = lane + 64 * u, n = ii >> 2, c = ii & 3; const LAS float* sp = scr + (8 * c) * 33 + n;
      u32x4 o; o.x = cvt_pk_bf16(sp[0 * 33], sp[1 * 33]); o.y = cvt_pk_bf16(sp[2 * 33], sp[3 * 33]); o.z = cvt_pk_bf16(sp[4 * 33], sp[5 * 33]); o.w = cvt_pk_bf16(sp[6 * 33], sp[7 * 33]);
      __builtin_amdgcn_raw_buffer_store_b128(o, rd, (n * pldt + 8 * c) * 2, 0, 0); }
    LDS_WAIT(); asm volatile("" ::: "memory");
  }
  __device__ __forceinline__ void step() { flush_point(); issue_point(); }
  __device__ __forceinline__ void drain() { flush_point(); while (s < 96) { issue_point(); flush_point(); } }
};

template <int STRIP = 0, class Hook> __device__ __forceinline__ void phase_attn(const Params& P, LAS unsigned char* lds, int layer, int G, Hook& hk) {
  const bf16_t* Q = (const bf16_t*)(P.ws + WS_Q); const bf16_t* Kb = (const bf16_t*)(P.ws + WS_K); const bf16_t* Vb = (const bf16_t*)(P.ws + WS_V); bf16_t* AC = (bf16_t*)(P.ws + WS_AC);
  const int bx = blockIdx.x; const int nunits = layer == 0 ? 528 : 512;
  for (int i = 0;; ++i) {
    int p, qb; bool isctx = false;
    if (G == 256) { const int xcd = bx & 7, loc = bx >> 3;
      if (i < 2) { p = xcd * 2 + i; qb = loc; } else if (i == 2 && layer == 0 && loc < 2) { p = xcd * 2 + loc; qb = 0; isctx = true; } else break;
    } else { const int uid = i * G + bx; if (uid >= nunits) break; if (uid < 512) { p = uid >> 5; qb = uid & 31; } else { p = uid - 512; qb = 0; isctx = true; } }
    const int b = p >> 3, h = p & 7;
    const size_t krow0 = (size_t)b * T, qrow0 = krow0 + (isctx ? 0 : L + qb * 256);
    const int seq = isctx ? L : T;
#ifndef ATT2
#define ATT2 1
#endif
#ifndef ATT3M
#define ATT3M 1
#endif
    if ((ATT4 & 4) && layer == 0) att::attn_unit5<96, 64, 768, 768, 512, 1024, STRIP>(Q + qrow0 * 768 + h * 96, Kb + krow0 * 768 + h * 96, Vb + krow0 * 512 + h * 64, AC + qrow0 * 1024 + 512 + h * 64, seq, (char*)lds);
    else if ((ATT4 & 8) && layer == 1) att::attn_unit5<128, 128, 1024, 256, 256, 1024, STRIP>(Q + qrow0 * 1024 + h * 128, Kb + krow0 * 256 + (h >> 2) * 128, Vb + krow0 * 256 + (h >> 2) * 128, AC + qrow0 * 1024 + h * 128, seq, (char*)lds);
    else if ((ATT4 & 1) && layer == 0) att::attn_unit4<96, 64, 768, 768, 512, 1024, STRIP>(Q + qrow0 * 768 + h * 96, Kb + krow0 * 768 + h * 96, Vb + krow0 * 512 + h * 64, AC + qrow0 * 1024 + 512 + h * 64, seq, (char*)lds);
    else if ((ATT4 & 2) && layer == 1) att::attn_unit4<128, 128, 1024, 256, 256, 1024, STRIP>(Q + qrow0 * 1024 + h * 128, Kb + krow0 * 256 + (h >> 2) * 128, Vb + krow0 * 256 + (h >> 2) * 128, AC + qrow0 * 1024 + h * 128, seq, (char*)lds);
    else if (ATT3M && layer == 0) att::attn_unit3<96, 64, 768, 768, 512, 1024>(Q + qrow0 * 768 + h * 96, Kb + krow0 * 768 + h * 96, Vb + krow0 * 512 + h * 64, AC + qrow0 * 1024 + 512 + h * 64, seq, (char*)lds);
    else if (ATT2 && layer == 0) att::attn_unit2<96, 64, 768, 768, 512, 1024>(Q + qrow0 * 768 + h * 96, Kb + krow0 * 768 + h * 96, Vb + krow0 * 512 + h * 64, AC + qrow0 * 1024 + 512 + h * 64, seq, (char*)lds);
#ifndef ATT3
#define ATT3 1
#endif
    else if (ATT3) att::attn_unit3<128, 128, 1024, 256, 256, 1024>(Q + qrow0 * 1024 + h * 128, Kb + krow0 * 256 + (h >> 2) * 128, Vb + krow0 * 256 + (h >> 2) * 128, AC + qrow0 * 1024 + h * 128, seq, (char*)lds);
    else if (ATT2) att::attn_unit2<128, 128, 1024, 256, 256, 1024>(Q + qrow0 * 1024 + h * 128, Kb + krow0 * 256 + (h >> 2) * 128, Vb + krow0 * 256 + (h >> 2) * 128, AC + qrow0 * 1024 + h * 128, seq, (char*)lds);
    else if (layer == 0)
      att::attn_unit<96, 64, 768, 768, 512, 1024, 2>(Q + qrow0 * 768 + h * 96, Kb + krow0 * 768 + h * 96, Vb + krow0 * 512 + h * 64, AC + qrow0 * 1024 + 512 + h * 64, seq, (char*)lds, hk);
    else
      att::attn_unit<128, 128, 1024, 256, 256, 1024, 2>(Q + qrow0 * 1024 + h * 128, Kb + krow0 * 256 + (h >> 2) * 128, Vb + krow0 * 256 + (h >> 2) * 128, AC + qrow0 * 1024 + h * 128, seq, (char*)lds, hk);
  }
}

__global__ void __launch_bounds__(NTHR, 2) mega_fwd(Params P_) {
  const Params& P = *(const Params*)__builtin_amdgcn_kernarg_segment_ptr(); (void)P_;
  extern __shared__ __attribute__((aligned(16))) unsigned char lds_raw[];
  LAS unsigned char* lds = (LAS unsigned char*)lds_raw;
  const int tid = threadIdx.x, lane = tid & 63, wave = __builtin_amdgcn_readfirstlane(tid >> 6);
  const int G = gridDim.x, bx = blockIdx.x;
  const int vcu = (G % 8 == 0) ? (bx % 8) * (G / 8) + bx / 8 : bx;
  const int gw = vcu * NWAVES + wave, NGW = G * NWAVES;
  volatile LAS unsigned* MISC = (volatile LAS unsigned*)(lds + LDS_MISC);
  if (tid < 64) MISC[tid] = 0u;
  __syncthreads();
  unsigned char* ws = P.ws;
  unsigned* ctl = (unsigned*)(ws + WS_CTL);
  XcdBarrier bar = xcd_barrier_post(ctl + CW_BAR + P.bar_region * XCD_BAR_WORDS, MISC + 8);
  const int lo = P.ph_lo, hi = P.ph_hi;
#ifndef ONLY_PH
#define ONLY_PH -1
#endif
#define IN(k) ((ONLY_PH < 0 || ONLY_PH == (k)) && lo <= (k) && (k) < hi)
#ifndef USE_CG
#define USE_CG 1
#endif
#if USE_CG
#define SEAM(k) do { if (IN(k) && IN((k) + 1)) { if ((k) == 0 && P.use_cg) cg::this_grid().sync(); else xcd_barrier(bar); if (DUP(25)) { xcd_barrier(bar); xcd_barrier(bar); } } } while (0)
#else
#define SEAM(k) do { if (IN(k) && IN((k) + 1)) xcd_barrier(bar); } while (0)
#endif
  float* SSQ = (float*)ctl + CW_SSQ; const float* MOD = (const float*)ctl + CW_MOD;
  const f32x2* ropeA = (const f32x2*)(ws + WS_ROPEA);

#ifndef DUP_MASK
#define DUP_MASK 0
#endif
#define DUP(k) ((DUP_MASK >> (k)) & 1)
  if (IN(0)) { p0_prologue(P, lds, gw, NGW, lane, wave); if (DUP(0)) { __syncthreads(); p0_prologue(P, lds, gw, NGW, lane, wave, true); } }
  SEAM(0);
  if (IN(1)) phase_r0(P, gw, NGW, lane);
  SEAM(1);
  if (IN(2)) {
    pg8::PlainSched Sd; Sd.init(ws + WS_XN, 1024, ws + WS_WIN0, 1024, M, 1024, G, bx);
    EpiInProj0 E{(bf16_t*)(ws + WS_FTL), (bf16_t*)(ws + WS_FTC), (bf16_t*)(ws + WS_P2), (bf16_t*)(ws + WS_K), SSQ, ropeA};
    pg8::gemm_phase(lds, 1024, Sd, E);
    if (G == 256 && bx >= 8) filler(P, lds, 0, bx - 8, lane, wave);
  }
  SEAM(2);
  if (IN(3)) {
    { pg8::QKVSched Sd; Sd.init(ws + WS_P2, ws + WS_WUQ, ws + WS_WUKV, G, bx); EpiQKV E{EpiQ{(bf16_t*)(ws + WS_Q), SSQ, ropeA}, EpiKV{(bf16_t*)(ws + WS_K), (bf16_t*)(ws + WS_V), SSQ}}; pg8::gemm_phase(lds, 256, Sd, E); }
#ifndef NO_FFT
    fft_phase(lds, (const bf16_t*)(ws + WS_FTL), (const bf16_t*)(ws + WS_FTC), (bf16_t*)(ws + WS_YC), G);
    if (DUP(21)) { for (int q_ = 0; q_ < 4; ++q_) fft_phase(lds, (const bf16_t*)(ws + WS_FTL), (const bf16_t*)(ws + WS_FTC), (bf16_t*)(ws + WS_YC), G); }
#endif
  }
  SEAM(3);
  if (IN(4)) {
    { att::NoHook nh; phase_attn(P, lds, 0, G, nh); if (DUP(4)) phase_attn<ATT4_STRIP>(P, lds, 0, G, nh); }
    { pg8::PlainSched Sd; Sd.init(ws + WS_YC, 1024, ws + WS_WDFT, 1024, M, 512, G, bx); EpiBf16 E{(bf16_t*)(ws + WS_AC), 1024}; pg8::gemm_phase(lds, 1024, Sd, E); }
    if (G == 256 && bx >= 132) filler(P, lds, 6, bx - 132, lane, wave);
  }
  SEAM(4);
  if (IN(5)) { pg8::PlainSched Sd; Sd.init(ws + WS_AC, 1024, ws + WS_WO0, 1024, M, 1024, G, bx); EpiResid<true> E{(float*)(ws + WS_H), MOD, P.in[IN_X], P.in[IN_CTX]}; pg8::gemm_phase(lds, 1024, Sd, E); if (G == 256 && bx >= 8) filler(P, lds, 1, bx - 8, lane, wave); }
  SEAM(5);
  if (IN(6)) { phase_router(P, lds, 0, gw, NGW, lane); if (DUP(23)) { for (int q_ = 0; q_ < 4; ++q_) { __syncthreads(); phase_router(P, lds, 0, gw, NGW, lane); } } }
  SEAM(6);
  if (IN(7)) { phase_topk(P, lds, 0, G); if (DUP(22)) { for (int q_ = 0; q_ < 4; ++q_) phase_topk(P, lds, 0, G); } if (G == 256 && bx >= 64) filler(P, lds, 2, bx - 64, lane, wave); }
  SEAM(7);
  constexpr int MES = MOE_FP8 ? 1 : 2;
  if (IN(8)) { pg8::MoeSched<true, MES> Sd; Sd.init(ws + (MOE_FP8 ? WS_XN8 : WS_XN), 1024, 0, ws + WS_WGU, 1024, (size_t)4096 * 1024 * MES, (const int*)(ws + WS_IDX), 9, 16, G, bx); Sd.stage_idx((LAS int*)(lds + LDS_TAB)); EpiGateUp<MOE_FP8> E{ws + WS_H1}; pg8::gemm_phase(lds, 1024, Sd, E); if (DUP(8)) pg8::gemm_phase(lds, 1024, Sd, E);
    if (DUP(20)) { pg8::MoeSched<false, MES> S2; S2.init(ws + WS_XN8, 1024, (size_t)256 * 1024 * MES, ws + WS_WGU, 1024, (size_t)4096 * 1024 * MES, nullptr, 9, 16, G, bx); EpiGateUp<MOE_FP8> E2{ws + WS_Y2}; pg8::gemm_phase(lds, 1024, S2, E2); } }
  SEAM(8);
  if (IN(9)) { pg8::MoeSched<false, MES> Sd; Sd.init(ws + WS_H1, 2048, (size_t)PR * 2048 * MES, ws + WS_WD, 2048, (size_t)1024 * 2048 * MES, nullptr, 9, 4, G, bx); EpiDown<MOE_FP8> E{(bf16_t*)(ws + WS_Y2)}; pg8::gemm_phase(lds, 2048, Sd, E); if (DUP(9)) pg8::gemm_phase(lds, 2048, Sd, E);
    if (G == 256 && (bx >> 3) >= 8) filler(P, lds, 3, (bx & 7) * 24 + ((bx >> 3) - 8), lane, wave); }
  SEAM(9);
  if (IN(10)) phase_combine(P, 0, gw, NGW, lane);
  SEAM(10);
  if (IN(11)) { pg8::PlainSched Sd; Sd.init(ws + WS_XN, 1024, ws + WS_WIN1, 1024, M, 1536, G, bx); EpiInProj1 E{(bf16_t*)(ws + WS_QKR), (bf16_t*)(ws + WS_V)}; pg8::gemm_phase(lds, 1024, Sd, E); if (G == 256 && bx >= 140) filler(P, lds, 4, bx - 140, lane, wave); }
  SEAM(11);
  if (IN(12)) { phase_qkpost(P, gw, NGW, lane); if (DUP(24)) { for (int q_ = 0; q_ < 4; ++q_) phase_qkpost(P, gw, NGW, lane); } }
  SEAM(12);
  if (IN(13)) { att::NoHook nh; phase_attn(P, lds, 1, G, nh); if (DUP(13)) phase_attn<ATT4_STRIP>(P, lds, 1, G, nh); }
  SEAM(13);
  if (IN(14)) { pg8::PlainSched Sd; Sd.init(ws + WS_AC, 1024, ws + WS_WO1, 1024, M, 1024, G, bx, 1); EpiResid<false> E{(float*)(ws + WS_H), MOD + 3 * 6144, nullptr, nullptr}; pg8::gemm_phase(lds, 1024, Sd, E); }
  SEAM(14);
  if (IN(15)) phase_router(P, lds, 1, gw, NGW, lane);
  SEAM(15);
  if (IN(16)) { phase_topk(P, lds, 1, G); if (G == 256 && bx >= 32) filler(P, lds, 5, bx - 32, lane, wave); }
  SEAM(16);
  if (IN(17)) { pg8::MoeSched<true, MES> Sd; Sd.init(ws + (MOE_FP8 ? WS_XN8 : WS_XN), 1024, 0, ws + WS_WGU + (size_t)16 * 4096 * 1024 * MES, 1024, (size_t)4096 * 1024 * MES, (const int*)(ws + WS_IDX), 8, 16, G, bx); Sd.stage_idx((LAS int*)(lds + LDS_TAB)); EpiGateUp<MOE_FP8> E{ws + WS_H1}; pg8::gemm_phase(lds, 1024, Sd, E); }
  SEAM(17);
  if (IN(18)) { pg8::MoeSched<false, MES> Sd; Sd.init(ws + WS_H1, 2048, (size_t)PR * 2048 * MES, ws + WS_WD + (size_t)16 * 1024 * 2048 * MES, 2048, (size_t)1024 * 2048 * MES, nullptr, 8, 4, G, bx); EpiDown<MOE_FP8> E{(bf16_t*)(ws + WS_Y2)}; pg8::gemm_phase(lds, 2048, Sd, E); }
  SEAM(18);
  if (IN(19)) phase_combine(P, 1, gw, NGW, lane);
#undef IN
#undef SEAM
}

struct Host { int grid; bool ok; };
inline Host& host_state() { static Host h{0, false}; return h; }
inline bool host_init(size_t ws_size) {
  Host& h = host_state();
  if (h.grid != 0) return h.ok;
  h.grid = -1; h.ok = false;
  if (ws_size < WS_END) { fprintf(stderr, "fk: workspace too small: %zu < %zu\n", ws_size, (size_t)WS_END); return false; }
  int dev = 0, cus = 0, per_cu = 0;
  if (hipGetDevice(&dev) != hipSuccess || hipDeviceGetAttribute(&cus, hipDeviceAttributeMultiprocessorCount, dev) != hipSuccess) return false;
  if (hipFuncSetAttribute((const void*)mega_fwd, hipFuncAttributeMaxDynamicSharedMemorySize, LDS_BYTES) != hipSuccess) { fprintf(stderr, "fk: hipFuncSetAttribute failed\n"); return false; }
  if (hipOccupancyMaxActiveBlocksPerMultiprocessor(&per_cu, (const void*)mega_fwd, NTHR, LDS_BYTES) != hipSuccess || per_cu < 1) { fprintf(stderr, "fk: occupancy query failed (%d)\n", per_cu); (void)hipGetLastError(); return false; }
  h.grid = cus * (per_cu > 1 ? 1 : per_cu);
  h.ok = true; return true;
}
inline void launch(hipStream_t st, void* const* d_in, float* out, void* ws, int lo, int hi, int region) {
  Params p; memset(&p, 0, sizeof(p));
  for (int i = 0; i < 23; ++i) p.in[i] = (const float*)d_in[i];
  p.out = out; p.ws = (unsigned char*)ws; p.ph_lo = lo; p.ph_hi = hi; p.bar_region = region; p.use_cg = 1;
  void* args[] = {&p};
  const hipError_t e = hipLaunchCooperativeKernel((const void*)mega_fwd, dim3(host_state().grid), dim3(NTHR), args, LDS_BYTES, st);
  if (e != hipSuccess) fprintf(stderr, "fk: cooperative launch failed: %s (grid %d)\n", hipGetErrorString(e), host_state().grid);
}
}


extern "C" void kernel_launch(void* const* d_in, const int* in_sizes, int n_in, void* d_out, int out_size, void* d_ws, size_t ws_size, hipStream_t stream) {
  if (n_in != 23 || out_size != fk::NB * fk::S * fk::D) { fprintf(stderr, "kernel_launch: unexpected shapes\n"); return; }
  if (!fk::host_init(ws_size)) return;
  hipMemsetAsync((char*)d_ws + fk::WS_CTL, 0, fk::CTL_BYTES, stream);
  fk::launch(stream, d_in, (float*)d_out, d_ws, 0, fk::NPH, 0);
}
```
